# Optimizing an MI355X kernel written in HIP

```python
import jax
import jax.numpy as jnp
from jax import lax
import numpy as np

D_MODEL = 1024
BATCH = 2
SEQ = 8192
DEPTH = 2

GRID_W = 64
CTX_LEN = 256
N_AB_LAYERS = (DEPTH + 1) // 2
N_C_LAYERS = DEPTH // 2

RW_HEADS = 8
RW_HEAD_DIM = 64
RW_DIM = RW_HEADS * RW_HEAD_DIM
DECAY_LORA = 64
ICLR_LORA = 64
GATE_LORA = 128
RW_COLS = 3 * RW_DIM + 2 * DECAY_LORA + 2 * ICLR_LORA + GATE_LORA
RW_SPLITS = (RW_DIM, 2 * RW_DIM, 3 * RW_DIM, 3 * RW_DIM + DECAY_LORA, 3 * RW_DIM + 2 * DECAY_LORA,
             3 * RW_DIM + 2 * DECAY_LORA + ICLR_LORA, 3 * RW_DIM + 2 * DECAY_LORA + 2 * ICLR_LORA)
LN_X_EPS = 64e-5

MLA_HEADS = 8
MLA_NOPE = 64
MLA_ROPE = 32
MLA_V = 64
MLA_QK = MLA_NOPE + MLA_ROPE
MLA_Q_RANK = 384
MLA_KV_RANK = 256
MLA_COLS = MLA_Q_RANK + MLA_KV_RANK + MLA_ROPE
AB_IN = RW_COLS + MLA_COLS
AB_OUT = RW_DIM + MLA_HEADS * MLA_V

GQA_HEADS = 16
GQA_KV_HEADS = 4
GQA_HEAD_DIM = 64
GQA_IN = (GQA_HEADS + 2 * GQA_KV_HEADS) * GQA_HEAD_DIM

N_EXPERTS = 16
N_GROUPS = 4
EXPERTS_PER_GROUP = N_EXPERTS // N_GROUPS
TOP_K = 2
EXPERT_FF = 256
SHARED_FF = 256

Q_BLOCK = 128
ROPE_THETA = 10000.0
NORM_EPS = 1e-6

kernel_name = 'hybrid_rwkv7_mla_gqa_moe_dit'


def rmsnorm(x, g):
    xf = x.astype(jnp.float32)
    y = xf * lax.rsqrt(jnp.mean(xf * xf, axis=-1, keepdims=True) + NORM_EPS)
    return y.astype(x.dtype) * g


def ada_mods(cvec, w, b):
    m = jax.nn.silu(cvec) @ w + b
    return jnp.split(m[:, None, :], 6, axis=-1)


def modulate(h, shift, scale):
    return h * (1.0 + scale) + shift


def rope_1d(x, pos):
    half = x.shape[-1] // 2
    inv = ROPE_THETA ** (-jnp.arange(half, dtype=jnp.float32) / half)
    ang = pos[:, None] * inv[None, :]
    cos = jnp.cos(ang)[None, :, None, :].astype(x.dtype)
    sin = jnp.sin(ang)[None, :, None, :].astype(x.dtype)
    x1, x2 = x[..., :half], x[..., half:]
    return jnp.concatenate([x1 * cos - x2 * sin, x2 * cos + x1 * sin], axis=-1)


def axial_rope(x, row, col):
    h = x.shape[-1] // 2
    return jnp.concatenate([rope_1d(x[..., :h], row), rope_1d(x[..., h:], col)], axis=-1)


def ctx_attention(q, k, v, scale):
    B, L, H, d = q.shape
    Hk = k.shape[2]
    qg = q.reshape(B, L, Hk, H // Hk, d)
    s = jnp.einsum('bqkgd,bskd->bkgqs', qg, k).astype(jnp.float32) * scale
    p = jax.nn.softmax(s, axis=-1).astype(v.dtype)
    o = jnp.einsum('bkgqs,bskd->bqkgd', p, v)
    return o.reshape(B, L, H, v.shape[-1])


def latent_attention(q, k_lat, v_lat, k_ctx, v_ctx, scale):
    B, S, H, d = q.shape
    Hk = k_lat.shape[2]
    G = H // Hk
    dv = v_lat.shape[-1]
    n_ctx = k_ctx.shape[1]
    n_blk = S // Q_BLOCK
    qb = q.reshape(B, n_blk, Q_BLOCK, Hk, G, d).transpose(1, 0, 2, 3, 4, 5)

    def one_block(qblk):
        s_ctx = jnp.einsum('bqkgd,bskd->bkgqs', qblk, k_ctx)
        s_lat = jnp.einsum('bqkgd,bskd->bkgqs', qblk, k_lat)
        s = jnp.concatenate([s_ctx, s_lat], axis=-1).astype(jnp.float32) * scale
        p = jax.nn.softmax(s, axis=-1).astype(v_lat.dtype)
        return (jnp.einsum('bkgqs,bskd->bqkgd', p[..., :n_ctx], v_ctx)
                + jnp.einsum('bkgqs,bskd->bqkgd', p[..., n_ctx:], v_lat))

    o = lax.map(one_block, qb)
    return o.transpose(1, 0, 2, 3, 4, 5).reshape(B, S, H, dv)


def centred_shift_mix(p, mu):
    prev = jnp.pad(p[:, :-1], ((0, 0), (1, 0), (0, 0)))
    nxt = jnp.pad(p[:, 1:], ((0, 0), (0, 1), (0, 0)))
    return p + mu * (0.5 * (prev + nxt) - p)


def wkv7_scan(state0, r, w, k, v, a_vec, b_vec, reverse):
    xs = tuple(t.transpose(1, 0, 2, 3) for t in (r, w, k, v, a_vec, b_vec))

    def step(S, inp):
        r_t, w_t, k_t, v_t, a_t, b_t = inp
        sa = jnp.einsum('bhij,bhj->bhi', S, a_t)
        S = (S * w_t[:, :, None, :] + sa[..., None] * b_t[:, :, None, :]
             + v_t[..., None] * k_t[:, :, None, :])
        return S, jnp.einsum('bhij,bhj->bhi', S, r_t)

    s_fin, ys = lax.scan(step, state0, xs, reverse=reverse)
    return s_fin, ys.transpose(1, 0, 2, 3)


def rwkv_prep(p, prm):
    p = centred_shift_mix(p, prm['mu'])
    r, k, v, w1f, w1b, a1f, a1b, g1 = jnp.split(p, RW_SPLITS, axis=-1)
    B, L = p.shape[:2]

    def heads(t):
        return t.astype(jnp.float32).reshape(B, L, RW_HEADS, RW_HEAD_DIM)

    kk = heads(k * prm['k_k'])
    kk = kk * lax.rsqrt(jnp.sum(kk * kk, axis=-1, keepdims=True) + 1e-12)
    kf = k.astype(jnp.float32)
    dirs = []
    for d, (w1, a1) in enumerate(((w1f, a1f), (w1b, a1b))):
        z = (prm['w0'][d] + jnp.tanh(w1) @ prm['w2'][d]).astype(jnp.float32)
        decay = jnp.exp(-jnp.exp(-jax.nn.softplus(-z) - 0.5))
        a = jax.nn.sigmoid((prm['a0'][d] + a1 @ prm['a2'][d]).astype(jnp.float32))
        k_d = kf * (1.0 + (a - 1.0) * prm['k_a'])
        dirs.append((heads(decay), heads(k_d), -kk, kk * heads(a)))
    g = jax.nn.sigmoid(g1) @ prm['g2']
    return heads(r), heads(v), dirs, g


def rwkv_scans(r, v, dirs, states0):
    ys, finals = [], []
    for d, (decay, k_d, a_vec, b_vec) in enumerate(dirs):
        s_fin, y_d = wkv7_scan(states0[d], r, decay, k_d, v, a_vec, b_vec, reverse=(d == 1))
        ys.append(y_d)
        finals.append(s_fin)
    return ys[0] + ys[1], (finals[0], finals[1])


def rwkv_out(y, r, v, dirs, g, prm):
    B, L = y.shape[:2]
    mean = jnp.mean(y, axis=-1, keepdims=True)
    var = jnp.mean(jnp.square(y - mean), axis=-1, keepdims=True)
    yn = ((y - mean) * lax.rsqrt(var + LN_X_EPS)).reshape(B, L, RW_DIM) * prm['ln_w'] + prm['ln_b']
    k_sum = dirs[0][1] + dirs[1][1]
    bonus = jnp.sum(r * k_sum * prm['r_k'], axis=-1, keepdims=True) * v
    return ((yn + bonus.reshape(B, L, RW_DIM)) * g).astype(g.dtype)


def mla_qkv(p, prm, pos):
    B, L = p.shape[:2]
    q_a, kv_a, k_rope = jnp.split(p, [MLA_Q_RANK, MLA_Q_RANK + MLA_KV_RANK], axis=-1)
    q = (rmsnorm(q_a, prm['g_qa']) @ prm['w_q_up']).reshape(B, L, MLA_HEADS, MLA_QK)
    kv = (rmsnorm(kv_a, prm['g_kva']) @ prm['w_kv_up']).reshape(B, L, MLA_HEADS, MLA_NOPE + MLA_V)
    k_nope, v = kv[..., :MLA_NOPE], kv[..., MLA_NOPE:]
    k_rope = jnp.broadcast_to(k_rope[:, :, None, :], (B, L, MLA_HEADS, MLA_ROPE))
    k = jnp.concatenate([k_nope, k_rope], axis=-1)
    q = rmsnorm(q, prm['g_q'])
    k = rmsnorm(k, prm['g_k'])
    if pos is not None:
        row, col = pos
        q = jnp.concatenate([q[..., :MLA_NOPE], axial_rope(q[..., MLA_NOPE:], row, col)], axis=-1)
        k = jnp.concatenate([k[..., :MLA_NOPE], axial_rope(k[..., MLA_NOPE:], row, col)], axis=-1)
    return q, k, v


def mixer_ab(hc, hl, row, col, need_ctx, prm):
    B, S = hl.shape[:2]
    pc = hc @ prm['w_in']
    pl = hl @ prm['w_in']
    r_c, v_c, dirs_c, g_c = rwkv_prep(pc[..., :RW_COLS], prm)
    r_l, v_l, dirs_l, g_l = rwkv_prep(pl[..., :RW_COLS], prm)
    zero = jnp.zeros((B, RW_HEADS, RW_HEAD_DIM, RW_HEAD_DIM), jnp.float32)
    y_c, states_c = rwkv_scans(r_c, v_c, dirs_c, (zero, zero))
    y_l, _ = rwkv_scans(r_l, v_l, dirs_l, states_c)
    q_c, k_c, vm_c = mla_qkv(pc[..., RW_COLS:], prm, None)
    q_l, k_l, vm_l = mla_qkv(pl[..., RW_COLS:], prm, (row, col))
    scale = MLA_QK ** -0.5
    o_l = latent_attention(q_l, k_l, vm_l, k_c, vm_c, scale).reshape(B, S, MLA_HEADS * MLA_V)
    out_l = jnp.concatenate([rwkv_out(y_l, r_l, v_l, dirs_l, g_l, prm), o_l], axis=-1) @ prm['w_out']
    if not need_ctx:
        return None, out_l
    C = hc.shape[1]
    o_c = ctx_attention(q_c, k_c, vm_c, scale).reshape(B, C, MLA_HEADS * MLA_V)
    out_c = jnp.concatenate([rwkv_out(y_c, r_c, v_c, dirs_c, g_c, prm), o_c], axis=-1) @ prm['w_out']
    return out_c, out_l


def gqa_qkv(h, prm, pos):
    B, L = h.shape[:2]
    p = h @ prm['w_in']
    q, k, v = jnp.split(p, [GQA_HEADS * GQA_HEAD_DIM, (GQA_HEADS + GQA_KV_HEADS) * GQA_HEAD_DIM], axis=-1)
    q = rmsnorm(q.reshape(B, L, GQA_HEADS, GQA_HEAD_DIM), prm['g_q'])
    k = rmsnorm(k.reshape(B, L, GQA_KV_HEADS, GQA_HEAD_DIM), prm['g_k'])
    v = v.reshape(B, L, GQA_KV_HEADS, GQA_HEAD_DIM)
    if pos is not None:
        q = axial_rope(q, pos[0], pos[1])
        k = axial_rope(k, pos[0], pos[1])
    return q, k, v


def mixer_gqa(hc, hl, row, col, need_ctx, prm):
    B, S = hl.shape[:2]
    q_c, k_c, v_c = gqa_qkv(hc, prm, None)
    q_l, k_l, v_l = gqa_qkv(hl, prm, (row, col))
    scale = GQA_HEAD_DIM ** -0.5
    out_l = latent_attention(q_l, k_l, v_l, k_c, v_c, scale).reshape(B, S, GQA_HEADS * GQA_HEAD_DIM) @ prm['w_out']
    if not need_ctx:
        return None, out_l
    C = hc.shape[1]
    out_c = ctx_attention(q_c, k_c, v_c, scale).reshape(B, C, GQA_HEADS * GQA_HEAD_DIM) @ prm['w_out']
    return out_c, out_l


def moe_ffn(h, prm):
    B, L, D = h.shape
    t = h.reshape(B * L, D)
    scores = jax.nn.sigmoid((t @ prm['router_w']).astype(jnp.float32))
    grouped = (scores + prm['router_b']).reshape(-1, N_GROUPS, EXPERTS_PER_GROUP)
    group_score = jnp.sum(lax.top_k(grouped, 2)[0], axis=-1)
    grp = jnp.argmax(group_score, axis=-1)
    in_group = jnp.take_along_axis(grouped, grp[:, None, None], axis=1)[:, 0]
    _, local = lax.top_k(in_group, TOP_K)
    idx = grp[:, None] * EXPERTS_PER_GROUP + local
    wts = jnp.take_along_axis(scores, idx, axis=-1)
    wts = wts / jnp.sum(wts, axis=-1, keepdims=True)
    combine = jnp.einsum('tk,tke->te', wts, jax.nn.one_hot(idx, N_EXPERTS, dtype=jnp.float32)).astype(h.dtype)
    g = jnp.einsum('td,edf->tef', t, prm['w_gate'])
    u = jnp.einsum('td,edf->tef', t, prm['w_up'])
    y = jnp.einsum('tef,efd->td', jax.nn.silu(g) * u * combine[..., None], prm['w_down'])
    y = y + (jax.nn.silu(t @ prm['sh_gate']) * (t @ prm['sh_up'])) @ prm['sh_down']
    return y.reshape(B, L, D)


def setup_inputs(seed: int = 0) -> dict:
    key = jax.random.key(seed)
    ks = iter(jax.random.split(key, 64))

    def nrm(shape, scale):
        return jax.random.normal(next(ks), shape, jnp.float32) * scale

    def unif(shape, lo, hi):
        return jax.random.uniform(next(ks), shape, jnp.float32, lo, hi)

    def gain(shape):
        return 1.0 + nrm(shape, 0.05)

    D = D_MODEL
    A, Cn = N_AB_LAYERS, N_C_LAYERS
    return {
        'x': nrm((BATCH, SEQ, D), 1.0),
        'c': nrm((BATCH, D), 1.0),
        'ctx': nrm((BATCH, CTX_LEN, D), 1.0),
        'c_ctx': nrm((D,), 1.0),
        'ada_w': nrm((DEPTH, D, 6 * D), 0.5 * D ** -0.5),
        'ada_b': nrm((DEPTH, 6 * D), 0.02),
        'norm1_g': gain((DEPTH, D)),
        'norm2_g': gain((DEPTH, D)),
        'ab_w_in': nrm((A, D, AB_IN), D ** -0.5),
        'ab_w_out': nrm((A, AB_OUT, D), AB_OUT ** -0.5),
        'rw_mu': unif((A, RW_COLS), 0.0, 1.0),
        'rw_w0': unif((A, 2, RW_DIM), -6.0, -1.0),
        'rw_w2': nrm((A, 2, DECAY_LORA, RW_DIM), 0.5 * DECAY_LORA ** -0.5),
        'rw_a0': nrm((A, 2, RW_DIM), 0.5),
        'rw_a2': nrm((A, 2, ICLR_LORA, RW_DIM), 0.5 * ICLR_LORA ** -0.5),
        'rw_k_k': 0.85 + nrm((A, RW_DIM), 0.05),
        'rw_k_a': gain((A, RW_DIM)),
        'rw_r_k': nrm((A, RW_HEADS, RW_HEAD_DIM), 0.1),
        'rw_g2': nrm((A, GATE_LORA, RW_DIM), GATE_LORA ** -0.5),
        'rw_ln_w': gain((A, RW_DIM)),
        'rw_ln_b': nrm((A, RW_DIM), 0.02),
        'mla_g_qa': gain((A, MLA_Q_RANK)),
        'mla_w_q_up': nrm((A, MLA_Q_RANK, MLA_HEADS * MLA_QK), MLA_Q_RANK ** -0.5),
        'mla_g_kva': gain((A, MLA_KV_RANK)),
        'mla_w_kv_up': nrm((A, MLA_KV_RANK, MLA_HEADS * (MLA_NOPE + MLA_V)), MLA_KV_RANK ** -0.5),
        'mla_g_q': gain((A, MLA_QK)),
        'mla_g_k': gain((A, MLA_QK)),
        'gqa_w_in': nrm((Cn, D, GQA_IN), D ** -0.5),
        'gqa_w_out': nrm((Cn, GQA_HEADS * GQA_HEAD_DIM, D), (GQA_HEADS * GQA_HEAD_DIM) ** -0.5),
        'gqa_g_q': gain((Cn, GQA_HEAD_DIM)),
        'gqa_g_k': gain((Cn, GQA_HEAD_DIM)),
        'router_w': nrm((D, N_EXPERTS), D ** -0.5),
        'router_b': nrm((N_EXPERTS,), 0.01),
        'moe_w_gate': nrm((DEPTH, N_EXPERTS, D, EXPERT_FF), D ** -0.5),
        'moe_w_up': nrm((DEPTH, N_EXPERTS, D, EXPERT_FF), D ** -0.5),
        'moe_w_down': nrm((DEPTH, N_EXPERTS, EXPERT_FF, D), EXPERT_FF ** -0.5),
        'shared_w_gate': nrm((DEPTH, D, SHARED_FF), D ** -0.5),
        'shared_w_up': nrm((DEPTH, D, SHARED_FF), D ** -0.5),
        'shared_w_down': nrm((DEPTH, SHARED_FF, D), SHARED_FF ** -0.5),
    }


def reference(x, c, ctx, c_ctx, ada_w, ada_b, norm1_g, norm2_g, ab_w_in, ab_w_out, rw_mu, rw_w0,
              rw_w2, rw_a0, rw_a2, rw_k_k, rw_k_a, rw_r_k, rw_g2, rw_ln_w, rw_ln_b, mla_g_qa,
              mla_w_q_up, mla_g_kva, mla_w_kv_up, mla_g_q, mla_g_k, gqa_w_in, gqa_w_out, gqa_g_q,
              gqa_g_k, router_w, router_b, moe_w_gate, moe_w_up, moe_w_down, shared_w_gate,
              shared_w_up, shared_w_down):
    seq = x.shape[1]
    rows = seq // GRID_W
    row = jnp.repeat(jnp.arange(rows, dtype=jnp.float32), GRID_W)
    col = jnp.tile(jnp.arange(GRID_W, dtype=jnp.float32), rows)
    xl, xc = x, ctx
    for l in range(DEPTH):
        need_ctx = l < DEPTH - 1
        i = l // 2
        sh1_l, sc1_l, ga1_l, sh2_l, sc2_l, ga2_l = ada_mods(c, ada_w[l], ada_b[l])
        sh1_c, sc1_c, ga1_c, sh2_c, sc2_c, ga2_c = ada_mods(c_ctx[None, :], ada_w[l], ada_b[l])
        hl = modulate(rmsnorm(xl, norm1_g[l]), sh1_l, sc1_l)
        hc = modulate(rmsnorm(xc, norm1_g[l]), sh1_c, sc1_c)
        if l % 2 == 0:
            prm = dict(w_in=ab_w_in[i], w_out=ab_w_out[i], mu=rw_mu[i], w0=rw_w0[i], w2=rw_w2[i],
                       a0=rw_a0[i], a2=rw_a2[i], k_k=rw_k_k[i], k_a=rw_k_a[i], r_k=rw_r_k[i],
                       g2=rw_g2[i], ln_w=rw_ln_w[i], ln_b=rw_ln_b[i], g_qa=mla_g_qa[i],
                       w_q_up=mla_w_q_up[i], g_kva=mla_g_kva[i], w_kv_up=mla_w_kv_up[i],
                       g_q=mla_g_q[i], g_k=mla_g_k[i])
            oc, ol = mixer_ab(hc, hl, row, col, need_ctx, prm)
        else:
            prm = dict(w_in=gqa_w_in[i], w_out=gqa_w_out[i], g_q=gqa_g_q[i], g_k=gqa_g_k[i])
            oc, ol = mixer_gqa(hc, hl, row, col, need_ctx, prm)
        moe_prm = dict(router_w=router_w, router_b=router_b, w_gate=moe_w_gate[l], w_up=moe_w_up[l],
                       w_down=moe_w_down[l], sh_gate=shared_w_gate[l], sh_up=shared_w_up[l],
                       sh_down=shared_w_down[l])
        xl = xl + ga1_l * ol
        hl = modulate(rmsnorm(xl, norm2_g[l]), sh2_l, sc2_l)
        xl = xl + ga2_l * moe_ffn(hl, moe_prm)
        if need_ctx:
            xc = xc + ga1_c * oc
            hc = modulate(rmsnorm(xc, norm2_g[l]), sh2_c, sc2_c)
            xc = xc + ga2_c * moe_ffn(hc, moe_prm)
    return xl
```

```cpp
#include <hip/hip_runtime.h>
#include <hip/hip_bf16.h>
#include <cstdio>
#include <cstdint>

#define LAS __attribute__((address_space(3)))
#define GAS __attribute__((address_space(1)))
typedef unsigned short bf16_t;
typedef short bf16x8 __attribute__((ext_vector_type(8)));
typedef short s16x4 __attribute__((ext_vector_type(4)));
typedef float f32x4 __attribute__((ext_vector_type(4)));
typedef float f32x2 __attribute__((ext_vector_type(2)));
typedef float f32x16 __attribute__((ext_vector_type(16)));
typedef unsigned u32x4 __attribute__((ext_vector_type(4)));
typedef unsigned u32x2 __attribute__((ext_vector_type(2)));
typedef __bf16 bf16x2_t __attribute__((ext_vector_type(2)));

#ifndef PH_END
#define PH_END 23
#endif
#ifndef N_LAUNCH_MODE
#define N_LAUNCH_MODE 0
#endif
#ifndef ONLY_PH
#define ONLY_PH -1
#endif
#define CT(id) (ONLY_PH < 0 || ONLY_PH == (id))
#ifndef MIX_AMP
#define MIX_AMP 1.0f
#endif

constexpr int T = 16896, RB = 8448, CTXL = 256, SEQ = 8192, DM = 1024;
constexpr int NWAVES = 8, NTHR = 512;
constexpr int NE = 16, HS_TILES = 148, HS_ROWS = HS_TILES * 256;
constexpr float C2_MLA = 0.10206207261596575f * 1.4426950408889634f;
constexpr float C2_GQA = 0.125f * 1.4426950408889634f;

constexpr size_t MiB = 1u << 20;
constexpr size_t WS_CTL = 0, CTL_BYTES = 1 * MiB;
constexpr size_t WS_SMALL = 1 * MiB;
constexpr size_t SM_MODS = WS_SMALL;
constexpr size_t SM_BIASZ = WS_SMALL + 160 * 1024;
constexpr size_t SM_SEL = WS_SMALL + 192 * 1024;
constexpr size_t SM_WTS = WS_SMALL + 512 * 1024;
constexpr size_t SM_POS = WS_SMALL + 704 * 1024;
constexpr size_t SM_ROWWT = WS_SMALL + 1024 * 1024;
constexpr size_t WS_WD = 4 * MiB;
constexpr size_t O_WIN0 = 0, O_WOUT0 = 5767168, O_WLORA = 7864320, O_WQUP = 9830400, O_WKVUP = 10420224, O_WIN1 = 10944512, O_WOUT1 = 14090240, O_WD_END = 16187392;
static_assert(O_WD_END <= 17 * MiB, "dense weights");
constexpr size_t WS_XLC = 21 * MiB;
constexpr size_t WS_KROPE = 23 * MiB;
constexpr size_t WS_A = 26 * MiB;
constexpr size_t WS_B = 59 * MiB;
constexpr size_t WS_C = 113770496;
constexpr size_t WS_ACT = 183 * MiB;
constexpr size_t WS_D = 191 * MiB;
constexpr size_t WS_YB = 224 * MiB;
constexpr size_t SZ1024 = (size_t)T * 1024 * 2, SZ512 = (size_t)T * 512 * 2, SZ768 = (size_t)T * 768 * 2, SZ384 = (size_t)T * 384 * 2, SZ256 = (size_t)T * 256 * 2;
static_assert(WS_A + SZ1024 <= WS_B && WS_B + 3 * SZ512 <= WS_C && WS_C + (size_t)T * 2816 * 2 <= 200 * MiB, "map");
static_assert(WS_C + (size_t)HS_ROWS * 2048 <= WS_ACT && WS_ACT + (size_t)(HS_ROWS + T) * 512 <= 211 * MiB, "map2");
static_assert(WS_D + SZ768 + SZ1024 <= 256 * MiB && WS_YB + SZ512 <= 256 * MiB && WS_D + SZ1024 <= WS_YB, "map3");
constexpr size_t WS_NEED = 256 * MiB;
constexpr int CW_TMO = 0, CW_BAR = 4096, CW_CNT = 8192  , CW_QUEUE = 12288;

__device__ __forceinline__ float bf2f(unsigned short h) { return __uint_as_float((unsigned)h << 16); }
__device__ __forceinline__ unsigned pk2(float lo, float hi) { f32x2 v = {lo, hi}; bf16x2_t b = __builtin_convertvector(v, bf16x2_t); return __builtin_bit_cast(unsigned, b); }
__device__ __forceinline__ float lo2f(unsigned w) { return __uint_as_float(w << 16); }
__device__ __forceinline__ float hi2f(unsigned w) { return __uint_as_float(w & 0xffff0000u); }
__device__ __forceinline__ float sigmoidf_(float x) { return __builtin_amdgcn_rcpf(1.f + __expf(-x)); }
__device__ __forceinline__ float wave_sum(float v) {
#pragma unroll
    for (int o = 1; o < 64; o <<= 1) v += __shfl_xor(v, o);
    return v;
}
#define DPP_ROR_ADD(x, ctrl) x += __int_as_float(__builtin_amdgcn_update_dpp(0, __float_as_int(x), ctrl, 0xF, 0xF, false))
__device__ __forceinline__ float rowsum16(float x) {
    DPP_ROR_ADD(x, 0x128); DPP_ROR_ADD(x, 0x124); DPP_ROR_ADD(x, 0x122); DPP_ROR_ADD(x, 0x121); return x;
}
#define LDS_WAIT() asm volatile("s_waitcnt lgkmcnt(0)" ::: "memory")
#define VM_WAIT() asm volatile("s_waitcnt vmcnt(0)" ::: "memory")

namespace g8 {
constexpr int BM = 256, BK = 64, HALF = 128, HTB = HALF * BK * 2, STAGE_BYTES = 8 * HTB, NXCD = 8, WGM = 8;
__host__ __device__ __forceinline__ int lds_byte(int r, int c) { const int st = (r >> 4) * 2 + (c >> 5), rr = r & 15, cc = c & 31, ob = rr * 64 + cc * 2; return st * 1024 + (ob ^ (((ob >> 9) & 1) << 5)); }
__host__ __device__ __forceinline__ void stage_rc(int b, int& R, int& C) { const int st = b / 1024, sb = b % 1024, swz = sb ^ (((sb >> 9) & 1) << 5); R = (st >> 1) * 16 + swz / 64; C = (st & 1) * 32 + (swz % 64) / 2; }
__host__ __device__ __forceinline__ int perm32(int rho) { const int n = rho >> 4, i = rho & 15; return 8 * (i >> 2) + 4 * n + (i & 3); }

struct Unit { const char* a; const char* b; char* o; const float* f0; int pn; int aux; };

__device__ __forceinline__ bool tile_order(int i, int G, int c, int nM, int nN, int& pm, int& pn) {
    const int nwg = nM * nN; const long L = (long)i * G + c; if (L >= nwg) return false;
    int wgid = (int)L; { const int q = nwg / NXCD, r = nwg % NXCD, xcd = wgid % NXCD, off = wgid / NXCD; wgid = (xcd < r ? xcd * (q + 1) : r * (q + 1) + (xcd - r) * q) + off; }
    const int nig = WGM * nN, gid = wgid / nig, fm = gid * WGM, gsz = (nM - fm) < WGM ? (nM - fm) : WGM;
    pm = fm + ((wgid % nig) % gsz); pn = (wgid % nig) / gsz; return true;
}

struct EpiStoreBf16 {
    static constexpr bool PERM = true;
    int ldc; const float* bias; int sig_cols;
    __device__ __forceinline__ void operator()(const f32x4 (&acc)[2][2][4][2], const Unit& u, int wr, int wc, int fr, int fq) const {
        bf16_t* base = (bf16_t*)u.o; const int col0 = u.pn * BM + wc * 32 + 8 * fq;
        const bool sig = (u.pn * BM) < sig_cols;
        f32x4 bv[2][2];
#pragma unroll
        for (int bj = 0; bj < 2; ++bj)
#pragma unroll
            for (int n = 0; n < 2; ++n) bv[bj][n] = bias ? *(const f32x4*)(bias + col0 + bj * HALF + 4 * n) : (f32x4){0.f, 0.f, 0.f, 0.f};
#pragma unroll
        for (int ai = 0; ai < 2; ++ai)
#pragma unroll
            for (int m = 0; m < 4; ++m) { bf16_t* rowp = base + (size_t)(ai * HALF + wr * 64 + m * 16 + fr) * ldc + col0;
#pragma unroll
                for (int bj = 0; bj < 2; ++bj) { f32x4 v0 = acc[ai][bj][m][0] + bv[bj][0], v1 = acc[ai][bj][m][1] + bv[bj][1];
                    if (sig) {
#pragma unroll
                        for (int j = 0; j < 4; ++j) { v0[j] = sigmoidf_(v0[j]); v1[j] = sigmoidf_(v1[j]); } }
                    u32x4 w; w.x = pk2(v0[0], v0[1]); w.y = pk2(v0[2], v0[3]); w.z = pk2(v1[0], v1[1]); w.w = pk2(v1[2], v1[3]);
                    *(u32x4*)(rowp + bj * HALF) = w; } }
    }
};
struct EpiResGate {
    static constexpr bool PERM = false;
    const float* gate0; float amp;
    __device__ __forceinline__ void operator()(const f32x4 (&acc)[2][2][4][2], const Unit& u, int wr, int wc, int fr, int fq) const {
        const float* base = u.f0; float* out = (float*)u.o; const float* gate = gate0 + u.aux * 6144;
        const int col0 = u.pn * BM + wc * 32 + 4 * fq;
        f32x4 gv[2][2];
#pragma unroll
        for (int bj = 0; bj < 2; ++bj)
#pragma unroll
            for (int n = 0; n < 2; ++n) gv[bj][n] = *(const f32x4*)(gate + col0 + bj * HALF + n * 16) * amp;
#pragma unroll
        for (int ai = 0; ai < 2; ++ai)
#pragma unroll
            for (int m = 0; m < 4; ++m) { const size_t off = (size_t)(ai * HALF + wr * 64 + m * 16 + fr) * DM + col0;
#pragma unroll
                for (int bj = 0; bj < 2; ++bj)
#pragma unroll
                    for (int n = 0; n < 2; ++n) { const f32x4 bs = *(const f32x4*)(base + off + bj * HALF + n * 16);
                        *(f32x4*)(out + off + bj * HALF + n * 16) = bs + gv[bj][n] * acc[ai][bj][m][n]; }
                asm volatile("" ::: "memory"); }
    }
};
struct EpiSwiGLU {
    static constexpr bool PERM = true;
    __device__ __forceinline__ void operator()(const f32x4 (&acc)[2][2][4][2], const Unit& u, int wr, int wc, int fr, int fq) const {
        bf16_t* act = (bf16_t*)u.o; const float* rw = u.f0; const int f0 = u.pn * 128 + wc * 32 + 8 * fq;
#pragma unroll
        for (int ai = 0; ai < 2; ++ai)
#pragma unroll
            for (int m = 0; m < 4; ++m) { const int r = ai * HALF + wr * 64 + m * 16 + fr; const float wt = rw ? rw[r] : 1.f;
                float o[8];
#pragma unroll
                for (int n = 0; n < 2; ++n)
#pragma unroll
                    for (int j = 0; j < 4; ++j) { const float g = acc[ai][0][m][n][j], up = acc[ai][1][m][n][j]; o[n * 4 + j] = g * sigmoidf_(g) * up * wt; }
                u32x4 w; w.x = pk2(o[0], o[1]); w.y = pk2(o[2], o[3]); w.z = pk2(o[4], o[5]); w.w = pk2(o[6], o[7]);
                *(u32x4*)(act + (size_t)r * 256 + f0) = w; asm volatile("" ::: "memory"); }
    }
};

template <class Epi, class Sched>
__device__ __forceinline__ void gemm_phase(LAS unsigned char* lds, const int K, const Sched& S, const Epi& E) {
    const int tid = threadIdx.x, wid = __builtin_amdgcn_readfirstlane(tid >> 6), lane = tid & 63, wr = wid >> 2, wc = wid & 3, fr = lane & 15, fq = lane >> 4;
    const int nt = K / BK;
    unsigned voffA[2], voffB[2];
#pragma unroll
    for (int i = 0; i < 2; ++i) { int R, C; stage_rc(tid * 16 + i * 8192, R, C); const int Rb = Epi::PERM ? ((R & ~31) + perm32(R & 31)) : R;
        voffA[i] = (unsigned)(R * K + C) * 2u; voffB[i] = (unsigned)(Rb * K + C) * 2u; }
    const size_t kstep = (size_t)(BK * 2);
    const size_t hstep = (size_t)HALF * K * 2;
    const unsigned ldsw = (unsigned)wid * 1024u;
    const int aoff = lds_byte(wr * 64 + fr, fq * 8), boff = lds_byte(wc * 32 + fr, fq * 8);
#define PG8_SA(b, h) (((b) * 2 + (h)) * HTB)
#define PG8_SB(b, h) ((4 + (b) * 2 + (h)) * HTB)
#define PG8_STAGE(bufoff, gbase, voff) do { _Pragma("unroll") for (int _i = 0; _i < 2; ++_i) \
        __builtin_amdgcn_global_load_lds((const unsigned*)((const char*)(gbase) + (voff)[_i]), (LAS unsigned*)(lds + (bufoff) + ldsw + _i * 8192), 16, 0, 0); } while (0)
#define PG8_LDA(dst, b, h) do { _Pragma("unroll") for (int m = 0; m < 4; ++m) _Pragma("unroll") for (int k = 0; k < 2; ++k) dst[m][k] = *(const LAS bf16x8*)(lds + PG8_SA(b, h) + aoff + m * 2048 + k * 1024); } while (0)
#define PG8_LDB(dst, b, h) do { _Pragma("unroll") for (int n = 0; n < 2; ++n) _Pragma("unroll") for (int k = 0; k < 2; ++k) dst[n][k] = *(const LAS bf16x8*)(lds + PG8_SB(b, h) + boff + n * 2048 + k * 1024); } while (0)
#define PG8_MMA(ai, bj, At, Bt) do { __builtin_amdgcn_s_setprio(1); _Pragma("unroll") for (int m = 0; m < 4; ++m) _Pragma("unroll") for (int n = 0; n < 2; ++n) _Pragma("unroll") for (int k = 0; k < 2; ++k) \
        acc[ai][bj][m][n] = __builtin_amdgcn_mfma_f32_16x16x32_bf16(Bt[n][k], At[m][k], acc[ai][bj][m][n], 0, 0, 0); __builtin_amdgcn_s_setprio(0); } while (0)
#define PG8_WAIT_V(n) asm volatile("s_waitcnt vmcnt(" #n ")" ::: "memory")
#define PG8_WAIT_L(n) asm volatile("s_waitcnt lgkmcnt(" #n ")" ::: "memory")
#define PG8_BAR __builtin_amdgcn_s_barrier()
#define PG8_SCHED __builtin_amdgcn_sched_barrier(0)
    Unit cur, nxt; int ui = 0;
    if (!S.next(0, cur)) return;
    f32x4 acc[2][2][4][2];
#pragma unroll
    for (int a = 0; a < 2; ++a)
#pragma unroll
        for (int b = 0; b < 2; ++b)
#pragma unroll
            for (int m = 0; m < 4; ++m)
#pragma unroll
                for (int n = 0; n < 2; ++n) acc[a][b][m][n] = (f32x4){0.f, 0.f, 0.f, 0.f};
    bf16x8 At[4][2], B0[2][2], B1[2][2];
    const char* cA = cur.a; const char* cB = cur.b;
    PG8_STAGE(PG8_SB(0, 0), cB, voffB); PG8_STAGE(PG8_SB(0, 1), cB + hstep, voffB); PG8_STAGE(PG8_SA(0, 0), cA, voffA); PG8_STAGE(PG8_SA(0, 1), cA + hstep, voffA);
    if (wr == 1) PG8_BAR;
    PG8_WAIT_V(2); PG8_BAR;
    PG8_STAGE(PG8_SB(1, 0), cB + kstep, voffB); PG8_STAGE(PG8_SA(1, 0), cA + kstep, voffA); PG8_STAGE(PG8_SB(1, 1), cB + hstep + kstep, voffB);
    PG8_WAIT_V(6); PG8_BAR;
    for (;;) {
        const bool has_next = S.next(ui + 1, nxt);
        const char* nA = has_next ? nxt.a : cA; const char* nB = has_next ? nxt.b : cB;
#pragma unroll 1
        for (int t = 0; t < nt; t += 2) {
            const bool last = (t == nt - 2);
            const char* a1 = cA + (size_t)(t + 1) * kstep;
            const char* a2 = last ? nA : cA + (size_t)(t + 2) * kstep; const char* b2 = last ? nB : cB + (size_t)(t + 2) * kstep;
            const char* a3 = a2 + kstep; const char* b3 = b2 + kstep;
            PG8_LDB(B0, 0, 0); PG8_LDB(B1, 0, 1); PG8_SCHED; PG8_LDA(At, 0, 0); PG8_STAGE(PG8_SA(1, 1), a1 + hstep, voffA);
            PG8_WAIT_V(8); PG8_WAIT_L(0); PG8_BAR; PG8_MMA(0, 0, At, B0); PG8_MMA(0, 1, At, B1); PG8_BAR; PG8_SCHED;
            PG8_LDA(At, 0, 1); PG8_STAGE(PG8_SB(0, 0), b2, voffB); PG8_STAGE(PG8_SB(0, 1), b2 + hstep, voffB); PG8_STAGE(PG8_SA(0, 0), a2, voffA);
            PG8_WAIT_V(8); PG8_WAIT_L(0); PG8_BAR; PG8_MMA(1, 0, At, B0); PG8_MMA(1, 1, At, B1); PG8_BAR; PG8_SCHED;
            PG8_LDB(B0, 1, 0); PG8_LDB(B1, 1, 1); PG8_SCHED; PG8_LDA(At, 1, 0); PG8_STAGE(PG8_SA(0, 1), a2 + hstep, voffA);
            PG8_WAIT_V(8); PG8_WAIT_L(0); PG8_BAR; PG8_MMA(0, 0, At, B0); PG8_MMA(0, 1, At, B1); PG8_BAR; PG8_SCHED;
            PG8_LDA(At, 1, 1); PG8_STAGE(PG8_SB(1, 0), b3, voffB); PG8_STAGE(PG8_SB(1, 1), b3 + hstep, voffB); PG8_STAGE(PG8_SA(1, 0), a3, voffA);
            PG8_WAIT_V(8); PG8_WAIT_L(0); PG8_BAR; PG8_MMA(1, 0, At, B0); PG8_MMA(1, 1, At, B1); PG8_BAR; PG8_SCHED;
        }
        if (wr == 0) PG8_BAR;
        E(acc, cur, wr, wc, fr, fq);
        if (!has_next) break;
#pragma unroll
        for (int a = 0; a < 2; ++a)
#pragma unroll
            for (int b = 0; b < 2; ++b)
#pragma unroll
                for (int m = 0; m < 4; ++m)
#pragma unroll
                    for (int n = 0; n < 2; ++n) acc[a][b][m][n] = (f32x4){0.f, 0.f, 0.f, 0.f};
        cur = nxt; cA = nA; cB = nB; ++ui;
        if (wr == 1) PG8_BAR;
    }
    PG8_WAIT_V(0);
    PG8_BAR;
#undef PG8_SA
#undef PG8_SB
#undef PG8_STAGE
#undef PG8_LDA
#undef PG8_LDB
#undef PG8_MMA
#undef PG8_WAIT_V
#undef PG8_WAIT_L
#undef PG8_BAR
#undef PG8_SCHED
}
}

namespace att {
#define SBAR() __builtin_amdgcn_sched_barrier(0)
__device__ __forceinline__ int crow(int r, int hi) { return (r & 3) + 8 * (r >> 2) + 4 * hi; }
constexpr float THR = 8.f;
__device__ __forceinline__ void partialSM(f32x16& p0, f32x16& p1, float& m_reg, float& alpha) {
    float pmax = p0[0];
#pragma unroll
    for (int r = 1; r < 16; ++r) pmax = fmaxf(pmax, p0[r]);
#pragma unroll
    for (int r = 0; r < 16; ++r) pmax = fmaxf(pmax, p1[r]);
    { auto rr = __builtin_amdgcn_permlane32_swap(__float_as_uint(pmax), __float_as_uint(pmax), false, false);
      pmax = fmaxf(__uint_as_float(rr[0]), __uint_as_float(rr[1])); }
    float mn;
    if (__builtin_expect(__all(pmax - m_reg <= THR), 1)) { mn = m_reg; alpha = 1.f; }
    else { mn = fmaxf(m_reg, pmax); alpha = __builtin_amdgcn_exp2f(m_reg - mn); m_reg = mn; }
#pragma unroll
    for (int r = 0; r < 16; ++r) p0[r] = p0[r] - mn;
#pragma unroll
    for (int r = 0; r < 16; ++r) p1[r] = p1[r] - mn;
#pragma unroll
    for (int r = 0; r < 16; ++r) p0[r] = __builtin_amdgcn_exp2f(p0[r]);
}
__device__ __forceinline__ void finishSM(f32x16& p0, f32x16& p1, float alpha, float& l_reg, bf16x8& pa0, bf16x8& pa1, bf16x8& pa2, bf16x8& pa3) {
#pragma unroll
    for (int r = 0; r < 16; ++r) p1[r] = __builtin_amdgcn_exp2f(p1[r]);
    float ps = 0;
#pragma unroll
    for (int r = 0; r < 16; ++r) ps += p0[r];
#pragma unroll
    for (int r = 0; r < 16; ++r) ps += p1[r];
    { auto rr = __builtin_amdgcn_permlane32_swap(__float_as_uint(ps), __float_as_uint(ps), false, false);
      ps = __uint_as_float(rr[0]) + __uint_as_float(rr[1]); }
    l_reg = l_reg * alpha + ps;
#define PK4(P, BASE, OUT) do { unsigned a0 = pk2(P[BASE + 0], P[BASE + 1]), a1 = pk2(P[BASE + 2], P[BASE + 3]);   \
    unsigned b0 = pk2(P[BASE + 4], P[BASE + 5]), b1 = pk2(P[BASE + 6], P[BASE + 7]);                              \
    auto r0 = __builtin_amdgcn_permlane32_swap(a0, b0, false, false); auto r1 = __builtin_amdgcn_permlane32_swap(a1, b1, false, false); \
    u32x4 w = {r0[0], r1[0], r0[1], r1[1]}; OUT = __builtin_bit_cast(bf16x8, w); } while (0)
    PK4(p0, 0, pa0); PK4(p0, 8, pa1); PK4(p1, 0, pa2); PK4(p1, 8, pa3);
#undef PK4
}
template <int DQK>
__device__ __forceinline__ void qkt(f32x16& p0, f32x16& p1, const char* Ks, const bf16x8* qr, int r32, int hi) {
    p0 = f32x16{}; p1 = f32x16{};
    const char* kb = Ks + hi * 1024 + r32 * 16;
#pragma unroll
    for (int d0 = 0; d0 < DQK / 16; ++d0) {
        bf16x8 b0 = *reinterpret_cast<const bf16x8*>(kb + d0 * 2048);
        bf16x8 b1 = *reinterpret_cast<const bf16x8*>(kb + d0 * 2048 + 512);
        p0 = __builtin_amdgcn_mfma_f32_32x32x16_bf16(b0, qr[d0], p0, 0, 0, 0);
        p1 = __builtin_amdgcn_mfma_f32_32x32x16_bf16(b1, qr[d0], p1, 0, 0, 0); }
}
__device__ __forceinline__ int v_st(int k, int c) { const int kk = (k & ~0xC) | ((k & 4) << 1) | ((k & 8) >> 1); return ((kk >> 3) * 2 + (c >> 5)) * 512 + ((kk & 7) * 32 + (c & 31)) * 2; }
__device__ __forceinline__ int v_rd_base(int lane) { return ((lane & 3) << 3) | (((lane >> 2) & 3) << 6) | (((lane >> 4) & 1) << 5) | (((lane >> 5) & 1) << 8); }
constexpr int v_rd_off(int d0, int ks, int half) { return d0 * 512 + ks * 2048 + half * 1024; }
template <int OFF> __device__ __forceinline__ s16x4 tr_read(int vb) {
    s16x4 r; asm volatile("ds_read_b64_tr_b16 %0, %1 offset:%2" : "=&v"(r) : "v"(vb), "i"(OFF) : "memory"); return r;
}
template <int D0> __device__ __forceinline__ void pv_one(f32x16& od, int vb, bf16x8 pa0, bf16x8 pa1, bf16x8 pa2, bf16x8 pa3) {
    const s16x4 l0 = tr_read<v_rd_off(D0, 0, 0)>(vb), h0 = tr_read<v_rd_off(D0, 0, 1)>(vb), l1 = tr_read<v_rd_off(D0, 1, 0)>(vb), h1 = tr_read<v_rd_off(D0, 1, 1)>(vb);
    const s16x4 l2 = tr_read<v_rd_off(D0, 2, 0)>(vb), h2 = tr_read<v_rd_off(D0, 2, 1)>(vb), l3 = tr_read<v_rd_off(D0, 3, 0)>(vb), h3 = tr_read<v_rd_off(D0, 3, 1)>(vb);
    asm volatile("s_waitcnt lgkmcnt(0)" ::: "memory"); SBAR();
#define PK(L, H) (bf16x8){L[0], L[1], L[2], L[3], H[0], H[1], H[2], H[3]}
    od = __builtin_amdgcn_mfma_f32_32x32x16_bf16(pa0, PK(l0, h0), od, 0, 0, 0);
    od = __builtin_amdgcn_mfma_f32_32x32x16_bf16(pa1, PK(l1, h1), od, 0, 0, 0);
    od = __builtin_amdgcn_mfma_f32_32x32x16_bf16(pa2, PK(l2, h2), od, 0, 0, 0);
    od = __builtin_amdgcn_mfma_f32_32x32x16_bf16(pa3, PK(l3, h3), od, 0, 0, 0);
#undef PK
}
__device__ __forceinline__ void pv_all(f32x16* o, int vb, bf16x8 pa0, bf16x8 pa1, bf16x8 pa2, bf16x8 pa3) {
    pv_one<0>(o[0], vb, pa0, pa1, pa2, pa3); pv_one<1>(o[1], vb, pa0, pa1, pa2, pa3);
}
template <int DQK> struct Lay { static constexpr int NCH = DQK / 8, SHM_K = 64 * DQK * 2, SHM_V = 8192, OFF_V = 0, OFF_K = 2 * SHM_V, OFF_WS = OFF_K + 2 * SHM_K, OFF_OST = OFF_WS + NWAVES * 256, BYTES = OFF_OST + NWAVES * 4096; };
template <int DQK>
__device__ __forceinline__ void attn_unit(const bf16_t* __restrict__ Qb, int ldq, const bf16_t* __restrict__ Kh, int ldk, const bf16_t* __restrict__ Vh, int ldv,
                                          bf16_t* __restrict__ Ob, int ldo, int NT, char* lds) {
    using L = Lay<DQK>; constexpr int NCH = L::NCH, ND0 = DQK / 16;
    const int tid = threadIdx.x, wid = tid >> 6, lane = tid & 63, r32 = lane & 31, hi = lane >> 5;
    char* V_lds = lds + L::OFF_V; char* K_lds = lds + L::OFF_K;
    float* ws = (float*)(lds + L::OFF_WS) + wid * 64; float* li_l = ws; float* al_l = ws + 32;
    float m_reg = -1e30f, l_reg = 0; f32x16 o[2] = {}; bf16x8 qr[ND0];
    const bf16_t* Qw = Qb + (size_t)(wid * 32 + r32) * ldq + hi * 8;
#pragma unroll
    for (int d0 = 0; d0 < ND0; ++d0) qr[d0] = *reinterpret_cast<const bf16x8*>(Qw + d0 * 16);
    const int vrow = tid >> 3, vcol = (tid & 7) * 8, vst = v_st(vrow, vcol);
    const int kp0 = tid, kr0 = kp0 / NCH, kc0 = kp0 % NCH, kst0 = kc0 * 1024 + kr0 * 16;
    const int kp1 = 512 + (tid & 255), kr1 = kp1 / NCH, kc1 = kp1 % NCH, kst1 = kc1 * 1024 + kr1 * 16;
    const int vb0 = (int)(uintptr_t)V_lds + v_rd_base(lane);
    struct { bf16x8 v, k0, k1; } sr_[2];
#define SLOAD(i, key0) do { sr_[i].v = *reinterpret_cast<const bf16x8*>(Vh + (size_t)((key0) + vrow) * ldv + vcol); \
    sr_[i].k0 = *reinterpret_cast<const bf16x8*>(Kh + (size_t)((key0) + kr0) * ldk + kc0 * 8); \
    if (NCH > 8) sr_[i].k1 = *reinterpret_cast<const bf16x8*>(Kh + (size_t)((key0) + kr1) * ldk + kc1 * 8); } while (0)
#define SWRITE(b, i) do { *(bf16x8*)(V_lds + (b) * L::SHM_V + vst) = sr_[i].v; *(bf16x8*)(K_lds + (b) * L::SHM_K + kst0) = sr_[i].k0; \
    if (NCH > 8) { if (tid < 256) *(bf16x8*)(K_lds + (b) * L::SHM_K + kst1) = sr_[i].k1; } } while (0)
#define SWAIT() do { if (NCH > 8) asm volatile("s_waitcnt vmcnt(3)" ::: "memory"); else asm volatile("s_waitcnt vmcnt(2)" ::: "memory"); } while (0)
#define RESC(a) do { if (__any((a) < 1.f)) { if (hi == 0) al_l[r32] = (a); asm volatile("s_waitcnt lgkmcnt(0)" ::: "memory"); \
    _Pragma("unroll") for (int d = 0; d < 2; ++d) _Pragma("unroll") for (int r = 0; r < 16; ++r) o[d][r] *= al_l[crow(r, hi)]; } } while (0)
    f32x16 pA0, pA1, pB0, pB1; float alA, alB; bf16x8 pa0, pa1, pa2, pa3;
    constexpr int SE = 0, SO = 1;
    SLOAD(SE, 0); asm volatile("s_waitcnt vmcnt(0)" ::: "memory"); SWRITE(0, SE); __syncthreads();
    qkt<DQK>(pA0, pA1, K_lds, qr, r32, hi); partialSM(pA0, pA1, m_reg, alA);
    SLOAD(SO, 64); if (2 < NT) SLOAD(SE, 128);
    SWAIT(); SWRITE(1, SO); __syncthreads();
    for (int j = 1; j + 1 < NT; j += 2) {
        SBAR(); qkt<DQK>(pB0, pB1, K_lds + L::SHM_K, qr, r32, hi);
        finishSM(pA0, pA1, alA, l_reg, pa0, pa1, pa2, pa3); SBAR();
        SLOAD(SO, (j + 2) * 64); SBAR();
        pv_all(o, vb0, pa0, pa1, pa2, pa3); partialSM(pB0, pB1, m_reg, alB);
        __syncthreads(); SWAIT(); SWRITE(0, SE);
        RESC(alB); __syncthreads();
        SBAR(); qkt<DQK>(pA0, pA1, K_lds, qr, r32, hi);
        finishSM(pB0, pB1, alB, l_reg, pa0, pa1, pa2, pa3); SBAR();
        if (j + 3 < NT) SLOAD(SE, (j + 3) * 64); SBAR();
        pv_all(o, vb0 + L::SHM_V, pa0, pa1, pa2, pa3); partialSM(pA0, pA1, m_reg, alA);
        __syncthreads(); SWAIT(); SWRITE(1, SO);
        RESC(alA); __syncthreads();
    }
    SBAR(); qkt<DQK>(pB0, pB1, K_lds + L::SHM_K, qr, r32, hi);
    finishSM(pA0, pA1, alA, l_reg, pa0, pa1, pa2, pa3); SBAR();
    pv_all(o, vb0, pa0, pa1, pa2, pa3); partialSM(pB0, pB1, m_reg, alB);
    __syncthreads(); RESC(alB);
    finishSM(pB0, pB1, alB, l_reg, pa0, pa1, pa2, pa3); SBAR();
    pv_all(o, vb0 + L::SHM_V, pa0, pa1, pa2, pa3);
    if (hi == 0) li_l[r32] = l_reg; asm volatile("s_waitcnt lgkmcnt(0)" ::: "memory");
    float rli[16];
#pragma unroll
    for (int r = 0; r < 16; ++r) rli[r] = __builtin_amdgcn_rcpf(li_l[crow(r, hi)]);
    bf16_t* Ow = Ob + (size_t)(wid * 32) * ldo;
    { bf16_t* stg = (bf16_t*)(lds + L::OFF_OST) + wid * 2048;
#pragma unroll
      for (int r = 0; r < 16; ++r) { const int orow = crow(r, hi);
#pragma unroll
        for (int d0 = 0; d0 < 2; ++d0) stg[orow * 64 + d0 * 32 + r32] = (bf16_t)(pk2(o[d0][r] * rli[r], 0.f) & 0xffffu); }
      asm volatile("s_waitcnt lgkmcnt(0)" ::: "memory");
#pragma unroll
      for (int i = 0; i < 4; ++i) { const int row = i * 8 + (lane >> 3), ch = lane & 7; const u32x4 v = *(const u32x4*)(stg + row * 64 + ch * 8); *(u32x4*)(Ow + (size_t)row * ldo + ch * 8) = v; } }
    asm volatile("s_waitcnt lgkmcnt(0)" ::: "memory");
#undef SLOAD
#undef SWRITE
#undef SWAIT
#undef RESC
}
#undef SBAR
}

#define XB_TMO      128
#define XB_XCNT(j)  (256  + 64 * (j))
#define XB_XSUB(j)  (1280 + 64 * (j))
#define XB_XGEN(j)  (2304 + 64 * (j))
#define XB_TOP      3328
#define XB_TOPGEN   3392
#define XCD_BAR_WORDS 3456
#define XB_SPIN_CAP (1u << 18)
__device__ __forceinline__ unsigned xb_ld(unsigned* p)              { return __hip_atomic_load(p, __ATOMIC_RELAXED, __HIP_MEMORY_SCOPE_AGENT); }
__device__ __forceinline__ unsigned xb_add(unsigned* p, unsigned v) { return __hip_atomic_fetch_add(p, v, __ATOMIC_RELAXED, __HIP_MEMORY_SCOPE_AGENT); }
__device__ __forceinline__ unsigned xb_xcc_id() { return (unsigned)__builtin_amdgcn_s_getreg((3 << 11) | 20) & 0xFu; }
#define XB_SPIN(cond, bar) do { unsigned _sp = 0; while (cond) { __builtin_amdgcn_s_sleep(1); \
    if ((++_sp & 255u) == 0u) { if (xb_ld(&(bar)[XB_TMO])) break; if (_sp > XB_SPIN_CAP) { atomicAdd(&(bar)[XB_TMO], 1u); break; } } } } while (0)
struct XcdBarrier { unsigned* bar; unsigned x; volatile LAS unsigned* st; };
__device__ __forceinline__ XcdBarrier xcd_barrier_post(unsigned* bar, volatile LAS unsigned* st) {
    XcdBarrier b; b.bar = bar; b.x = xb_xcc_id(); b.st = st;
    if (threadIdx.x == 0) (void)xb_add(&bar[XB_XCNT(b.x)], 1u);
    return b;
}
__device__ __forceinline__ void xcd_barrier_complete(unsigned* bar, unsigned x, unsigned& nloc, unsigned& nx) {
    const unsigned G = gridDim.x * gridDim.y * gridDim.z;
    unsigned sum, cnt, mine, sp = 0u;
    for (;;) {
        sum = 0u; cnt = 0u; mine = 0u;
#pragma unroll
        for (unsigned j = 0; j < 16; ++j) { const unsigned c = xb_ld(&bar[XB_XCNT(j)]); sum += c; cnt += (c > 0u) ? 1u : 0u; mine = (j == x) ? c : mine; }
        if (sum == G) break;
        __builtin_amdgcn_s_sleep(1);
        if ((++sp & 255u) == 0u) { if (xb_ld(&bar[XB_TMO])) break; if (sp > XB_SPIN_CAP) { atomicAdd(&bar[XB_TMO], 1u); break; } }
    }
    nloc = mine > 0u ? mine : 1u; nx = cnt > 0u ? cnt : 1u;
}
__device__ __forceinline__ void xcd_barrier(const XcdBarrier& b) {
    asm volatile("s_waitcnt vmcnt(0)" ::: "memory");
    __syncthreads();
    if (threadIdx.x == 0) {
        unsigned* bar = b.bar;
        __builtin_amdgcn_s_waitcnt(0);
        unsigned nloc = b.st[0], nx = b.st[1];
        if (nloc == 0u) { xcd_barrier_complete(bar, b.x, nloc, nx); b.st[0] = nloc; b.st[1] = nx; }
        const unsigned old = xb_add(&bar[XB_XSUB(b.x)], 1u);
        const unsigned gen = old / nloc;
        if (old + 1u == (gen + 1u) * nloc) {
            __builtin_amdgcn_fence(__ATOMIC_RELEASE, "agent");
            asm volatile("s_waitcnt vmcnt(0)" ::: "memory");
            const unsigned og = xb_add(&bar[XB_TOP], 1u);
            const unsigned tg = og / nx;
            if (og + 1u == (tg + 1u) * nx) xb_add(&bar[XB_TOPGEN], 1u);
            else XB_SPIN(xb_ld(&bar[XB_TOPGEN]) == tg, bar);
            __builtin_amdgcn_fence(__ATOMIC_ACQUIRE, "agent");
            xb_add(&bar[XB_XGEN(b.x)], 1u);
            asm volatile("s_waitcnt vmcnt(0)" ::: "memory");
        } else {
            XB_SPIN(xb_ld(&bar[XB_XGEN(b.x)]) == gen, bar);
            __builtin_amdgcn_fence(__ATOMIC_ACQUIRE, "agent");
            asm volatile("s_waitcnt vmcnt(0)" ::: "memory");
        }
    }
    __syncthreads();
}

constexpr int RING_BYTES = 131072, LDSCTL_OFF = RING_BYTES, MISC_OFF = LDSCTL_OFF + 320, LDS_BYTES = 147456;
struct Args { const float* in[39]; float* out; unsigned char* ws; int ph_lo, ph_hi; };
enum { I_X = 0, I_C, I_CTX, I_CCTX, I_ADAW, I_ADAB, I_N1G, I_N2G, I_ABWIN, I_ABWOUT, I_MU, I_W0, I_W2, I_A0, I_A2, I_KK, I_KA, I_RK, I_G2, I_LNW, I_LNB,
       I_GQA_, I_WQUP, I_GKVA, I_WKVUP, I_MGQ, I_MGK, I_GWIN, I_GWOUT, I_GGQ, I_GGK, I_RW, I_RBIAS, I_MGATE, I_MUP, I_MDOWN, I_SGATE, I_SUP, I_SDOWN };

struct Ctx {
    LAS unsigned char* lds; int tid, lane, wave, G, bid;
    unsigned char* ws; float* out;
};
__device__ __forceinline__ bool row_is_ctx(int m) { return (m % RB) < CTXL; }
__device__ __forceinline__ float* xl_row(const Ctx& F, int m) {
    const int b = m / RB, j = m % RB;
    return j < CTXL ? (float*)(F.ws + WS_XLC) + (size_t)(b * CTXL + j) * DM : F.out + (size_t)(b * SEQ + j - CTXL) * DM;
}

__device__ __forceinline__ void tr_item(const float* W, int ldn, int k0, int n0, bf16_t* dst, int ldw, LAS float* scr, int lane) {
#pragma unroll 8
    for (int i = 0; i < 32; ++i) { const int kk = 2 * i + (lane >> 5); scr[kk * 33 + (lane & 31)] = W[(size_t)(k0 + kk) * ldn + n0 + (lane & 31)]; }
    LDS_WAIT(); asm volatile("" ::: "memory");
    const int c = lane & 7;
#pragma unroll
    for (int j = 0; j < 4; ++j) { const int n = (lane >> 3) + 8 * j; const LAS float* s = scr + (8 * c) * 33 + n;
        u32x4 o; o.x = pk2(s[0 * 33], s[1 * 33]); o.y = pk2(s[2 * 33], s[3 * 33]); o.z = pk2(s[4 * 33], s[5 * 33]); o.w = pk2(s[6 * 33], s[7 * 33]);
        *(u32x4*)(dst + (size_t)n * ldw + 8 * c) = o; }
    LDS_WAIT(); asm volatile("" ::: "memory");
}
__device__ __forceinline__ void tr_matrix_item(const float* W, int K, int N, bf16_t* dst, int ldw, LAS float* scr, int item, int lane) {
    const int nblk = N / 32, kb = item / nblk, nb = item % nblk;
    tr_item(W, N, 64 * kb, 32 * nb, dst + (size_t)(32 * nb) * ldw + 64 * kb, ldw, scr, lane);
}

__device__ __forceinline__ void norm_mod_row(const float* xrow, const float* g, const float* sh, const float* sc, bf16_t* orow, int lane, f32x4 (&hv)[4]) {
    const f32x4* xr = (const f32x4*)xrow + lane;
    f32x4 v[4]; float s = 0.f;
#pragma unroll
    for (int j = 0; j < 4; ++j) { v[j] = xr[64 * j]; s += (v[j].x * v[j].x + v[j].y * v[j].y) + (v[j].z * v[j].z + v[j].w * v[j].w); }
    const float rstd = 1.f / sqrtf(wave_sum(s) * (1.f / DM) + 1e-6f);
    unsigned long long* o8 = (unsigned long long*)orow + lane;
#pragma unroll
    for (int j = 0; j < 4; ++j) { const f32x4 gg = ((const f32x4*)g)[lane + 64 * j], s1 = ((const f32x4*)sc)[lane + 64 * j], s0 = ((const f32x4*)sh)[lane + 64 * j];
        f32x4 h = (v[j] * rstd * gg) * (s1 + 1.f) + s0; hv[j] = h;
        o8[64 * j] = (unsigned long long)pk2(h.x, h.y) | ((unsigned long long)pk2(h.z, h.w) << 32); }
}

struct SchedDense {
    int nM, nN, G, c; const char* A; const char* B; char* O; size_t a_tile, b_tile, o_tile; int latent_only;
    __device__ __forceinline__ bool next(int i, g8::Unit& u) const {
        int pm, pn; if (!g8::tile_order(i, G, c, nM, nN, pm, pn)) return false;
        if (latent_only) pm = pm + 1 + pm / 32;
        u.a = A + (size_t)pm * a_tile; u.b = B + (size_t)pn * b_tile; u.o = O + (size_t)pm * o_tile; u.pn = pn; u.aux = 0; u.f0 = nullptr; return true;
    }
};
struct SchedRes {
    int nM, nN, G, c; const char* A; const char* B; size_t a_tile, b_tile; int latent_only;
    const float* base_l; const float* base_c; float* out_l; float* out_c;
    __device__ __forceinline__ bool next(int i, g8::Unit& u) const {
        int pm, pn; if (!g8::tile_order(i, G, c, nM, nN, pm, pn)) return false;
        if (latent_only) pm = pm + 1 + pm / 32;
        const int b = pm / 33, t = pm % 33;
        u.a = A + (size_t)pm * a_tile; u.b = B + (size_t)pn * b_tile; u.pn = pn;
        if (t == 0) { u.f0 = base_c + (size_t)(b * CTXL) * DM; u.o = (char*)(out_c + (size_t)(b * CTXL) * DM); u.aux = 2; }
        else { const size_t r0 = (size_t)(b * SEQ + (t - 1) * 256) * DM; u.f0 = base_l + r0; u.o = (char*)(out_l + r0); u.aux = b; }
        return true;
    }
};
struct SchedMoe {
    volatile LAS unsigned* tab;
    const char* HS; const char* HSH; size_t a_tile;
    const char* W; size_t w_exp, w_tile;
    char* O; char* OSH; size_t o_tile;
    const float* rowwt;
    __device__ __forceinline__ bool next(int i, g8::Unit& u) const {
        const int n = __builtin_amdgcn_readfirstlane((int)tab[0]); if (i >= n) return false;
        const unsigned w0 = (unsigned)__builtin_amdgcn_readfirstlane((int)tab[1 + 2 * i]), e = (unsigned)__builtin_amdgcn_readfirstlane((int)tab[2 + 2 * i]);
        const unsigned tile = w0 & 0xffffu, pn = (w0 >> 16) & 0xffu; const bool sh = (w0 >> 31) != 0u;
        u.pn = (int)pn; u.aux = 0;
        u.a = (sh ? HSH : HS) + (size_t)tile * a_tile; u.b = W + (size_t)e * w_exp + (size_t)pn * w_tile; u.o = (sh ? OSH : O) + (size_t)tile * o_tile;
        u.f0 = (sh || !rowwt) ? nullptr : rowwt + (size_t)tile * 256;
        return true;
    }
};
__device__ __forceinline__ void moe_units(volatile LAS unsigned* tab, const unsigned* cnt, int G, int c, int npn, int n_sh, int latent_only) {
    int ts[NE + 1]; int tot = 0;
    for (int e = 0; e < NE; ++e) { ts[e] = tot; tot += (int)((cnt[e * 64] + 255u) >> 8); }
    ts[NE] = tot;
    const int total = (tot + n_sh) * npn; int n = 0;
    for (int i = 0; i < 16; ++i) { const int L = i * G + c; if (L >= total) break;
        const int tile = L / npn, pn = L % npn;
        if (tile < tot) { int e = 0; for (int q = 1; q < NE; ++q) e += (tile >= ts[q]) ? 1 : 0; tab[1 + 2 * n] = (unsigned)tile | ((unsigned)pn << 16); tab[2 + 2 * n] = (unsigned)e; }
        else { const int t2 = tile - tot, pm = latent_only ? t2 + 1 + t2 / 32 : t2; tab[1 + 2 * n] = (unsigned)pm | ((unsigned)pn << 16) | 0x80000000u; tab[2 + 2 * n] = (unsigned)NE; }
        ++n; }
    tab[0] = (unsigned)n;
}

#define IN(k) (lo <= (k) && (k) < hi)
#define SEAM(k) do { if (N_LAUNCH_MODE == 1 && IN((k) + 1)) xcd_barrier(bar); } while (0)
template <int L>
__device__ __forceinline__ void moe_block(const Args& args, const Ctx& F, const XcdBarrier& bar, const int lo, const int hi) {
    const int gw = F.bid * NWAVES + F.wave, NGW = F.G * NWAVES, lane = F.lane, tid = F.tid;
    unsigned char* ws = F.ws; unsigned* ctl = (unsigned*)(ws + WS_CTL); float* MODS = (float*)(ws + SM_MODS);
    volatile LAS unsigned* MISC = (volatile LAS unsigned*)(F.lds + MISC_OFF);
    constexpr int l = L, pb = L == 0 ? 9 : 18, NROW = L == 0 ? T : 2 * SEQ;
    unsigned* cnt = ctl + CW_CNT + l * 1024;
    bf16_t* MW1 = (bf16_t*)(ws + WS_B); bf16_t* MW2 = MW1 + (size_t)17 * 512 * 1024;
    if (CT(9) && IN(pb + 0)) {
        LAS float* rwT = (LAS float*)F.lds;
        for (int i = tid; i < 16384; i += NTHR) { const int k = i >> 4, e = i & 15; rwT[e * 1024 + k] = args.in[I_RW][i]; }
        __syncthreads();
        bf16_t* H = (bf16_t*)(ws + WS_A); int* SEL = (int*)(ws + SM_SEL); float* WTS = (float*)(ws + SM_WTS);
        const float rbias_l = lane < 16 ? args.in[I_RBIAS][lane] : 0.f;
        for (int r = gw; r < NROW; r += NGW) { const int m = l == 0 ? r : (r / SEQ) * RB + CTXL + r % SEQ; const int b = m / RB; const bool cx = (m % RB) < CTXL;
            const float* md = MODS + (l * 3 + (cx ? 2 : b)) * 6144; f32x4 hv[4];
            norm_mod_row(xl_row(F, m), args.in[I_N2G] + l * 1024, md + 3 * 1024, md + 4 * 1024, H + (size_t)m * DM, lane, hv);
            float mylg = 0.f;
#pragma unroll 2
            for (int e = 0; e < 16; ++e) { float a = 0.f;
#pragma unroll
                for (int j = 0; j < 4; ++j) { const f32x4 w = *(const LAS f32x4*)(rwT + e * 1024 + 4 * lane + 256 * j); a += hv[j].x * w.x + hv[j].y * w.y + hv[j].z * w.z + hv[j].w * w.w; }
                a = wave_sum(a); mylg = lane == e ? a : mylg; }
            const float mysc = 1.f / (1.f + __expf(-mylg)), mybs = mysc + rbias_l;
            float sc[16], bs[16];
#pragma unroll
            for (int e = 0; e < 16; ++e) { sc[e] = __int_as_float(__builtin_amdgcn_readlane(__float_as_int(mysc), e)); bs[e] = __int_as_float(__builtin_amdgcn_readlane(__float_as_int(mybs), e)); }
            int grp = 0; float best = -1e30f;
#pragma unroll
            for (int g = 0; g < 4; ++g) { float m1 = -1e30f, m2 = -1e30f;
#pragma unroll
                for (int q = 0; q < 4; ++q) { const float v = bs[g * 4 + q]; if (v > m1) { m2 = m1; m1 = v; } else if (v > m2) m2 = v; }
                const float gs = m1 + m2; if (gs > best) { best = gs; grp = g; } }
            float v4[4], s4[4];
#pragma unroll
            for (int q = 0; q < 4; ++q) { v4[q] = grp == 0 ? bs[q] : grp == 1 ? bs[4 + q] : grp == 2 ? bs[8 + q] : bs[12 + q]; s4[q] = grp == 0 ? sc[q] : grp == 1 ? sc[4 + q] : grp == 2 ? sc[8 + q] : sc[12 + q]; }
            int i0 = 0; float bv0 = v4[0];
#pragma unroll
            for (int q = 1; q < 4; ++q) if (v4[q] > bv0) { bv0 = v4[q]; i0 = q; }
            int i1 = -1; float bv1 = -1e30f;
#pragma unroll
            for (int q = 0; q < 4; ++q) if (q != i0 && v4[q] > bv1) { bv1 = v4[q]; i1 = q; }
            float w0 = 0.f, w1 = 0.f;
#pragma unroll
            for (int q = 0; q < 4; ++q) { w0 = q == i0 ? s4[q] : w0; w1 = q == i1 ? s4[q] : w1; }
            const float ws_ = 1.f / (w0 + w1);
            if (lane == 0) { const int e0 = grp * 4 + i0, e1 = grp * 4 + i1;
                const int s0 = (int)atomicAdd(cnt + e0 * 64, 1u), s1 = (int)atomicAdd(cnt + e1 * 64, 1u);
                *(int4*)(SEL + (size_t)m * 4) = make_int4(e0, s0, e1, s1); *(float2*)(WTS + (size_t)m * 2) = make_float2(w0 * ws_, w1 * ws_); }
        }
        __syncthreads();
        LAS float* scr = (LAS float*)(F.lds + F.wave * 12288);
        for (int it = gw; it < 17 * 384; it += NGW) { const int e = it / 384, r = it % 384;
            if (r < 256) { const int isup = r >> 7, rr = r & 127, kb = rr >> 3, nb = rr & 7;
                const float* W = e < 16 ? (isup ? args.in[I_MUP] : args.in[I_MGATE]) + ((size_t)l * 16 + e) * 1024 * 256 : (isup ? args.in[I_SUP] : args.in[I_SGATE]) + (size_t)l * 1024 * 256;
                const int f0 = nb * 32, drow = (f0 >> 7) * 256 + isup * 128 + (f0 & 127);
                tr_item(W, 256, kb * 64, f0, MW1 + (size_t)e * 512 * 1024 + (size_t)drow * 1024 + kb * 64, 1024, scr, lane); }
            else { const int rr = r - 256, kb = rr >> 5, nb = rr & 31;
                const float* W = e < 16 ? args.in[I_MDOWN] + ((size_t)l * 16 + e) * 256 * 1024 : args.in[I_SDOWN] + (size_t)l * 256 * 1024;
                tr_item(W, 1024, kb * 64, nb * 32, MW2 + (size_t)e * 1024 * 256 + (size_t)(nb * 32) * 256 + kb * 64, 256, scr, lane); } }
        SEAM(pb + 0);
    }
    if (CT(10) && IN(pb + 1)) {
        const bf16_t* H = (const bf16_t*)(ws + WS_A); bf16_t* HSb = (bf16_t*)(ws + WS_C); const int* SEL = (const int*)(ws + SM_SEL); const float* WTS = (const float*)(ws + SM_WTS);
        int* POS = (int*)(ws + SM_POS); float* ROWWT = (float*)(ws + SM_ROWWT);
        int seg[16]; { int tot = 0;
#pragma unroll
            for (int e = 0; e < 16; ++e) { seg[e] = tot; tot += (int)((cnt[e * 64] + 255u) & ~255u); } }
        for (int r = gw; r < NROW; r += NGW) { const int m = l == 0 ? r : (r / SEQ) * RB + CTXL + r % SEQ;
            const int4 s = *(const int4*)(SEL + (size_t)m * 4); const float2 w = *(const float2*)(WTS + (size_t)m * 2);
            int d0 = 0, d1 = 0;
#pragma unroll
            for (int e = 0; e < 16; ++e) { d0 = s.x == e ? seg[e] : d0; d1 = s.z == e ? seg[e] : d1; }
            d0 += s.y; d1 += s.w;
            const u32x4* src = (const u32x4*)(H + (size_t)m * DM) + lane; u32x4* p0 = (u32x4*)(HSb + (size_t)d0 * DM) + lane; u32x4* p1 = (u32x4*)(HSb + (size_t)d1 * DM) + lane;
            const u32x4 a = src[0], c = src[64]; p0[0] = a; p0[64] = c; p1[0] = a; p1[64] = c;
            if (lane == 0) { POS[(size_t)m * 2] = d0; POS[(size_t)m * 2 + 1] = d1; ROWWT[d0] = w.x; ROWWT[d1] = w.y; } }
        SEAM(pb + 1);
    }
    if (CT(11) && IN(pb + 2)) {
        if (tid == 0) moe_units(MISC + 16, cnt, F.G, F.bid, 2, l == 0 ? 66 : 64, l);
        __syncthreads();
        SchedMoe S{MISC + 16, (const char*)(ws + WS_C), (const char*)(ws + WS_A), (size_t)256 * 1024 * 2,
                   (const char*)MW1, (size_t)512 * 1024 * 2, (size_t)256 * 1024 * 2, (char*)(ws + WS_ACT), (char*)(ws + WS_ACT) + (size_t)HS_ROWS * 512, (size_t)256 * 512, (const float*)(ws + SM_ROWWT)};
        g8::EpiSwiGLU E{};
        g8::gemm_phase(F.lds, 1024, S, E);
        SEAM(pb + 2);
    }
    if (CT(12) && IN(pb + 3)) {
        if (tid == 0) moe_units(MISC + 16, cnt, F.G, F.bid, 4, l == 0 ? 66 : 64, l);
        __syncthreads();
        SchedMoe S{MISC + 16, (const char*)(ws + WS_ACT), (const char*)(ws + WS_ACT) + (size_t)HS_ROWS * 512, (size_t)256 * 256 * 2,
                   (const char*)MW2, (size_t)1024 * 256 * 2, (size_t)256 * 256 * 2, (char*)(ws + WS_C), (char*)(ws + WS_A), (size_t)256 * 1024 * 2, nullptr};
        g8::EpiStoreBf16 E{1024, nullptr, 0};
        g8::gemm_phase(F.lds, 256, S, E);
        SEAM(pb + 3);
    }
    if (CT(13) && IN(pb + 4)) {
        const bf16_t* YS = (const bf16_t*)(ws + WS_C); bf16_t* YSH = (bf16_t*)(ws + WS_A); const int* POS = (const int*)(ws + SM_POS);
        for (int r = gw; r < NROW; r += NGW) { const int m = l == 0 ? r : (r / SEQ) * RB + CTXL + r % SEQ; const int b = m / RB; const bool cx = (m % RB) < CTXL;
            const float* ga2 = MODS + (l * 3 + (cx ? 2 : b)) * 6144 + 5 * 1024;
            const int d0 = POS[(size_t)m * 2], d1 = POS[(size_t)m * 2 + 1];
            float* xr = xl_row(F, m);
            const u32x2* y0 = (const u32x2*)(YS + (size_t)d0 * DM) + lane; const u32x2* y1 = (const u32x2*)(YS + (size_t)d1 * DM) + lane; const u32x2* y2 = (const u32x2*)(YSH + (size_t)m * DM) + lane;
            f32x4 v[4]; float ss = 0.f;
#pragma unroll
            for (int j = 0; j < 4; ++j) { const u32x2 a = y0[64 * j], c = y1[64 * j], d = y2[64 * j]; const f32x4 g = ((const f32x4*)ga2)[lane + 64 * j]; f32x4 x = ((const f32x4*)xr)[lane + 64 * j];
                x.x += g.x * (lo2f(a.x) + lo2f(c.x) + lo2f(d.x)); x.y += g.y * (hi2f(a.x) + hi2f(c.x) + hi2f(d.x)); x.z += g.z * (lo2f(a.y) + lo2f(c.y) + lo2f(d.y)); x.w += g.w * (hi2f(a.y) + hi2f(c.y) + hi2f(d.y));
                ((f32x4*)xr)[lane + 64 * j] = x; v[j] = x; ss += (x.x * x.x + x.y * x.y) + (x.z * x.z + x.w * x.w); }
            if (l == 0) { const float rstd = 1.f / sqrtf(wave_sum(ss) * (1.f / DM) + 1e-6f); const float* md = MODS + (1 * 3 + (cx ? 2 : b)) * 6144; const float* g1 = args.in[I_N1G] + 1024;
                unsigned long long* o8 = (unsigned long long*)(YSH + (size_t)m * DM) + lane;
#pragma unroll
                for (int j = 0; j < 4; ++j) { const f32x4 gg = ((const f32x4*)g1)[lane + 64 * j], s1 = ((const f32x4*)(md + 1024))[lane + 64 * j], s0 = ((const f32x4*)md)[lane + 64 * j];
                    const f32x4 h = (v[j] * rstd * gg) * (s1 + 1.f) + s0; o8[64 * j] = (unsigned long long)pk2(h.x, h.y) | ((unsigned long long)pk2(h.z, h.w) << 32); } }
        }
        SEAM(pb + 4);
    }
}

__global__ void __launch_bounds__(NTHR, 2) fwd_kernel(Args args) {
    extern __shared__ __attribute__((aligned(16))) unsigned char lds_raw[];
    Ctx F; F.lds = (LAS unsigned char*)lds_raw; F.tid = threadIdx.x; F.lane = F.tid & 63; F.wave = __builtin_amdgcn_readfirstlane(F.tid >> 6);
    F.G = gridDim.x; F.bid = blockIdx.x; F.ws = args.ws; F.out = args.out;
    volatile LAS unsigned* MISC = (volatile LAS unsigned*)(F.lds + MISC_OFF);
    unsigned* ctl = (unsigned*)(F.ws + WS_CTL);
    for (int u = F.tid; u < (LDS_BYTES - LDSCTL_OFF) / 4; u += NTHR) ((LAS unsigned*)(F.lds + LDSCTL_OFF))[u] = 0u;
    __syncthreads();
    XcdBarrier bar; bar.bar = ctl + CW_BAR; bar.x = 0; bar.st = nullptr;
    if (N_LAUNCH_MODE == 1) bar = xcd_barrier_post(ctl + CW_BAR, MISC + 8);
    const int lo = args.ph_lo, hi = args.ph_hi;
    const int gw = F.bid * NWAVES + F.wave, NGW = F.G * NWAVES, lane = F.lane, tid = F.tid;
    unsigned char* ws = F.ws;
    float* MODS = (float*)(ws + SM_MODS);
    bf16_t* WD = (bf16_t*)(ws + WS_WD);

    if (CT(0) && IN(0)) {
        if (F.bid < 192) {
            LAS float* sl = (LAS float*)F.lds;
            for (int i = tid; i < 3072; i += NTHR) { const int v = i >> 10, k = i & 1023; const float x = v < 2 ? args.in[I_C][v * 1024 + k] : args.in[I_CCTX][k]; sl[i] = x * sigmoidf_(x); }
            __syncthreads();
            const int l = F.bid / 96, n0 = (F.bid % 96) * 64, ks = tid >> 6, nl = tid & 63;
            const float* W = args.in[I_ADAW] + (size_t)l * 1024 * 6144 + n0 + nl;
            float a0 = 0.f, a1 = 0.f, a2 = 0.f;
#pragma unroll 8
            for (int k = ks * 128; k < ks * 128 + 128; ++k) { const float w = W[(size_t)k * 6144]; a0 += sl[k] * w; a1 += sl[1024 + k] * w; a2 += sl[2048 + k] * w; }
            LAS float* part = sl + 3072;
            part[(ks * 3 + 0) * 64 + nl] = a0; part[(ks * 3 + 1) * 64 + nl] = a1; part[(ks * 3 + 2) * 64 + nl] = a2;
            __syncthreads();
            if (tid < 192) { const int v = tid >> 6, n = tid & 63; float s = args.in[I_ADAB][l * 6144 + n0 + n];
#pragma unroll
                for (int q = 0; q < 8; ++q) s += part[(q * 3 + v) * 64 + n];
                MODS[(l * 3 + v) * 6144 + n0 + n] = s; }
            __syncthreads();
        }
        if (F.bid == 192) { float* bz = (float*)(ws + SM_BIASZ);
            for (int i = tid; i < 2560; i += NTHR) bz[i] = i < 1024 ? args.in[I_W0][i] : (i < 2048 ? args.in[I_A0][i - 1024] : 0.f); }
        LAS float* scr = (LAS float*)(F.lds + 32768 + F.wave * 12288);
        constexpr int I1 = 16 * 81, I2 = 16 * 32, I3 = 16, I4 = 32, I5 = 6 * 24, I6 = 4 * 32, I7 = 16 * 48, I8 = 16 * 32;
        constexpr int NIT = I1 + I2 + 4 * I3 + I4 + I5 + I6 + I7 + I8;
        for (int it = gw; it < NIT; it += NGW) {
            int r = it;
            if (r < I1) { tr_matrix_item(args.in[I_ABWIN], 1024, 2592, WD + O_WIN0 / 2, 1024, scr, r, lane); continue; } r -= I1;
            if (r < I2) { tr_matrix_item(args.in[I_ABWOUT], 1024, 1024, WD + O_WOUT0 / 2, 1024, scr, r, lane); continue; } r -= I2;
            if (r < I3) { tr_matrix_item(args.in[I_W2], 64, 512, WD + O_WLORA / 2 + (size_t)0 * 384 + 0, 384, scr, r, lane); continue; } r -= I3;
            if (r < I3) { tr_matrix_item(args.in[I_W2] + 64 * 512, 64, 512, WD + O_WLORA / 2 + (size_t)512 * 384 + 64, 384, scr, r, lane); continue; } r -= I3;
            if (r < I3) { tr_matrix_item(args.in[I_A2], 64, 512, WD + O_WLORA / 2 + (size_t)1024 * 384 + 128, 384, scr, r, lane); continue; } r -= I3;
            if (r < I3) { tr_matrix_item(args.in[I_A2] + 64 * 512, 64, 512, WD + O_WLORA / 2 + (size_t)1536 * 384 + 192, 384, scr, r, lane); continue; } r -= I3;
            if (r < I4) { tr_matrix_item(args.in[I_G2], 128, 512, WD + O_WLORA / 2 + (size_t)2048 * 384 + 256, 384, scr, r, lane); continue; } r -= I4;
            if (r < I5) { tr_matrix_item(args.in[I_WQUP], 384, 768, WD + O_WQUP / 2, 384, scr, r, lane); continue; } r -= I5;
            if (r < I6) { tr_matrix_item(args.in[I_WKVUP], 256, 1024, WD + O_WKVUP / 2, 256, scr, r, lane); continue; } r -= I6;
            if (r < I7) { tr_matrix_item(args.in[I_GWIN], 1024, 1536, WD + O_WIN1 / 2, 1024, scr, r, lane); continue; } r -= I7;
            tr_matrix_item(args.in[I_GWOUT], 1024, 1024, WD + O_WOUT1 / 2, 1024, scr, r, lane);
        }
        { const int gt = F.bid * NTHR + tid, NGT = F.G * NTHR; const u32x4 z = {0u, 0u, 0u, 0u};
          for (int i = gt; i < 224 * 128; i += NGT) *(u32x4*)(WD + O_WIN0 / 2 + (size_t)2592 * 1024 + (size_t)i * 8) = z;
          for (int i = gt; i < 2560 * 48; i += NGT) { const int n = i / 48, ch = i % 48, blk = n >> 9; const int klo = blk < 4 ? blk * 64 : 256, khi = blk < 4 ? klo + 64 : 384;
              if (ch * 8 < klo || ch * 8 >= khi) *(u32x4*)(WD + O_WLORA / 2 + (size_t)n * 384 + ch * 8) = z; } }
        SEAM(0);
    }

    if (CT(1) && IN(1)) {
        bf16_t* H = (bf16_t*)(ws + WS_A);
        for (int m = gw; m < T; m += NGW) { const int b = m / RB, j = m % RB; const bool cx = j < CTXL;
            const float* xr = cx ? args.in[I_CTX] + (size_t)(b * CTXL + j) * DM : args.in[I_X] + (size_t)(b * SEQ + j - CTXL) * DM;
            const float* md = MODS + (0 * 3 + (cx ? 2 : b)) * 6144; f32x4 hv[4];
            norm_mod_row(xr, args.in[I_N1G], md, md + 1024, H + (size_t)m * DM, lane, hv); }
        SEAM(1);
    }
    if (CT(2) && IN(2)) {
        SchedDense S{66, 11, F.G, F.bid, (const char*)(ws + WS_A), (const char*)(WD + O_WIN0 / 2), (char*)(ws + WS_C), (size_t)256 * 1024 * 2, (size_t)256 * 1024 * 2, (size_t)256 * 2816 * 2, 0};
        g8::EpiStoreBf16 E{2816, nullptr, 0};
        g8::gemm_phase(F.lds, 1024, S, E);
        SEAM(2);
    }
    if (CT(3) && IN(3)) {
        const bf16_t* P = (const bf16_t*)(ws + WS_C);
        bf16_t* Rb = (bf16_t*)(ws + WS_B); bf16_t* Kb = Rb + (size_t)T * 512; bf16_t* Vb = Kb + (size_t)T * 512;
        bf16_t* LIN = (bf16_t*)(ws + WS_A); bf16_t* QAN = LIN + (size_t)T * 384; bf16_t* KVAN = QAN + (size_t)T * 384;
        float* KROPE = (float*)(ws + WS_KROPE);
        const float* mu = args.in[I_MU];
        for (int m = gw; m < T; m += NGW) { const int j = m % RB;
            const bool hasp = !(j == 0 || j == CTXL), hasn = !(j == CTXL - 1 || j == RB - 1);
            const bf16_t* pr = P + (size_t)m * 2816;
#pragma unroll 1
            for (int ch = lane; ch < 240; ch += 64) {
                const u32x4 pc = *(const u32x4*)(pr + ch * 8);
                u32x4 pp = {0u, 0u, 0u, 0u}, pn = {0u, 0u, 0u, 0u};
                if (hasp) pp = *(const u32x4*)(pr - 2816 + ch * 8);
                if (hasn) pn = *(const u32x4*)(pr + 2816 + ch * 8);
                const f32x4 m0 = *(const f32x4*)(mu + ch * 8), m1 = *(const f32x4*)(mu + ch * 8 + 4);
                float o[8];
#pragma unroll
                for (int q = 0; q < 4; ++q) { const unsigned c = pc[q], a = pp[q], n = pn[q];
                    const float c0 = lo2f(c), c1 = hi2f(c), mm0 = q < 2 ? m0[2 * q] : m1[2 * q - 4], mm1 = q < 2 ? m0[2 * q + 1] : m1[2 * q - 3];
                    o[2 * q] = c0 + mm0 * (0.5f * (lo2f(a) + lo2f(n)) - c0); o[2 * q + 1] = c1 + mm1 * (0.5f * (hi2f(a) + hi2f(n)) - c1); }
                bf16_t* dst;
                if (ch < 64) dst = Rb + (size_t)m * 512 + ch * 8;
                else if (ch < 128) dst = Kb + (size_t)m * 512 + (ch - 64) * 8;
                else if (ch < 192) dst = Vb + (size_t)m * 512 + (ch - 128) * 8;
                else { dst = LIN + (size_t)m * 384 + (ch - 192) * 8;
                    if (ch < 208) {
#pragma unroll
                        for (int q = 0; q < 8; ++q) { const float e = __expf(-2.f * fabsf(o[q])); const float th = (1.f - e) * __builtin_amdgcn_rcpf(1.f + e); o[q] = o[q] < 0.f ? -th : th; } }
                    else if (ch >= 224) {
#pragma unroll
                        for (int q = 0; q < 8; ++q) o[q] = sigmoidf_(o[q]); } }
                u32x4 w; w.x = pk2(o[0], o[1]); w.y = pk2(o[2], o[3]); w.z = pk2(o[4], o[5]); w.w = pk2(o[6], o[7]);
                *(u32x4*)dst = w;
            }
            { float q[8], ss = 0.f; const bool act = lane < 48;
              const u32x4 pc = act ? *(const u32x4*)(pr + 1920 + lane * 8) : (u32x4){0u, 0u, 0u, 0u};
#pragma unroll
              for (int i = 0; i < 4; ++i) { q[2 * i] = lo2f(pc[i]); q[2 * i + 1] = hi2f(pc[i]); ss += q[2 * i] * q[2 * i] + q[2 * i + 1] * q[2 * i + 1]; }
              const float rstd = 1.f / sqrtf(wave_sum(ss) * (1.f / 384.f) + 1e-6f);
              if (act) { const float* g = args.in[I_GQA_] + lane * 8; u32x4 w; w.x = pk2(q[0] * rstd * g[0], q[1] * rstd * g[1]); w.y = pk2(q[2] * rstd * g[2], q[3] * rstd * g[3]);
                  w.z = pk2(q[4] * rstd * g[4], q[5] * rstd * g[5]); w.w = pk2(q[6] * rstd * g[6], q[7] * rstd * g[7]); *(u32x4*)(QAN + (size_t)m * 384 + lane * 8) = w; } }
            { float q[8], ss = 0.f; const bool act = lane < 32;
              const u32x4 pc = act ? *(const u32x4*)(pr + 2304 + lane * 8) : (u32x4){0u, 0u, 0u, 0u};
#pragma unroll
              for (int i = 0; i < 4; ++i) { q[2 * i] = lo2f(pc[i]); q[2 * i + 1] = hi2f(pc[i]); ss += q[2 * i] * q[2 * i] + q[2 * i + 1] * q[2 * i + 1]; }
              const float rstd = 1.f / sqrtf(wave_sum(ss) * (1.f / 256.f) + 1e-6f);
              if (act) { const float* g = args.in[I_GKVA] + lane * 8; u32x4 w; w.x = pk2(q[0] * rstd * g[0], q[1] * rstd * g[1]); w.y = pk2(q[2] * rstd * g[2], q[3] * rstd * g[3]);
                  w.z = pk2(q[4] * rstd * g[4], q[5] * rstd * g[5]); w.w = pk2(q[6] * rstd * g[6], q[7] * rstd * g[7]); *(u32x4*)(KVAN + (size_t)m * 256 + lane * 8) = w; } }
            if (lane < 32) KROPE[(size_t)m * 32 + lane] = bf2f(pr[2560 + lane]);
        }
        SEAM(3);
    }
    if (CT(4) && IN(4)) {
        { SchedDense S{66, 10, F.G, F.bid, (const char*)(ws + WS_A), (const char*)(WD + O_WLORA / 2), (char*)(ws + WS_C), (size_t)256 * 384 * 2, (size_t)256 * 384 * 2, (size_t)256 * 2560 * 2, 0};
          g8::EpiStoreBf16 E{2560, (const float*)(ws + SM_BIASZ), 2048};
          g8::gemm_phase(F.lds, 384, S, E); }
        { SchedDense S{66, 3, F.G, F.bid, (const char*)(ws + WS_A + SZ384), (const char*)(WD + O_WQUP / 2), (char*)(ws + WS_D), (size_t)256 * 384 * 2, (size_t)256 * 384 * 2, (size_t)256 * 768 * 2, 0};
          g8::EpiStoreBf16 E{768, nullptr, 0};
          g8::gemm_phase(F.lds, 384, S, E); }
        { SchedDense S{66, 4, F.G, F.bid, (const char*)(ws + WS_A + 2 * SZ384), (const char*)(WD + O_WKVUP / 2), (char*)(ws + WS_D + SZ768), (size_t)256 * 256 * 2, (size_t)256 * 256 * 2, (size_t)256 * 1024 * 2, 0};
          g8::EpiStoreBf16 E{1024, nullptr, 0};
          g8::gemm_phase(F.lds, 256, S, E); }
        SEAM(4);
    }
    if (CT(5) && IN(5)) {
        const bf16_t* QRAW = (const bf16_t*)(ws + WS_D); const bf16_t* KVRAW = (const bf16_t*)(ws + WS_D + SZ768); const float* KROPE = (const float*)(ws + WS_KROPE);
        bf16_t* Qm = (bf16_t*)F.out; bf16_t* Km = Qm + (size_t)T * 768; bf16_t* Vm = (bf16_t*)(ws + WS_A);
        const int h = lane >> 3, s = lane & 7;
        const float inv = __powf(10000.f, -(float)s * 0.125f);
        float gq[12], gk[12];
#pragma unroll
        for (int i = 0; i < 12; ++i) { gq[i] = args.in[I_MGQ][s + 8 * i]; gk[i] = args.in[I_MGK][s + 8 * i]; }
        for (int m = gw; m < T; m += NGW) { const int j = m % RB; const bool lat = j >= CTXL;
            float cr = 1.f, sr = 0.f, cc = 1.f, sc = 0.f;
            if (lat) { const int sp = j - CTXL; const float pr_ = (float)(sp >> 6), pc_ = (float)(sp & 63); sincosf(pr_ * inv, &sr, &cr); sincosf(pc_ * inv, &sc, &cc); }
            float q[12], k[12], ssq = 0.f, ssk = 0.f;
#pragma unroll
            for (int i = 0; i < 12; ++i) { q[i] = bf2f(QRAW[(size_t)m * 768 + h * 96 + s + 8 * i]); ssq += q[i] * q[i]; }
#pragma unroll
            for (int i = 0; i < 8; ++i) k[i] = bf2f(KVRAW[(size_t)m * 1024 + h * 128 + s + 8 * i]);
#pragma unroll
            for (int i = 8; i < 12; ++i) k[i] = KROPE[(size_t)m * 32 + s + 8 * (i - 8)];
#pragma unroll
            for (int i = 0; i < 12; ++i) ssk += k[i] * k[i];
            ssq += __shfl_xor(ssq, 1); ssq += __shfl_xor(ssq, 2); ssq += __shfl_xor(ssq, 4);
            ssk += __shfl_xor(ssk, 1); ssk += __shfl_xor(ssk, 2); ssk += __shfl_xor(ssk, 4);
            const float rq = 1.f / sqrtf(ssq * (1.f / 96.f) + 1e-6f), rk = 1.f / sqrtf(ssk * (1.f / 96.f) + 1e-6f);
#pragma unroll
            for (int i = 0; i < 12; ++i) { q[i] = q[i] * rq * gq[i]; k[i] = k[i] * rk * gk[i]; }
            { const float a = q[8], b2 = q[9]; q[8] = a * cr - b2 * sr; q[9] = b2 * cr + a * sr; const float c = q[10], d = q[11]; q[10] = c * cc - d * sc; q[11] = d * cc + c * sc; }
            { const float a = k[8], b2 = k[9]; k[8] = a * cr - b2 * sr; k[9] = b2 * cr + a * sr; const float c = k[10], d = k[11]; k[10] = c * cc - d * sc; k[11] = d * cc + c * sc; }
#pragma unroll
            for (int i = 0; i < 12; ++i) { Qm[(size_t)m * 768 + h * 96 + s + 8 * i] = (bf16_t)(pk2(q[i] * C2_MLA, 0.f) & 0xffffu); Km[(size_t)m * 768 + h * 96 + s + 8 * i] = (bf16_t)(pk2(k[i], 0.f) & 0xffffu); }
#pragma unroll
            for (int i = 0; i < 8; ++i) Vm[(size_t)m * 512 + h * 64 + s + 8 * i] = KVRAW[(size_t)m * 1024 + h * 128 + 64 + s + 8 * i];
        }
        SEAM(5);
    }
    if (CT(6) && IN(6)) {
        unsigned* queue = ctl + CW_QUEUE;
        if (F.bid < 64) {
            const int sid = F.bid, b = sid >> 5, h = (sid >> 2) & 7, dir = (sid >> 1) & 1, half = sid & 1;
            const bf16_t* Rb = (const bf16_t*)(ws + WS_B); const bf16_t* Kb = Rb + (size_t)T * 512; const bf16_t* Vb = Kb + (size_t)T * 512; const bf16_t* ZZ = (const bf16_t*)(ws + WS_C);
            bf16_t* Y = dir == 0 ? (bf16_t*)(ws + WS_A + SZ512) : (bf16_t*)(ws + WS_YB);
            LAS float* OPS = (LAS float*)F.lds;
            LAS float* VV = OPS + 2 * 32 * 320;
            LAS float* BK = VV + 2 * 32 * 64;
            LAS float* YB = BK + 2 * 32 * 2;
            const int tok = tid >> 4, cgs = tid & 15;
            const int wv = F.wave, r4 = lane >> 4, cg = lane & 15, rloc = wv * 4 + r4, irow = half * 32 + rloc;
            float kkp[4], kap[4];
#pragma unroll
            for (int i = 0; i < 4; ++i) { kkp[i] = args.in[I_KK][h * 64 + 4 * cgs + i]; kap[i] = args.in[I_KA][h * 64 + 4 * cgs + i]; }
            u32x2 g_r, g_k, g_v, g_s, g_a;
#define SC_ROW(s_) (b * RB + (dir == 0 ? (s_) : ((s_) < CTXL ? CTXL - 1 - (s_) : RB + CTXL - 1 - (s_))))
#define SC_LOAD(c_) do { const int m_ = SC_ROW((c_) * 32 + tok); const size_t o5 = (size_t)m_ * 512 + h * 64 + 4 * cgs, oz = (size_t)m_ * 2560 + dir * 512 + h * 64 + 4 * cgs; \
        g_r = *(const u32x2*)(Rb + o5); g_k = *(const u32x2*)(Kb + o5); g_v = *(const u32x2*)(Vb + o5); g_s = *(const u32x2*)(ZZ + oz); g_a = *(const u32x2*)(ZZ + oz + 1024); } while (0)
#define SC_WRITE(bf_) do { float r_[4] = {lo2f(g_r.x), hi2f(g_r.x), lo2f(g_r.y), hi2f(g_r.y)}, k_[4] = {lo2f(g_k.x), hi2f(g_k.x), lo2f(g_k.y), hi2f(g_k.y)}, v_[4] = {lo2f(g_v.x), hi2f(g_v.x), lo2f(g_v.y), hi2f(g_v.y)}; \
        float s_[4] = {lo2f(g_s.x), hi2f(g_s.x), lo2f(g_s.y), hi2f(g_s.y)}, a_[4] = {lo2f(g_a.x), hi2f(g_a.x), lo2f(g_a.y), hi2f(g_a.y)}; \
        float ku[4], ss = 0.f; _Pragma("unroll") for (int i = 0; i < 4; ++i) { ku[i] = k_[i] * kkp[i]; ss += ku[i] * ku[i]; } \
        ss = rowsum16(ss); const float inv_ = 1.f / sqrtf(ss + 1e-12f); \
        f32x4 oa, ow, ob, okd, owr; float br_ = 0.f, kr_ = 0.f; \
        _Pragma("unroll") for (int i = 0; i < 4; ++i) { const float kn = ku[i] * inv_, w_ = __expf(-0.6065306597126334f * s_[i]), bb = kn * a_[i], kd = k_[i] * (1.f + (a_[i] - 1.f) * kap[i]); \
            oa[i] = -kn; ow[i] = w_; ob[i] = bb; okd[i] = kd; owr[i] = w_ * r_[i]; br_ += bb * r_[i]; kr_ += kd * r_[i]; } \
        br_ = rowsum16(br_); kr_ = rowsum16(kr_); \
        LAS float* op_ = OPS + ((bf_) * 32 + tok) * 320 + 4 * cgs; \
        *(LAS f32x4*)(op_) = oa; *(LAS f32x4*)(op_ + 64) = ow; *(LAS f32x4*)(op_ + 128) = ob; *(LAS f32x4*)(op_ + 192) = okd; *(LAS f32x4*)(op_ + 256) = owr; \
        *(LAS f32x4*)(VV + ((bf_) * 32 + tok) * 64 + 4 * cgs) = (f32x4){v_[0], v_[1], v_[2], v_[3]}; \
        if (cgs == 0) { BK[((bf_) * 32 + tok) * 2] = br_; BK[((bf_) * 32 + tok) * 2 + 1] = kr_; } } while (0)
            float S0 = 0.f, S1 = 0.f, S2 = 0.f, S3 = 0.f;
            SC_LOAD(0); SC_WRITE(0); __syncthreads();
            constexpr int NCHUNK = RB / 32;
            for (int c = 0; c < NCHUNK; ++c) {
                const int bf = c & 1;
                if (c + 1 < NCHUNK) SC_LOAD(c + 1);
#pragma unroll 4
                for (int t = 0; t < 32; ++t) {
                    const LAS float* op = OPS + (bf * 32 + t) * 320 + 4 * cg;
                    const f32x4 a4 = *(const LAS f32x4*)(op), w4 = *(const LAS f32x4*)(op + 64), b4 = *(const LAS f32x4*)(op + 128), k4 = *(const LAS f32x4*)(op + 192), wr4 = *(const LAS f32x4*)(op + 256);
                    const float v = VV[(bf * 32 + t) * 64 + irow]; const f32x2 bk = *(const LAS f32x2*)(BK + (bf * 32 + t) * 2);
                    float p = S0 * a4[0] + S1 * a4[1] + S2 * a4[2] + S3 * a4[3];
                    float q = S0 * wr4[0] + S1 * wr4[1] + S2 * wr4[2] + S3 * wr4[3];
                    p = rowsum16(p); q = rowsum16(q);
                    const float y = q + p * bk[0] + v * bk[1];
                    S0 = S0 * w4[0] + p * b4[0] + v * k4[0]; S1 = S1 * w4[1] + p * b4[1] + v * k4[1]; S2 = S2 * w4[2] + p * b4[2] + v * k4[2]; S3 = S3 * w4[3] + p * b4[3] + v * k4[3];
                    if (cg == 0) YB[t * 32 + rloc] = y;
                }
                __syncthreads();
                { const int t = tid >> 4, rp = (tid & 15) * 2; const int m_ = SC_ROW(c * 32 + t);
                  *(unsigned*)(Y + (size_t)m_ * 512 + h * 64 + half * 32 + rp) = pk2(YB[t * 32 + rp], YB[t * 32 + rp + 1]); }
                if (c + 1 < NCHUNK) SC_WRITE((c + 1) & 1);
                __syncthreads();
            }
#undef SC_ROW
#undef SC_LOAD
#undef SC_WRITE
        }
        { const bf16_t* Qm = (const bf16_t*)F.out; const bf16_t* Km = Qm + (size_t)T * 768; const bf16_t* Vm = (const bf16_t*)(ws + WS_A); bf16_t* CAT = (bf16_t*)(ws + WS_D);
          for (;;) {
              __syncthreads();
              if (tid == 0) MISC[0] = atomicAdd(queue, 1u);
              __syncthreads();
              const unsigned u = MISC[0];
              if (u >= 528u) break;
              const int bh = u < 512u ? (int)u / 32 : (int)u - 512, qb = u < 512u ? 1 + (int)u % 32 : 0, b = bh >> 3, h = bh & 7;
              const size_t m0 = (size_t)b * RB + (size_t)qb * 256, k0 = (size_t)b * RB;
              att::attn_unit<96>(Qm + m0 * 768 + h * 96, 768, Km + k0 * 768 + h * 96, 768, Vm + k0 * 512 + h * 64, 512, CAT + m0 * 1024 + 512 + h * 64, 1024, qb == 0 ? 4 : 132, (char*)lds_raw);
          } }
        SEAM(6);
    }
    if (CT(7) && IN(7)) {
        const bf16_t* Rb = (const bf16_t*)(ws + WS_B); const bf16_t* Kb = Rb + (size_t)T * 512; const bf16_t* Vb = Kb + (size_t)T * 512; const bf16_t* ZZ = (const bf16_t*)(ws + WS_C);
        const bf16_t* Yf = (const bf16_t*)(ws + WS_A + SZ512); const bf16_t* Yb = (const bf16_t*)(ws + WS_YB); bf16_t* CAT = (bf16_t*)(ws + WS_D);
        float lnw[8], lnb[8], rk[8], ka[8];
#pragma unroll
        for (int i = 0; i < 8; ++i) { lnw[i] = args.in[I_LNW][lane * 8 + i]; lnb[i] = args.in[I_LNB][lane * 8 + i]; rk[i] = args.in[I_RK][lane * 8 + i]; ka[i] = args.in[I_KA][lane * 8 + i]; }
        for (int m = gw; m < T; m += NGW) {
            const size_t o5 = (size_t)m * 512 + lane * 8, oz = (size_t)m * 2560 + lane * 8;
            const u32x4 yf = *(const u32x4*)(Yf + o5), yb = *(const u32x4*)(Yb + o5), rr = *(const u32x4*)(Rb + o5), kk = *(const u32x4*)(Kb + o5), vv = *(const u32x4*)(Vb + o5);
            const u32x4 af = *(const u32x4*)(ZZ + oz + 1024), ab = *(const u32x4*)(ZZ + oz + 1536), gg = *(const u32x4*)(ZZ + oz + 2048);
            float y[8], s = 0.f, bon = 0.f;
#pragma unroll
            for (int i = 0; i < 4; ++i) { y[2 * i] = lo2f(yf[i]) + lo2f(yb[i]); y[2 * i + 1] = hi2f(yf[i]) + hi2f(yb[i]); s += y[2 * i] + y[2 * i + 1];
                const float k0 = lo2f(kk[i]), k1 = hi2f(kk[i]), a0 = lo2f(af[i]) + lo2f(ab[i]) - 2.f, a1 = hi2f(af[i]) + hi2f(ab[i]) - 2.f;
                bon += lo2f(rr[i]) * (k0 * (2.f + a0 * ka[2 * i])) * rk[2 * i] + hi2f(rr[i]) * (k1 * (2.f + a1 * ka[2 * i + 1])) * rk[2 * i + 1]; }
            s += __shfl_xor(s, 1); s += __shfl_xor(s, 2); s += __shfl_xor(s, 4);
            bon += __shfl_xor(bon, 1); bon += __shfl_xor(bon, 2); bon += __shfl_xor(bon, 4);
            const float mean = s * (1.f / 64.f); float q = 0.f;
#pragma unroll
            for (int i = 0; i < 8; ++i) { y[i] -= mean; q += y[i] * y[i]; }
            q += __shfl_xor(q, 1); q += __shfl_xor(q, 2); q += __shfl_xor(q, 4);
            const float rstd = 1.f / sqrtf(q * (1.f / 64.f) + 64e-5f);
            float o[8];
#pragma unroll
            for (int i = 0; i < 4; ++i) { o[2 * i] = (y[2 * i] * rstd * lnw[2 * i] + lnb[2 * i] + bon * lo2f(vv[i])) * lo2f(gg[i]); o[2 * i + 1] = (y[2 * i + 1] * rstd * lnw[2 * i + 1] + lnb[2 * i + 1] + bon * hi2f(vv[i])) * hi2f(gg[i]); }
            u32x4 w; w.x = pk2(o[0], o[1]); w.y = pk2(o[2], o[3]); w.z = pk2(o[4], o[5]); w.w = pk2(o[6], o[7]);
            *(u32x4*)(CAT + (size_t)m * 1024 + lane * 8) = w;
        }
        SEAM(7);
    }
    if (CT(8) && IN(8)) {
        SchedRes S{66, 4, F.G, F.bid, (const char*)(ws + WS_D), (const char*)(WD + O_WOUT0 / 2), (size_t)256 * 1024 * 2, (size_t)256 * 1024 * 2, 0,
                   args.in[I_X], args.in[I_CTX], F.out, (float*)(ws + WS_XLC)};
        g8::EpiResGate E{MODS + 0 * 3 * 6144 + 2 * 1024, MIX_AMP};
        g8::gemm_phase(F.lds, 1024, S, E);
        SEAM(8);
    }

    moe_block<0>(args, F, bar, lo, hi);
        if (CT(14) && IN(14)) {
            SchedDense S{66, 6, F.G, F.bid, (const char*)(ws + WS_A), (const char*)(WD + O_WIN1 / 2), (char*)(ws + WS_C), (size_t)256 * 1024 * 2, (size_t)256 * 1024 * 2, (size_t)256 * 1536 * 2, 0};
            g8::EpiStoreBf16 E{1536, nullptr, 0};
            g8::gemm_phase(F.lds, 1024, S, E);
            SEAM(14);
        }
        if (CT(15) && IN(15)) {
            bf16_t* QKV = (bf16_t*)(ws + WS_C);
            const int hq = lane >> 2, sq = lane & 3, hk = lane >> 4, sk = lane & 15;
            float gq[16], gk[4];
#pragma unroll
            for (int i = 0; i < 16; ++i) gq[i] = args.in[I_GGQ][sq + 4 * i];
#pragma unroll
            for (int i = 0; i < 4; ++i) gk[i] = args.in[I_GGK][sk + 16 * i];
            float invq[4];
#pragma unroll
            for (int i = 0; i < 4; ++i) invq[i] = __powf(10000.f, -(float)(sq + 4 * i) * (1.f / 16.f));
            const float invk = __powf(10000.f, -(float)sk * (1.f / 16.f));
            for (int m = gw; m < T; m += NGW) { const int j = m % RB; const bool lat = j >= CTXL; bf16_t* row = QKV + (size_t)m * 1536;
                const int sp = j - CTXL; const float pr_ = (float)(sp >> 6), pc_ = (float)(sp & 63);
                { float k[4], ss = 0.f;
#pragma unroll
                  for (int i = 0; i < 4; ++i) { k[i] = bf2f(row[1024 + hk * 64 + sk + 16 * i]); ss += k[i] * k[i]; }
                  ss = rowsum16(ss); const float rs = 1.f / sqrtf(ss * (1.f / 64.f) + 1e-6f);
#pragma unroll
                  for (int i = 0; i < 4; ++i) k[i] = k[i] * rs * gk[i];
                  if (lat) { float cr, sr, cc, sc; sincosf(pr_ * invk, &sr, &cr); sincosf(pc_ * invk, &sc, &cc);
                      const float a = k[0], b2 = k[1]; k[0] = a * cr - b2 * sr; k[1] = b2 * cr + a * sr; const float c = k[2], d = k[3]; k[2] = c * cc - d * sc; k[3] = d * cc + c * sc; }
#pragma unroll
                  for (int i = 0; i < 4; ++i) row[1024 + hk * 64 + sk + 16 * i] = (bf16_t)(pk2(k[i], 0.f) & 0xffffu); }
                if (lat) { float q[16], ss = 0.f;
#pragma unroll
                  for (int i = 0; i < 16; ++i) { q[i] = bf2f(row[hq * 64 + sq + 4 * i]); ss += q[i] * q[i]; }
                  ss += __shfl_xor(ss, 1); ss += __shfl_xor(ss, 2); const float rs = 1.f / sqrtf(ss * (1.f / 64.f) + 1e-6f);
#pragma unroll
                  for (int i = 0; i < 16; ++i) q[i] = q[i] * rs * gq[i];
#pragma unroll
                  for (int i = 0; i < 4; ++i) { float cr, sr, cc, sc; sincosf(pr_ * invq[i], &sr, &cr); sincosf(pc_ * invq[i], &sc, &cc);
                      const float a = q[i], b2 = q[i + 4]; q[i] = a * cr - b2 * sr; q[i + 4] = b2 * cr + a * sr; const float c = q[i + 8], d = q[i + 12]; q[i + 8] = c * cc - d * sc; q[i + 12] = d * cc + c * sc; }
#pragma unroll
                  for (int i = 0; i < 16; ++i) row[hq * 64 + sq + 4 * i] = (bf16_t)(pk2(q[i] * C2_GQA, 0.f) & 0xffffu); }
            }
            SEAM(15);
        }
        if (CT(16) && IN(16)) {
            const bf16_t* QKV = (const bf16_t*)(ws + WS_C); bf16_t* O1 = (bf16_t*)(ws + WS_D);
            const int x = F.bid & 7, b = x >> 2, kvh = x & 3, per = F.G >> 3, i0 = F.bid >> 3;
            for (int uu = i0; uu < 128; uu += per) { const int hh = kvh * 4 + (uu >> 5), qb = 1 + (uu & 31);
                const size_t m0 = (size_t)b * RB + (size_t)qb * 256, k0 = (size_t)b * RB;
                __syncthreads();
                att::attn_unit<64>(QKV + m0 * 1536 + hh * 64, 1536, QKV + k0 * 1536 + 1024 + kvh * 64, 1536, QKV + k0 * 1536 + 1280 + kvh * 64, 1536, O1 + m0 * 1024 + hh * 64, 1024, 132, (char*)lds_raw); }
            SEAM(16);
        }
        if (CT(17) && IN(17)) {
            SchedRes S{64, 4, F.G, F.bid, (const char*)(ws + WS_D), (const char*)(WD + O_WOUT1 / 2), (size_t)256 * 1024 * 2, (size_t)256 * 1024 * 2, 1,
                       F.out, (const float*)(ws + WS_XLC), F.out, (float*)(ws + WS_XLC)};
            g8::EpiResGate E{MODS + 1 * 3 * 6144 + 2 * 1024, 1.0f};
            g8::gemm_phase(F.lds, 1024, S, E);
            SEAM(17);
        }
    moe_block<1>(args, F, bar, lo, hi);
#undef IN
#undef SEAM
}

extern "C" void kernel_launch(void* const* d_in, const int* in_sizes, int n_in, void* d_out, int out_size, void* d_ws, size_t ws_size, hipStream_t stream) {
    static int grid = 0;
    if (grid == 0) {
        if (n_in != 39 || out_size != 2 * SEQ * DM || ws_size < WS_NEED) { fprintf(stderr, "kernel_launch: unexpected shapes (n_in %d out %d ws %zu)\n", n_in, out_size, ws_size); grid = -1; return; }
        int dev = 0, cus = 0;
        if (hipGetDevice(&dev) != hipSuccess || hipDeviceGetAttribute(&cus, hipDeviceAttributeMultiprocessorCount, dev) != hipSuccess) { grid = -1; return; }
        if (hipFuncSetAttribute((const void*)fwd_kernel, hipFuncAttributeMaxDynamicSharedMemorySize, LDS_BYTES) != hipSuccess) { fprintf(stderr, "kernel_launch: hipFuncSetAttribute failed\n"); grid = -1; return; }
        int per_cu = 0;
        if (hipOccupancyMaxActiveBlocksPerMultiprocessor(&per_cu, (const void*)fwd_kernel, NTHR, LDS_BYTES) != hipSuccess || per_cu < 1) fprintf(stderr, "kernel_launch: occupancy query says %d\n", per_cu);
        (void)hipGetLastError();
        grid = cus;
    }
    if (grid < 0) return;
    if (hipMemsetAsync((char*)d_ws + WS_CTL, 0, CTL_BYTES, stream) != hipSuccess) return;
    Args a{};
    for (int i = 0; i < 39; ++i) a.in[i] = (const float*)d_in[i];
    a.out = (float*)d_out; a.ws = (unsigned char*)d_ws;
    if (N_LAUNCH_MODE == 1) { a.ph_lo = 0; a.ph_hi = PH_END; hipLaunchKernelGGL(fwd_kernel, dim3(grid), dim3(NTHR), LDS_BYTES, stream, a); }
    else for (int p = 0; p < PH_END; ++p) { a.ph_lo = p; a.ph_hi = p + 1; hipLaunchKernelGGL(fwd_kernel, dim3(grid), dim3(NTHR), LDS_BYTES, stream, a); }
}
```

```cpp
#include <hip/hip_runtime.h>
#include <hip/hip_bf16.h>
#include <cstdio>
#include <cstdint>

#define LAS __attribute__((address_space(3)))
#define GAS __attribute__((address_space(1)))
typedef unsigned short bf16_t;
typedef short bf16x8 __attribute__((ext_vector_type(8)));
typedef short s16x4 __attribute__((ext_vector_type(4)));
typedef float f32x4 __attribute__((ext_vector_type(4)));
typedef float f32x2 __attribute__((ext_vector_type(2)));
typedef float f32x16 __attribute__((ext_vector_type(16)));
typedef unsigned u32x4 __attribute__((ext_vector_type(4)));
typedef unsigned u32x2 __attribute__((ext_vector_type(2)));
typedef __bf16 bf16x2_t __attribute__((ext_vector_type(2)));

#ifndef PH_END
#define PH_END 23
#endif
#ifndef N_LAUNCH_MODE
#define N_LAUNCH_MODE 1
#endif
#ifndef ONLY_PH
#define ONLY_PH -1
#endif
#define CT(id) (ONLY_PH < 0 || ONLY_PH == (id))
#ifndef MIX_AMP
#define MIX_AMP 1.0f
#endif

constexpr int T = 16896, RB = 8448, CTXL = 256, SEQ = 8192, DM = 1024;
constexpr int NWAVES = 8, NTHR = 512;
constexpr int NE = 16, HS_TILES = 148, HS_ROWS = HS_TILES * 256;
constexpr float C2_MLA = 0.10206207261596575f * 1.4426950408889634f;
constexpr float C2_GQA = 0.125f * 1.4426950408889634f;

constexpr size_t MiB = 1u << 20;
constexpr size_t WS_CTL = 0, CTL_BYTES = 1 * MiB;
constexpr size_t WS_SMALL = 1 * MiB;
constexpr size_t SM_MODS = WS_SMALL;
constexpr size_t SM_BIASZ = WS_SMALL + 160 * 1024;
constexpr size_t SM_SEL = WS_SMALL + 192 * 1024;
constexpr size_t SM_WTS = WS_SMALL + 512 * 1024;
constexpr size_t SM_POS = WS_SMALL + 704 * 1024;
constexpr size_t SM_ROWWT = WS_SMALL + 1024 * 1024;
constexpr size_t WS_WD = 4 * MiB;
constexpr size_t O_WIN0 = 0, O_WOUT0 = 5767168, O_WLORA = 7864320, O_WQUP = 9830400, O_WKVUP = 10420224, O_WIN1 = 10944512, O_WOUT1 = 14090240, O_WD_END = 16187392;
static_assert(O_WD_END <= 17 * MiB, "dense weights");
constexpr size_t WS_XLC = 21 * MiB;
constexpr size_t WS_KROPE = 23 * MiB;
constexpr size_t WS_A = 26 * MiB;
constexpr size_t WS_B = 59 * MiB;
constexpr size_t WS_C = 113770496;
constexpr size_t WS_ACT = 183 * MiB;
constexpr size_t WS_D = 191 * MiB;
constexpr size_t WS_YB = 224 * MiB;
constexpr size_t SZ1024 = (size_t)T * 1024 * 2, SZ512 = (size_t)T * 512 * 2, SZ768 = (size_t)T * 768 * 2, SZ384 = (size_t)T * 384 * 2, SZ256 = (size_t)T * 256 * 2;
static_assert(WS_A + SZ1024 <= WS_B && WS_B + 3 * SZ512 <= WS_C && WS_C + (size_t)T * 2816 * 2 <= 200 * MiB, "map");
static_assert(WS_C + (size_t)HS_ROWS * 2048 <= WS_ACT && WS_ACT + (size_t)(HS_ROWS + T) * 512 <= 211 * MiB, "map2");
static_assert(WS_D + SZ768 + SZ1024 <= 256 * MiB && WS_YB + SZ512 <= 256 * MiB && WS_D + SZ1024 <= WS_YB, "map3");
constexpr size_t WS_NEED = 256 * MiB;
constexpr int CW_TMO = 0, CW_BAR = 4096, CW_CNT = 8192  , CW_QUEUE = 12288;

__device__ __forceinline__ float bf2f(unsigned short h) { return __uint_as_float((unsigned)h << 16); }
__device__ __forceinline__ unsigned pk2(float lo, float hi) { f32x2 v = {lo, hi}; bf16x2_t b = __builtin_convertvector(v, bf16x2_t); return __builtin_bit_cast(unsigned, b); }
__device__ __forceinline__ float lo2f(unsigned w) { return __uint_as_float(w << 16); }
__device__ __forceinline__ float hi2f(unsigned w) { return __uint_as_float(w & 0xffff0000u); }
__device__ __forceinline__ float sigmoidf_(float x) { return __builtin_amdgcn_rcpf(1.f + __expf(-x)); }
__device__ __forceinline__ float wave_sum(float v) {
#pragma unroll
    for (int o = 1; o < 64; o <<= 1) v += __shfl_xor(v, o);
    return v;
}
#define DPP_ROR_ADD(x, ctrl) x += __int_as_float(__builtin_amdgcn_update_dpp(0, __float_as_int(x), ctrl, 0xF, 0xF, false))
__device__ __forceinline__ float rowsum16(float x) {
    DPP_ROR_ADD(x, 0x128); DPP_ROR_ADD(x, 0x124); DPP_ROR_ADD(x, 0x122); DPP_ROR_ADD(x, 0x121); return x;
}
#define LDS_WAIT() asm volatile("s_waitcnt lgkmcnt(0)" ::: "memory")
#define VM_WAIT() asm volatile("s_waitcnt vmcnt(0)" ::: "memory")

namespace g8 {
constexpr int BM = 256, BK = 64, HALF = 128, HTB = HALF * BK * 2, STAGE_BYTES = 8 * HTB, NXCD = 8, WGM = 8;
__host__ __device__ __forceinline__ int lds_byte(int r, int c) { const int st = (r >> 4) * 2 + (c >> 5), rr = r & 15, cc = c & 31, ob = rr * 64 + cc * 2; return st * 1024 + (ob ^ (((ob >> 9) & 1) << 5)); }
__host__ __device__ __forceinline__ void stage_rc(int b, int& R, int& C) { const int st = b / 1024, sb = b % 1024, swz = sb ^ (((sb >> 9) & 1) << 5); R = (st >> 1) * 16 + swz / 64; C = (st & 1) * 32 + (swz % 64) / 2; }
__host__ __device__ __forceinline__ int perm32(int rho) { const int n = rho >> 4, i = rho & 15; return 8 * (i >> 2) + 4 * n + (i & 3); }

struct Unit { const char* a; const char* b; char* o; const float* f0; int pn; int aux; };

__device__ __forceinline__ bool tile_order(int i, int G, int c, int nM, int nN, int& pm, int& pn) {
    const int nwg = nM * nN; const long L = (long)i * G + c; if (L >= nwg) return false;
    int wgid = (int)L; { const int q = nwg / NXCD, r = nwg % NXCD, xcd = wgid % NXCD, off = wgid / NXCD; wgid = (xcd < r ? xcd * (q + 1) : r * (q + 1) + (xcd - r) * q) + off; }
    const int nig = WGM * nN, gid = wgid / nig, fm = gid * WGM, gsz = (nM - fm) < WGM ? (nM - fm) : WGM;
    pm = fm + ((wgid % nig) % gsz); pn = (wgid % nig) / gsz; return true;
}

struct EpiStoreBf16 {
    static constexpr bool PERM = true;
    int ldc; const float* bias; int sig_cols;
    __device__ __forceinline__ void operator()(const f32x4 (&acc)[2][2][4][2], const Unit& u, int wr, int wc, int fr, int fq) const {
        bf16_t* base = (bf16_t*)u.o; const int col0 = u.pn * BM + wc * 32 + 8 * fq;
        const bool sig = (u.pn * BM) < sig_cols;
        f32x4 bv[2][2];
#pragma unroll
        for (int bj = 0; bj < 2; ++bj)
#pragma unroll
            for (int n = 0; n < 2; ++n) bv[bj][n] = bias ? *(const f32x4*)(bias + col0 + bj * HALF + 4 * n) : (f32x4){0.f, 0.f, 0.f, 0.f};
#pragma unroll
        for (int ai = 0; ai < 2; ++ai)
#pragma unroll
            for (int m = 0; m < 4; ++m) { bf16_t* rowp = base + (size_t)(ai * HALF + wr * 64 + m * 16 + fr) * ldc + col0;
#pragma unroll
                for (int bj = 0; bj < 2; ++bj) { f32x4 v0 = acc[ai][bj][m][0] + bv[bj][0], v1 = acc[ai][bj][m][1] + bv[bj][1];
                    if (sig) {
#pragma unroll
                        for (int j = 0; j < 4; ++j) { v0[j] = sigmoidf_(v0[j]); v1[j] = sigmoidf_(v1[j]); } }
                    u32x4 w; w.x = pk2(v0[0], v0[1]); w.y = pk2(v0[2], v0[3]); w.z = pk2(v1[0], v1[1]); w.w = pk2(v1[2], v1[3]);
                    *(u32x4*)(rowp + bj * HALF) = w; } }
    }
};
struct EpiResGate {
    static constexpr bool PERM = false;
    const float* gate0; float amp;
    __device__ __forceinline__ void operator()(const f32x4 (&acc)[2][2][4][2], const Unit& u, int wr, int wc, int fr, int fq) const {
        const float* base = u.f0; float* out = (float*)u.o; const float* gate = gate0 + u.aux * 6144;
        const int col0 = u.pn * BM + wc * 32 + 4 * fq;
        f32x4 gv[2][2];
#pragma unroll
        for (int bj = 0; bj < 2; ++bj)
#pragma unroll
            for (int n = 0; n < 2; ++n) gv[bj][n] = *(const f32x4*)(gate + col0 + bj * HALF + n * 16) * amp;
#pragma unroll
        for (int ai = 0; ai < 2; ++ai)
#pragma unroll
            for (int m = 0; m < 4; ++m) { const size_t off = (size_t)(ai * HALF + wr * 64 + m * 16 + fr) * DM + col0;
#pragma unroll
                for (int bj = 0; bj < 2; ++bj)
#pragma unroll
                    for (int n = 0; n < 2; ++n) { const f32x4 bs = *(const f32x4*)(base + off + bj * HALF + n * 16);
                        *(f32x4*)(out + off + bj * HALF + n * 16) = bs + gv[bj][n] * acc[ai][bj][m][n]; }
                asm volatile("" ::: "memory"); }
    }
};
struct EpiSwiGLU {
    static constexpr bool PERM = true;
    __device__ __forceinline__ void operator()(const f32x4 (&acc)[2][2][4][2], const Unit& u, int wr, int wc, int fr, int fq) const {
        bf16_t* act = (bf16_t*)u.o; const float* rw = u.f0; const int f0 = u.pn * 128 + wc * 32 + 8 * fq;
#pragma unroll
        for (int ai = 0; ai < 2; ++ai)
#pragma unroll
            for (int m = 0; m < 4; ++m) { const int r = ai * HALF + wr * 64 + m * 16 + fr; const float wt = rw ? rw[r] : 1.f;
                float o[8];
#pragma unroll
                for (int n = 0; n < 2; ++n)
#pragma unroll
                    for (int j = 0; j < 4; ++j) { const float g = acc[ai][0][m][n][j], up = acc[ai][1][m][n][j]; o[n * 4 + j] = g * sigmoidf_(g) * up * wt; }
                u32x4 w; w.x = pk2(o[0], o[1]); w.y = pk2(o[2], o[3]); w.z = pk2(o[4], o[5]); w.w = pk2(o[6], o[7]);
                *(u32x4*)(act + (size_t)r * 256 + f0) = w; asm volatile("" ::: "memory"); }
    }
};

template <class Epi, class Sched>
__device__ __forceinline__ void gemm_phase(LAS unsigned char* lds, const int K, const Sched& S, const Epi& E) {
    const int tid = threadIdx.x, wid = __builtin_amdgcn_readfirstlane(tid >> 6), lane = tid & 63, wr = wid >> 2, wc = wid & 3, fr = lane & 15, fq = lane >> 4;
    const int nt = K / BK;
    unsigned voffA[2], voffB[2];
#pragma unroll
    for (int i = 0; i < 2; ++i) { int R, C; stage_rc(tid * 16 + i * 8192, R, C); const int Rb = Epi::PERM ? ((R & ~31) + perm32(R & 31)) : R;
        voffA[i] = (unsigned)(R * K + C) * 2u; voffB[i] = (unsigned)(Rb * K + C) * 2u; }
    const size_t kstep = (size_t)(BK * 2);
    const size_t hstep = (size_t)HALF * K * 2;
    const unsigned ldsw = (unsigned)wid * 1024u;
    const int aoff = lds_byte(wr * 64 + fr, fq * 8), boff = lds_byte(wc * 32 + fr, fq * 8);
#define PG8_SA(b, h) (((b) * 2 + (h)) * HTB)
#define PG8_SB(b, h) ((4 + (b) * 2 + (h)) * HTB)
#define PG8_STAGE(bufoff, gbase, voff) do { _Pragma("unroll") for (int _i = 0; _i < 2; ++_i) \
        __builtin_amdgcn_global_load_lds((const unsigned*)((const char*)(gbase) + (voff)[_i]), (LAS unsigned*)(lds + (bufoff) + ldsw + _i * 8192), 16, 0, 0); } while (0)
#define PG8_LDA(dst, b, h) do { _Pragma("unroll") for (int m = 0; m < 4; ++m) _Pragma("unroll") for (int k = 0; k < 2; ++k) dst[m][k] = *(const LAS bf16x8*)(lds + PG8_SA(b, h) + aoff + m * 2048 + k * 1024); } while (0)
#define PG8_LDB(dst, b, h) do { _Pragma("unroll") for (int n = 0; n < 2; ++n) _Pragma("unroll") for (int k = 0; k < 2; ++k) dst[n][k] = *(const LAS bf16x8*)(lds + PG8_SB(b, h) + boff + n * 2048 + k * 1024); } while (0)
#define PG8_MMA(ai, bj, At, Bt) do { __builtin_amdgcn_s_setprio(1); _Pragma("unroll") for (int m = 0; m < 4; ++m) _Pragma("unroll") for (int n = 0; n < 2; ++n) _Pragma("unroll") for (int k = 0; k < 2; ++k) \
        acc[ai][bj][m][n] = __builtin_amdgcn_mfma_f32_16x16x32_bf16(Bt[n][k], At[m][k], acc[ai][bj][m][n], 0, 0, 0); __builtin_amdgcn_s_setprio(0); } while (0)
#define PG8_WAIT_V(n) asm volatile("s_waitcnt vmcnt(" #n ")" ::: "memory")
#define PG8_WAIT_L(n) asm volatile("s_waitcnt lgkmcnt(" #n ")" ::: "memory")
#define PG8_BAR __builtin_amdgcn_s_barrier()
#define PG8_SCHED __builtin_amdgcn_sched_barrier(0)
    Unit cur, nxt; int ui = 0;
    if (!S.next(0, cur)) return;
    f32x4 acc[2][2][4][2];
#pragma unroll
    for (int a = 0; a < 2; ++a)
#pragma unroll
        for (int b = 0; b < 2; ++b)
#pragma unroll
            for (int m = 0; m < 4; ++m)
#pragma unroll
                for (int n = 0; n < 2; ++n) acc[a][b][m][n] = (f32x4){0.f, 0.f, 0.f, 0.f};
    bf16x8 At[4][2], B0[2][2], B1[2][2];
    const char* cA = cur.a; const char* cB = cur.b;
    PG8_STAGE(PG8_SB(0, 0), cB, voffB); PG8_STAGE(PG8_SB(0, 1), cB + hstep, voffB); PG8_STAGE(PG8_SA(0, 0), cA, voffA); PG8_STAGE(PG8_SA(0, 1), cA + hstep, voffA);
    if (wr == 1) PG8_BAR;
    PG8_WAIT_V(2); PG8_BAR;
    PG8_STAGE(PG8_SB(1, 0), cB + kstep, voffB); PG8_STAGE(PG8_SA(1, 0), cA + kstep, voffA); PG8_STAGE(PG8_SB(1, 1), cB + hstep + kstep, voffB);
    PG8_WAIT_V(6); PG8_BAR;
    for (;;) {
        const bool has_next = S.next(ui + 1, nxt);
        const char* nA = has_next ? nxt.a : cA; const char* nB = has_next ? nxt.b : cB;
#pragma unroll 1
        for (int t = 0; t < nt; t += 2) {
            const bool last = (t == nt - 2);
            const char* a1 = cA + (size_t)(t + 1) * kstep;
            const char* a2 = last ? nA : cA + (size_t)(t + 2) * kstep; const char* b2 = last ? nB : cB + (size_t)(t + 2) * kstep;
            const char* a3 = a2 + kstep; const char* b3 = b2 + kstep;
            PG8_LDB(B0, 0, 0); PG8_LDB(B1, 0, 1); PG8_SCHED; PG8_LDA(At, 0, 0); PG8_STAGE(PG8_SA(1, 1), a1 + hstep, voffA);
            PG8_WAIT_V(8); PG8_WAIT_L(0); PG8_BAR; PG8_MMA(0, 0, At, B0); PG8_MMA(0, 1, At, B1); PG8_BAR; PG8_SCHED;
            PG8_LDA(At, 0, 1); PG8_STAGE(PG8_SB(0, 0), b2, voffB); PG8_STAGE(PG8_SB(0, 1), b2 + hstep, voffB); PG8_STAGE(PG8_SA(0, 0), a2, voffA);
            PG8_WAIT_V(8); PG8_WAIT_L(0); PG8_BAR; PG8_MMA(1, 0, At, B0); PG8_MMA(1, 1, At, B1); PG8_BAR; PG8_SCHED;
            PG8_LDB(B0, 1, 0); PG8_LDB(B1, 1, 1); PG8_SCHED; PG8_LDA(At, 1, 0); PG8_STAGE(PG8_SA(0, 1), a2 + hstep, voffA);
            PG8_WAIT_V(8); PG8_WAIT_L(0); PG8_BAR; PG8_MMA(0, 0, At, B0); PG8_MMA(0, 1, At, B1); PG8_BAR; PG8_SCHED;
            PG8_LDA(At, 1, 1); PG8_STAGE(PG8_SB(1, 0), b3, voffB); PG8_STAGE(PG8_SB(1, 1), b3 + hstep, voffB); PG8_STAGE(PG8_SA(1, 0), a3, voffA);
            PG8_WAIT_V(8); PG8_WAIT_L(0); PG8_BAR; PG8_MMA(1, 0, At, B0); PG8_MMA(1, 1, At, B1); PG8_BAR; PG8_SCHED;
        }
        if (wr == 0) PG8_BAR;
        E(acc, cur, wr, wc, fr, fq);
        if (!has_next) break;
#pragma unroll
        for (int a = 0; a < 2; ++a)
#pragma unroll
            for (int b = 0; b < 2; ++b)
#pragma unroll
                for (int m = 0; m < 4; ++m)
#pragma unroll
                    for (int n = 0; n < 2; ++n) acc[a][b][m][n] = (f32x4){0.f, 0.f, 0.f, 0.f};
        cur = nxt; cA = nA; cB = nB; ++ui;
        if (wr == 1) PG8_BAR;
    }
    PG8_WAIT_V(0);
    PG8_BAR;
#undef PG8_SA
#undef PG8_SB
#undef PG8_STAGE
#undef PG8_LDA
#undef PG8_LDB
#undef PG8_MMA
#undef PG8_WAIT_V
#undef PG8_WAIT_L
#undef PG8_BAR
#undef PG8_SCHED
}
}

namespace att {
#define SBAR() __builtin_amdgcn_sched_barrier(0)
__device__ __forceinline__ int crow(int r, int hi) { return (r & 3) + 8 * (r >> 2) + 4 * hi; }
constexpr float THR = 8.f;
__device__ __forceinline__ void partialSM(f32x16& p0, f32x16& p1, float& m_reg, float& alpha) {
    float pmax = p0[0];
#pragma unroll
    for (int r = 1; r < 16; ++r) pmax = fmaxf(pmax, p0[r]);
#pragma unroll
    for (int r = 0; r < 16; ++r) pmax = fmaxf(pmax, p1[r]);
    { auto rr = __builtin_amdgcn_permlane32_swap(__float_as_uint(pmax), __float_as_uint(pmax), false, false);
      pmax = fmaxf(__uint_as_float(rr[0]), __uint_as_float(rr[1])); }
    float mn;
    if (__builtin_expect(__all(pmax - m_reg <= THR), 1)) { mn = m_reg; alpha = 1.f; }
    else { mn = fmaxf(m_reg, pmax); alpha = __builtin_amdgcn_exp2f(m_reg - mn); m_reg = mn; }
#pragma unroll
    for (int r = 0; r < 16; ++r) p0[r] = p0[r] - mn;
#pragma unroll
    for (int r = 0; r < 16; ++r) p1[r] = p1[r] - mn;
#pragma unroll
    for (int r = 0; r < 16; ++r) p0[r] = __builtin_amdgcn_exp2f(p0[r]);
}
__device__ __forceinline__ void finishSM(f32x16& p0, f32x16& p1, float alpha, float& l_reg, bf16x8& pa0, bf16x8& pa1, bf16x8& pa2, bf16x8& pa3) {
#pragma unroll
    for (int r = 0; r < 16; ++r) p1[r] = __builtin_amdgcn_exp2f(p1[r]);
    float ps = 0;
#pragma unroll
    for (int r = 0; r < 16; ++r) ps += p0[r];
#pragma unroll
    for (int r = 0; r < 16; ++r) ps += p1[r];
    { auto rr = __builtin_amdgcn_permlane32_swap(__float_as_uint(ps), __float_as_uint(ps), false, false);
      ps = __uint_as_float(rr[0]) + __uint_as_float(rr[1]); }
    l_reg = l_reg * alpha + ps;
#define PK4(P, BASE, OUT) do { unsigned a0 = pk2(P[BASE + 0], P[BASE + 1]), a1 = pk2(P[BASE + 2], P[BASE + 3]);   \
    unsigned b0 = pk2(P[BASE + 4], P[BASE + 5]), b1 = pk2(P[BASE + 6], P[BASE + 7]);                              \
    auto r0 = __builtin_amdgcn_permlane32_swap(a0, b0, false, false); auto r1 = __builtin_amdgcn_permlane32_swap(a1, b1, false, false); \
    u32x4 w = {r0[0], r1[0], r0[1], r1[1]}; OUT = __builtin_bit_cast(bf16x8, w); } while (0)
    PK4(p0, 0, pa0); PK4(p0, 8, pa1); PK4(p1, 0, pa2); PK4(p1, 8, pa3);
#undef PK4
}
template <int DQK>
__device__ __forceinline__ void qkt(f32x16& p0, f32x16& p1, const char* Ks, const bf16x8* qr, int r32, int hi) {
    p0 = f32x16{}; p1 = f32x16{};
    const char* kb = Ks + hi * 1024 + r32 * 16;
#pragma unroll
    for (int d0 = 0; d0 < DQK / 16; ++d0) {
        bf16x8 b0 = *reinterpret_cast<const bf16x8*>(kb + d0 * 2048);
        bf16x8 b1 = *reinterpret_cast<const bf16x8*>(kb + d0 * 2048 + 512);
        p0 = __builtin_amdgcn_mfma_f32_32x32x16_bf16(b0, qr[d0], p0, 0, 0, 0);
        p1 = __builtin_amdgcn_mfma_f32_32x32x16_bf16(b1, qr[d0], p1, 0, 0, 0); }
}
__device__ __forceinline__ int v_st(int k, int c) { const int kk = (k & ~0xC) | ((k & 4) << 1) | ((k & 8) >> 1); return ((kk >> 3) * 2 + (c >> 5)) * 512 + ((kk & 7) * 32 + (c & 31)) * 2; }
__device__ __forceinline__ int v_rd_base(int lane) { return ((lane & 3) << 3) | (((lane >> 2) & 3) << 6) | (((lane >> 4) & 1) << 5) | (((lane >> 5) & 1) << 8); }
constexpr int v_rd_off(int d0, int ks, int half) { return d0 * 512 + ks * 2048 + half * 1024; }
template <int OFF> __device__ __forceinline__ s16x4 tr_read(int vb) {
    s16x4 r; asm volatile("ds_read_b64_tr_b16 %0, %1 offset:%2" : "=&v"(r) : "v"(vb), "i"(OFF) : "memory"); return r;
}
template <int D0> __device__ __forceinline__ void pv_one(f32x16& od, int vb, bf16x8 pa0, bf16x8 pa1, bf16x8 pa2, bf16x8 pa3) {
    const s16x4 l0 = tr_read<v_rd_off(D0, 0, 0)>(vb), h0 = tr_read<v_rd_off(D0, 0, 1)>(vb), l1 = tr_read<v_rd_off(D0, 1, 0)>(vb), h1 = tr_read<v_rd_off(D0, 1, 1)>(vb);
    const s16x4 l2 = tr_read<v_rd_off(D0, 2, 0)>(vb), h2 = tr_read<v_rd_off(D0, 2, 1)>(vb), l3 = tr_read<v_rd_off(D0, 3, 0)>(vb), h3 = tr_read<v_rd_off(D0, 3, 1)>(vb);
    asm volatile("s_waitcnt lgkmcnt(0)" ::: "memory"); SBAR();
#define PK(L, H) (bf16x8){L[0], L[1], L[2], L[3], H[0], H[1], H[2], H[3]}
    od = __builtin_amdgcn_mfma_f32_32x32x16_bf16(pa0, PK(l0, h0), od, 0, 0, 0);
    od = __builtin_amdgcn_mfma_f32_32x32x16_bf16(pa1, PK(l1, h1), od, 0, 0, 0);
    od = __builtin_amdgcn_mfma_f32_32x32x16_bf16(pa2, PK(l2, h2), od, 0, 0, 0);
    od = __builtin_amdgcn_mfma_f32_32x32x16_bf16(pa3, PK(l3, h3), od, 0, 0, 0);
#undef PK
}
__device__ __forceinline__ void pv_all(f32x16* o, int vb, bf16x8 pa0, bf16x8 pa1, bf16x8 pa2, bf16x8 pa3) {
    pv_one<0>(o[0], vb, pa0, pa1, pa2, pa3); pv_one<1>(o[1], vb, pa0, pa1, pa2, pa3);
}
template <int DQK> struct Lay { static constexpr int NCH = DQK / 8, SHM_K = 64 * DQK * 2, SHM_V = 8192, OFF_V = 0, OFF_K = 2 * SHM_V, OFF_WS = OFF_K + 2 * SHM_K, OFF_OST = OFF_WS + NWAVES * 256, BYTES = OFF_OST + NWAVES * 4096; };
template <int DQK>
__device__ __forceinline__ void attn_unit(const bf16_t* __restrict__ Qb, int ldq, const bf16_t* __restrict__ Kh, int ldk, const bf16_t* __restrict__ Vh, int ldv,
                                          bf16_t* __restrict__ Ob, int ldo, int NT, char* lds) {
    using L = Lay<DQK>; constexpr int NCH = L::NCH, ND0 = DQK / 16;
    const int tid = threadIdx.x, wid = tid >> 6, lane = tid & 63, r32 = lane & 31, hi = lane >> 5;
    char* V_lds = lds + L::OFF_V; char* K_lds = lds + L::OFF_K;
    float* ws = (float*)(lds + L::OFF_WS) + wid * 64; float* li_l = ws; float* al_l = ws + 32;
    float m_reg = -1e30f, l_reg = 0; f32x16 o[2] = {}; bf16x8 qr[ND0];
    const bf16_t* Qw = Qb + (size_t)(wid * 32 + r32) * ldq + hi * 8;
#pragma unroll
    for (int d0 = 0; d0 < ND0; ++d0) qr[d0] = *reinterpret_cast<const bf16x8*>(Qw + d0 * 16);
    const int vrow = tid >> 3, vcol = (tid & 7) * 8, vst = v_st(vrow, vcol);
    const int kp0 = tid, kr0 = kp0 / NCH, kc0 = kp0 % NCH, kst0 = kc0 * 1024 + kr0 * 16;
    const int kp1 = 512 + (tid & 255), kr1 = kp1 / NCH, kc1 = kp1 % NCH, kst1 = kc1 * 1024 + kr1 * 16;
    const int vb0 = (int)(uintptr_t)V_lds + v_rd_base(lane);
    struct { bf16x8 v, k0, k1; } sr_[2];
#define SLOAD(i, key0) do { sr_[i].v = *reinterpret_cast<const bf16x8*>(Vh + (size_t)((key0) + vrow) * ldv + vcol); \
    sr_[i].k0 = *reinterpret_cast<const bf16x8*>(Kh + (size_t)((key0) + kr0) * ldk + kc0 * 8); \
    if (NCH > 8) sr_[i].k1 = *reinterpret_cast<const bf16x8*>(Kh + (size_t)((key0) + kr1) * ldk + kc1 * 8); } while (0)
#define SWRITE(b, i) do { *(bf16x8*)(V_lds + (b) * L::SHM_V + vst) = sr_[i].v; *(bf16x8*)(K_lds + (b) * L::SHM_K + kst0) = sr_[i].k0; \
    if (NCH > 8) { if (tid < 256) *(bf16x8*)(K_lds + (b) * L::SHM_K + kst1) = sr_[i].k1; } } while (0)
#define SWAIT() do { if (NCH > 8) asm volatile("s_waitcnt vmcnt(3)" ::: "memory"); else asm volatile("s_waitcnt vmcnt(2)" ::: "memory"); } while (0)
#define RESC(a) do { if (__any((a) < 1.f)) { if (hi == 0) al_l[r32] = (a); asm volatile("s_waitcnt lgkmcnt(0)" ::: "memory"); \
    _Pragma("unroll") for (int d = 0; d < 2; ++d) _Pragma("unroll") for (int r = 0; r < 16; ++r) o[d][r] *= al_l[crow(r, hi)]; } } while (0)
    f32x16 pA0, pA1, pB0, pB1; float alA, alB; bf16x8 pa0, pa1, pa2, pa3;
    constexpr int SE = 0, SO = 1;
    SLOAD(SE, 0); asm volatile("s_waitcnt vmcnt(0)" ::: "memory"); SWRITE(0, SE); __syncthreads();
    qkt<DQK>(pA0, pA1, K_lds, qr, r32, hi); partialSM(pA0, pA1, m_reg, alA);
    SLOAD(SO, 64); if (2 < NT) SLOAD(SE, 128);
    SWAIT(); SWRITE(1, SO); __syncthreads();
    for (int j = 1; j + 1 < NT; j += 2) {
        SBAR(); qkt<DQK>(pB0, pB1, K_lds + L::SHM_K, qr, r32, hi);
        finishSM(pA0, pA1, alA, l_reg, pa0, pa1, pa2, pa3); SBAR();
        SLOAD(SO, (j + 2) * 64); SBAR();
        pv_all(o, vb0, pa0, pa1, pa2, pa3); partialSM(pB0, pB1, m_reg, alB);
        __syncthreads(); SWAIT(); SWRITE(0, SE);
        RESC(alB); __syncthreads();
        SBAR(); qkt<DQK>(pA0, pA1, K_lds, qr, r32, hi);
        finishSM(pB0, pB1, alB, l_reg, pa0, pa1, pa2, pa3); SBAR();
        if (j + 3 < NT) SLOAD(SE, (j + 3) * 64); SBAR();
        pv_all(o, vb0 + L::SHM_V, pa0, pa1, pa2, pa3); partialSM(pA0, pA1, m_reg, alA);
        __syncthreads(); SWAIT(); SWRITE(1, SO);
        RESC(alA); __syncthreads();
    }
    SBAR(); qkt<DQK>(pB0, pB1, K_lds + L::SHM_K, qr, r32, hi);
    finishSM(pA0, pA1, alA, l_reg, pa0, pa1, pa2, pa3); SBAR();
    pv_all(o, vb0, pa0, pa1, pa2, pa3); partialSM(pB0, pB1, m_reg, alB);
    __syncthreads(); RESC(alB);
    finishSM(pB0, pB1, alB, l_reg, pa0, pa1, pa2, pa3); SBAR();
    pv_all(o, vb0 + L::SHM_V, pa0, pa1, pa2, pa3);
    if (hi == 0) li_l[r32] = l_reg; asm volatile("s_waitcnt lgkmcnt(0)" ::: "memory");
    float rli[16];
#pragma unroll
    for (int r = 0; r < 16; ++r) rli[r] = __builtin_amdgcn_rcpf(li_l[crow(r, hi)]);
    bf16_t* Ow = Ob + (size_t)(wid * 32) * ldo;
    { bf16_t* stg = (bf16_t*)(lds + L::OFF_OST) + wid * 2048;
#pragma unroll
      for (int r = 0; r < 16; ++r) { const int orow = crow(r, hi);
#pragma unroll
        for (int d0 = 0; d0 < 2; ++d0) stg[orow * 64 + d0 * 32 + r32] = (bf16_t)(pk2(o[d0][r] * rli[r], 0.f) & 0xffffu); }
      asm volatile("s_waitcnt lgkmcnt(0)" ::: "memory");
#pragma unroll
      for (int i = 0; i < 4; ++i) { const int row = i * 8 + (lane >> 3), ch = lane & 7; const u32x4 v = *(const u32x4*)(stg + row * 64 + ch * 8); *(u32x4*)(Ow + (size_t)row * ldo + ch * 8) = v; } }
    asm volatile("s_waitcnt lgkmcnt(0)" ::: "memory");
#undef SLOAD
#undef SWRITE
#undef SWAIT
#undef RESC
}
#undef SBAR
}

#define XB_TMO      128
#define XB_XCNT(j)  (256  + 64 * (j))
#define XB_XSUB(j)  (1280 + 64 * (j))
#define XB_XGEN(j)  (2304 + 64 * (j))
#define XB_TOP      3328
#define XB_TOPGEN   3392
#define XCD_BAR_WORDS 3456
#define XB_SPIN_CAP (1u << 18)
__device__ __forceinline__ unsigned xb_ld(unsigned* p)              { return __hip_atomic_load(p, __ATOMIC_RELAXED, __HIP_MEMORY_SCOPE_AGENT); }
__device__ __forceinline__ unsigned xb_add(unsigned* p, unsigned v) { return __hip_atomic_fetch_add(p, v, __ATOMIC_RELAXED, __HIP_MEMORY_SCOPE_AGENT); }
__device__ __forceinline__ unsigned xb_xcc_id() { return (unsigned)__builtin_amdgcn_s_getreg((3 << 11) | 20) & 0xFu; }
#define XB_SPIN(cond, bar) do { unsigned _sp = 0; while (cond) { __builtin_amdgcn_s_sleep(1); \
    if ((++_sp & 255u) == 0u) { if (xb_ld(&(bar)[XB_TMO])) break; if (_sp > XB_SPIN_CAP) { atomicAdd(&(bar)[XB_TMO], 1u); break; } } } } while (0)
struct XcdBarrier { unsigned* bar; unsigned x; volatile LAS unsigned* st; };
__device__ __forceinline__ XcdBarrier xcd_barrier_post(unsigned* bar, volatile LAS unsigned* st) {
    XcdBarrier b; b.bar = bar; b.x = xb_xcc_id(); b.st = st;
    if (threadIdx.x == 0) (void)xb_add(&bar[XB_XCNT(b.x)], 1u);
    return b;
}
__device__ __forceinline__ void xcd_barrier_complete(unsigned* bar, unsigned x, unsigned& nloc, unsigned& nx) {
    const unsigned G = gridDim.x * gridDim.y * gridDim.z;
    unsigned sum, cnt, mine, sp = 0u;
    for (;;) {
        sum = 0u; cnt = 0u; mine = 0u;
#pragma unroll
        for (unsigned j = 0; j < 16; ++j) { const unsigned c = xb_ld(&bar[XB_XCNT(j)]); sum += c; cnt += (c > 0u) ? 1u : 0u; mine = (j == x) ? c : mine; }
        if (sum == G) break;
        __builtin_amdgcn_s_sleep(1);
        if ((++sp & 255u) == 0u) { if (xb_ld(&bar[XB_TMO])) break; if (sp > XB_SPIN_CAP) { atomicAdd(&bar[XB_TMO], 1u); break; } }
    }
    nloc = mine > 0u ? mine : 1u; nx = cnt > 0u ? cnt : 1u;
}
__device__ __forceinline__ void xcd_barrier(const XcdBarrier& b) {
    asm volatile("s_waitcnt vmcnt(0)" ::: "memory");
    __syncthreads();
    if (threadIdx.x == 0) {
        unsigned* bar = b.bar;
        __builtin_amdgcn_s_waitcnt(0);
        unsigned nloc = b.st[0], nx = b.st[1];
        if (nloc == 0u) { xcd_barrier_complete(bar, b.x, nloc, nx); b.st[0] = nloc; b.st[1] = nx; }
        const unsigned old = xb_add(&bar[XB_XSUB(b.x)], 1u);
        const unsigned gen = old / nloc;
        if (old + 1u == (gen + 1u) * nloc) {
            __builtin_amdgcn_fence(__ATOMIC_RELEASE, "agent");
            asm volatile("s_waitcnt vmcnt(0)" ::: "memory");
            const unsigned og = xb_add(&bar[XB_TOP], 1u);
            const unsigned tg = og / nx;
            if (og + 1u == (tg + 1u) * nx) xb_add(&bar[XB_TOPGEN], 1u);
            else XB_SPIN(xb_ld(&bar[XB_TOPGEN]) == tg, bar);
            __builtin_amdgcn_fence(__ATOMIC_ACQUIRE, "agent");
            xb_add(&bar[XB_XGEN(b.x)], 1u);
            asm volatile("s_waitcnt vmcnt(0)" ::: "memory");
        } else {
            XB_SPIN(xb_ld(&bar[XB_XGEN(b.x)]) == gen, bar);
            __builtin_amdgcn_fence(__ATOMIC_ACQUIRE, "agent");
            asm volatile("s_waitcnt vmcnt(0)" ::: "memory");
        }
    }
    __syncthreads();
}

constexpr int RING_BYTES = 131072, LDSCTL_OFF = RING_BYTES, MISC_OFF = LDSCTL_OFF + 320, LDS_BYTES = 147456;
struct Args { const float* in[39]; float* out; unsigned char* ws; int ph_lo, ph_hi; };
enum { I_X = 0, I_C, I_CTX, I_CCTX, I_ADAW, I_ADAB, I_N1G, I_N2G, I_ABWIN, I_ABWOUT, I_MU, I_W0, I_W2, I_A0, I_A2, I_KK, I_KA, I_RK, I_G2, I_LNW, I_LNB,
       I_GQA_, I_WQUP, I_GKVA, I_WKVUP, I_MGQ, I_MGK, I_GWIN, I_GWOUT, I_GGQ, I_GGK, I_RW, I_RBIAS, I_MGATE, I_MUP, I_MDOWN, I_SGATE, I_SUP, I_SDOWN };

struct Ctx {
    LAS unsigned char* lds; int tid, lane, wave, G, bid;
    unsigned char* ws; float* out;
};
__device__ __forceinline__ bool row_is_ctx(int m) { return (m % RB) < CTXL; }
__device__ __forceinline__ float* xl_row(const Ctx& F, int m) {
    const int b = m / RB, j = m % RB;
    return j < CTXL ? (float*)(F.ws + WS_XLC) + (size_t)(b * CTXL + j) * DM : F.out + (size_t)(b * SEQ + j - CTXL) * DM;
}

__device__ __forceinline__ void tr_item(const float* W, int ldn, int k0, int n0, bf16_t* dst, int ldw, LAS float* scr, int lane) {
#pragma unroll 8
    for (int i = 0; i < 32; ++i) { const int kk = 2 * i + (lane >> 5); scr[kk * 33 + (lane & 31)] = W[(size_t)(k0 + kk) * ldn + n0 + (lane & 31)]; }
    LDS_WAIT(); asm volatile("" ::: "memory");
    const int c = lane & 7;
#pragma unroll
    for (int j = 0; j < 4; ++j) { const int n = (lane >> 3) + 8 * j; const LAS float* s = scr + (8 * c) * 33 + n;
        u32x4 o; o.x = pk2(s[0 * 33], s[1 * 33]); o.y = pk2(s[2 * 33], s[3 * 33]); o.z = pk2(s[4 * 33], s[5 * 33]); o.w = pk2(s[6 * 33], s[7 * 33]);
        *(u32x4*)(dst + (size_t)n * ldw + 8 * c) = o; }
    LDS_WAIT(); asm volatile("" ::: "memory");
}
__device__ __forceinline__ void tr_matrix_item(const float* W, int K, int N, bf16_t* dst, int ldw, LAS float* scr, int item, int lane) {
    const int nblk = N / 32, kb = item / nblk, nb = item % nblk;
    tr_item(W, N, 64 * kb, 32 * nb, dst + (size_t)(32 * nb) * ldw + 64 * kb, ldw, scr, lane);
}

__device__ __forceinline__ void norm_mod_row(const float* xrow, const float* g, const float* sh, const float* sc, bf16_t* orow, int lane, f32x4 (&hv)[4]) {
    const f32x4* xr = (const f32x4*)xrow + lane;
    f32x4 v[4]; float s = 0.f;
#pragma unroll
    for (int j = 0; j < 4; ++j) { v[j] = xr[64 * j]; s += (v[j].x * v[j].x + v[j].y * v[j].y) + (v[j].z * v[j].z + v[j].w * v[j].w); }
    const float rstd = 1.f / sqrtf(wave_sum(s) * (1.f / DM) + 1e-6f);
    unsigned long long* o8 = (unsigned long long*)orow + lane;
#pragma unroll
    for (int j = 0; j < 4; ++j) { const f32x4 gg = ((const f32x4*)g)[lane + 64 * j], s1 = ((const f32x4*)sc)[lane + 64 * j], s0 = ((const f32x4*)sh)[lane + 64 * j];
        f32x4 h = (v[j] * rstd * gg) * (s1 + 1.f) + s0; hv[j] = h;
        o8[64 * j] = (unsigned long long)pk2(h.x, h.y) | ((unsigned long long)pk2(h.z, h.w) << 32); }
}

struct SchedDense {
    int nM, nN, G, c; const char* A; const char* B; char* O; size_t a_tile, b_tile, o_tile; int latent_only;
    __device__ __forceinline__ bool next(int i, g8::Unit& u) const {
        int pm, pn; if (!g8::tile_order(i, G, c, nM, nN, pm, pn)) return false;
        if (latent_only) pm = pm + 1 + pm / 32;
        u.a = A + (size_t)pm * a_tile; u.b = B + (size_t)pn * b_tile; u.o = O + (size_t)pm * o_tile; u.pn = pn; u.aux = 0; u.f0 = nullptr; return true;
    }
};
struct SchedRes {
    int nM, nN, G, c; const char* A; const char* B; size_t a_tile, b_tile; int latent_only;
    const float* base_l; const float* base_c; float* out_l; float* out_c;
    __device__ __forceinline__ bool next(int i, g8::Unit& u) const {
        int pm, pn; if (!g8::tile_order(i, G, c, nM, nN, pm, pn)) return false;
        if (latent_only) pm = pm + 1 + pm / 32;
        const int b = pm / 33, t = pm % 33;
        u.a = A + (size_t)pm * a_tile; u.b = B + (size_t)pn * b_tile; u.pn = pn;
        if (t == 0) { u.f0 = base_c + (size_t)(b * CTXL) * DM; u.o = (char*)(out_c + (size_t)(b * CTXL) * DM); u.aux = 2; }
        else { const size_t r0 = (size_t)(b * SEQ + (t - 1) * 256) * DM; u.f0 = base_l + r0; u.o = (char*)(out_l + r0); u.aux = b; }
        return true;
    }
};
struct SchedMoe {
    volatile LAS unsigned* tab;
    const char* HS; const char* HSH; size_t a_tile;
    const char* W; size_t w_exp, w_tile;
    char* O; char* OSH; size_t o_tile;
    const float* rowwt;
    __device__ __forceinline__ bool next(int i, g8::Unit& u) const {
        const int n = __builtin_amdgcn_readfirstlane((int)tab[0]); if (i >= n) return false;
        const unsigned w0 = (unsigned)__builtin_amdgcn_readfirstlane((int)tab[1 + 2 * i]), e = (unsigned)__builtin_amdgcn_readfirstlane((int)tab[2 + 2 * i]);
        const unsigned tile = w0 & 0xffffu, pn = (w0 >> 16) & 0xffu; const bool sh = (w0 >> 31) != 0u;
        u.pn = (int)pn; u.aux = 0;
        u.a = (sh ? HSH : HS) + (size_t)tile * a_tile; u.b = W + (size_t)e * w_exp + (size_t)pn * w_tile; u.o = (sh ? OSH : O) + (size_t)tile * o_tile;
        u.f0 = (sh || !rowwt) ? nullptr : rowwt + (size_t)tile * 256;
        return true;
    }
};
__device__ __forceinline__ void moe_units(volatile LAS unsigned* tab, const unsigned* cnt, int G, int c, int npn, int n_sh, int latent_only) {
    int ts[NE + 1]; int tot = 0;
    for (int e = 0; e < NE; ++e) { ts[e] = tot; tot += (int)((cnt[e * 64] + 255u) >> 8); }
    ts[NE] = tot;
    const int total = (tot + n_sh) * npn; int n = 0;
    for (int i = 0; i < 16; ++i) { const int L = i * G + c; if (L >= total) break;
        const int tile = L / npn, pn = L % npn;
        if (tile < tot) { int e = 0; for (int q = 1; q < NE; ++q) e += (tile >= ts[q]) ? 1 : 0; tab[1 + 2 * n] = (unsigned)tile | ((unsigned)pn << 16); tab[2 + 2 * n] = (unsigned)e; }
        else { const int t2 = tile - tot, pm = latent_only ? t2 + 1 + t2 / 32 : t2; tab[1 + 2 * n] = (unsigned)pm | ((unsigned)pn << 16) | 0x80000000u; tab[2 + 2 * n] = (unsigned)NE; }
        ++n; }
    tab[0] = (unsigned)n;
}

#define IN(k) (lo <= (k) && (k) < hi)
#define SEAM(k) do { if (N_LAUNCH_MODE == 1 && IN((k) + 1)) xcd_barrier(bar); } while (0)
template <int L>
__device__ __forceinline__ void moe_block(const Args& args, const Ctx& F, const XcdBarrier& bar, const int lo, const int hi) {
    const int gw = F.bid * NWAVES + F.wave, NGW = F.G * NWAVES, lane = F.lane, tid = F.tid;
    unsigned char* ws = F.ws; unsigned* ctl = (unsigned*)(ws + WS_CTL); float* MODS = (float*)(ws + SM_MODS);
    volatile LAS unsigned* MISC = (volatile LAS unsigned*)(F.lds + MISC_OFF);
    constexpr int l = L, pb = L == 0 ? 9 : 18, NROW = L == 0 ? T : 2 * SEQ;
    unsigned* cnt = ctl + CW_CNT + l * 1024;
    bf16_t* MW1 = (bf16_t*)(ws + WS_B); bf16_t* MW2 = MW1 + (size_t)17 * 512 * 1024;
    if (CT(9) && IN(pb + 0)) {
        LAS float* rwT = (LAS float*)F.lds;
        for (int i = tid; i < 16384; i += NTHR) { const int k = i >> 4, e = i & 15; rwT[e * 1024 + k] = args.in[I_RW][i]; }
        __syncthreads();
        bf16_t* H = (bf16_t*)(ws + WS_A); int* SEL = (int*)(ws + SM_SEL); float* WTS = (float*)(ws + SM_WTS);
        const float rbias_l = lane < 16 ? args.in[I_RBIAS][lane] : 0.f;
        for (int r = gw; r < NROW; r += NGW) { const int m = l == 0 ? r : (r / SEQ) * RB + CTXL + r % SEQ; const int b = m / RB; const bool cx = (m % RB) < CTXL;
            const float* md = MODS + (l * 3 + (cx ? 2 : b)) * 6144; f32x4 hv[4];
            norm_mod_row(xl_row(F, m), args.in[I_N2G] + l * 1024, md + 3 * 1024, md + 4 * 1024, H + (size_t)m * DM, lane, hv);
            float mylg = 0.f;
#pragma unroll 2
            for (int e = 0; e < 16; ++e) { float a = 0.f;
#pragma unroll
                for (int j = 0; j < 4; ++j) { const f32x4 w = *(const LAS f32x4*)(rwT + e * 1024 + 4 * lane + 256 * j); a += hv[j].x * w.x + hv[j].y * w.y + hv[j].z * w.z + hv[j].w * w.w; }
                a = wave_sum(a); mylg = lane == e ? a : mylg; }
            const float mysc = 1.f / (1.f + __expf(-mylg)), mybs = mysc + rbias_l;
            float sc[16], bs[16];
#pragma unroll
            for (int e = 0; e < 16; ++e) { sc[e] = __int_as_float(__builtin_amdgcn_readlane(__float_as_int(mysc), e)); bs[e] = __int_as_float(__builtin_amdgcn_readlane(__float_as_int(mybs), e)); }
            int grp = 0; float best = -1e30f;
#pragma unroll
            for (int g = 0; g < 4; ++g) { float m1 = -1e30f, m2 = -1e30f;
#pragma unroll
                for (int q = 0; q < 4; ++q) { const float v = bs[g * 4 + q]; if (v > m1) { m2 = m1; m1 = v; } else if (v > m2) m2 = v; }
                const float gs = m1 + m2; if (gs > best) { best = gs; grp = g; } }
            float v4[4], s4[4];
#pragma unroll
            for (int q = 0; q < 4; ++q) { v4[q] = grp == 0 ? bs[q] : grp == 1 ? bs[4 + q] : grp == 2 ? bs[8 + q] : bs[12 + q]; s4[q] = grp == 0 ? sc[q] : grp == 1 ? sc[4 + q] : grp == 2 ? sc[8 + q] : sc[12 + q]; }
            int i0 = 0; float bv0 = v4[0];
#pragma unroll
            for (int q = 1; q < 4; ++q) if (v4[q] > bv0) { bv0 = v4[q]; i0 = q; }
            int i1 = -1; float bv1 = -1e30f;
#pragma unroll
            for (int q = 0; q < 4; ++q) if (q != i0 && v4[q] > bv1) { bv1 = v4[q]; i1 = q; }
            float w0 = 0.f, w1 = 0.f;
#pragma unroll
            for (int q = 0; q < 4; ++q) { w0 = q == i0 ? s4[q] : w0; w1 = q == i1 ? s4[q] : w1; }
            const float ws_ = 1.f / (w0 + w1);
            if (lane == 0) { const int e0 = grp * 4 + i0, e1 = grp * 4 + i1;
                const int s0 = (int)atomicAdd(cnt + e0 * 64, 1u), s1 = (int)atomicAdd(cnt + e1 * 64, 1u);
                *(int4*)(SEL + (size_t)m * 4) = make_int4(e0, s0, e1, s1); *(float2*)(WTS + (size_t)m * 2) = make_float2(w0 * ws_, w1 * ws_); }
        }
        __syncthreads();
        LAS float* scr = (LAS float*)(F.lds + F.wave * 12288);
        for (int it = gw; it < 17 * 384; it += NGW) { const int e = it / 384, r = it % 384;
            if (r < 256) { const int isup = r >> 7, rr = r & 127, kb = rr >> 3, nb = rr & 7;
                const float* W = e < 16 ? (isup ? args.in[I_MUP] : args.in[I_MGATE]) + ((size_t)l * 16 + e) * 1024 * 256 : (isup ? args.in[I_SUP] : args.in[I_SGATE]) + (size_t)l * 1024 * 256;
                const int f0 = nb * 32, drow = (f0 >> 7) * 256 + isup * 128 + (f0 & 127);
                tr_item(W, 256, kb * 64, f0, MW1 + (size_t)e * 512 * 1024 + (size_t)drow * 1024 + kb * 64, 1024, scr, lane); }
            else { const int rr = r - 256, kb = rr >> 5, nb = rr & 31;
                const float* W = e < 16 ? args.in[I_MDOWN] + ((size_t)l * 16 + e) * 256 * 1024 : args.in[I_SDOWN] + (size_t)l * 256 * 1024;
                tr_item(W, 1024, kb * 64, nb * 32, MW2 + (size_t)e * 1024 * 256 + (size_t)(nb * 32) * 256 + kb * 64, 256, scr, lane); } }
        SEAM(pb + 0);
    }
    if (CT(10) && IN(pb + 1)) {
        const bf16_t* H = (const bf16_t*)(ws + WS_A); bf16_t* HSb = (bf16_t*)(ws + WS_C); const int* SEL = (const int*)(ws + SM_SEL); const float* WTS = (const float*)(ws + SM_WTS);
        int* POS = (int*)(ws + SM_POS); float* ROWWT = (float*)(ws + SM_ROWWT);
        int seg[16]; { int tot = 0;
#pragma unroll
            for (int e = 0; e < 16; ++e) { seg[e] = tot; tot += (int)((cnt[e * 64] + 255u) & ~255u); } }
        for (int r = gw; r < NROW; r += NGW) { const int m = l == 0 ? r : (r / SEQ) * RB + CTXL + r % SEQ;
            const int4 s = *(const int4*)(SEL + (size_t)m * 4); const float2 w = *(const float2*)(WTS + (size_t)m * 2);
            int d0 = 0, d1 = 0;
#pragma unroll
            for (int e = 0; e < 16; ++e) { d0 = s.x == e ? seg[e] : d0; d1 = s.z == e ? seg[e] : d1; }
            d0 += s.y; d1 += s.w;
            const u32x4* src = (const u32x4*)(H + (size_t)m * DM) + lane; u32x4* p0 = (u32x4*)(HSb + (size_t)d0 * DM) + lane; u32x4* p1 = (u32x4*)(HSb + (size_t)d1 * DM) + lane;
            const u32x4 a = src[0], c = src[64]; p0[0] = a; p0[64] = c; p1[0] = a; p1[64] = c;
            if (lane == 0) { POS[(size_t)m * 2] = d0; POS[(size_t)m * 2 + 1] = d1; ROWWT[d0] = w.x; ROWWT[d1] = w.y; } }
        SEAM(pb + 1);
    }
    if (CT(11) && IN(pb + 2)) {
        if (tid == 0) moe_units(MISC + 16, cnt, F.G, F.bid, 2, l == 0 ? 66 : 64, l);
        __syncthreads();
        SchedMoe S{MISC + 16, (const char*)(ws + WS_C), (const char*)(ws + WS_A), (size_t)256 * 1024 * 2,
                   (const char*)MW1, (size_t)512 * 1024 * 2, (size_t)256 * 1024 * 2, (char*)(ws + WS_ACT), (char*)(ws + WS_ACT) + (size_t)HS_ROWS * 512, (size_t)256 * 512, (const float*)(ws + SM_ROWWT)};
        g8::EpiSwiGLU E{};
        g8::gemm_phase(F.lds, 1024, S, E);
        SEAM(pb + 2);
    }
    if (CT(12) && IN(pb + 3)) {
        if (tid == 0) moe_units(MISC + 16, cnt, F.G, F.bid, 4, l == 0 ? 66 : 64, l);
        __syncthreads();
        SchedMoe S{MISC + 16, (const char*)(ws + WS_ACT), (const char*)(ws + WS_ACT) + (size_t)HS_ROWS * 512, (size_t)256 * 256 * 2,
                   (const char*)MW2, (size_t)1024 * 256 * 2, (size_t)256 * 256 * 2, (char*)(ws + WS_C), (char*)(ws + WS_A), (size_t)256 * 1024 * 2, nullptr};
        g8::EpiStoreBf16 E{1024, nullptr, 0};
        g8::gemm_phase(F.lds, 256, S, E);
        SEAM(pb + 3);
    }
    if (CT(13) && IN(pb + 4)) {
        const bf16_t* YS = (const bf16_t*)(ws + WS_C); bf16_t* YSH = (bf16_t*)(ws + WS_A); const int* POS = (const int*)(ws + SM_POS);
        for (int r = gw; r < NROW; r += NGW) { const int m = l == 0 ? r : (r / SEQ) * RB + CTXL + r % SEQ; const int b = m / RB; const bool cx = (m % RB) < CTXL;
            const float* ga2 = MODS + (l * 3 + (cx ? 2 : b)) * 6144 + 5 * 1024;
            const int d0 = POS[(size_t)m * 2], d1 = POS[(size_t)m * 2 + 1];
            float* xr = xl_row(F, m);
            const u32x2* y0 = (const u32x2*)(YS + (size_t)d0 * DM) + lane; const u32x2* y1 = (const u32x2*)(YS + (size_t)d1 * DM) + lane; const u32x2* y2 = (const u32x2*)(YSH + (size_t)m * DM) + lane;
            f32x4 v[4]; float ss = 0.f;
#pragma unroll
            for (int j = 0; j < 4; ++j) { const u32x2 a = y0[64 * j], c = y1[64 * j], d = y2[64 * j]; const f32x4 g = ((const f32x4*)ga2)[lane + 64 * j]; f32x4 x = ((const f32x4*)xr)[lane + 64 * j];
                x.x += g.x * (lo2f(a.x) + lo2f(c.x) + lo2f(d.x)); x.y += g.y * (hi2f(a.x) + hi2f(c.x) + hi2f(d.x)); x.z += g.z * (lo2f(a.y) + lo2f(c.y) + lo2f(d.y)); x.w += g.w * (hi2f(a.y) + hi2f(c.y) + hi2f(d.y));
                ((f32x4*)xr)[lane + 64 * j] = x; v[j] = x; ss += (x.x * x.x + x.y * x.y) + (x.z * x.z + x.w * x.w); }
            if (l == 0) { const float rstd = 1.f / sqrtf(wave_sum(ss) * (1.f / DM) + 1e-6f); const float* md = MODS + (1 * 3 + (cx ? 2 : b)) * 6144; const float* g1 = args.in[I_N1G] + 1024;
                unsigned long long* o8 = (unsigned long long*)(YSH + (size_t)m * DM) + lane;
#pragma unroll
                for (int j = 0; j < 4; ++j) { const f32x4 gg = ((const f32x4*)g1)[lane + 64 * j], s1 = ((const f32x4*)(md + 1024))[lane + 64 * j], s0 = ((const f32x4*)md)[lane + 64 * j];
                    const f32x4 h = (v[j] * rstd * gg) * (s1 + 1.f) + s0; o8[64 * j] = (unsigned long long)pk2(h.x, h.y) | ((unsigned long long)pk2(h.z, h.w) << 32); } }
        }
        SEAM(pb + 4);
    }
}

__global__ void __launch_bounds__(NTHR, 2) fwd_kernel(Args args) {
    extern __shared__ __attribute__((aligned(16))) unsigned char lds_raw[];
    Ctx F; F.lds = (LAS unsigned char*)lds_raw; F.tid = threadIdx.x; F.lane = F.tid & 63; F.wave = __builtin_amdgcn_readfirstlane(F.tid >> 6);
    F.G = gridDim.x; F.bid = blockIdx.x; F.ws = args.ws; F.out = args.out;
    volatile LAS unsigned* MISC = (volatile LAS unsigned*)(F.lds + MISC_OFF);
    unsigned* ctl = (unsigned*)(F.ws + WS_CTL);
    for (int u = F.tid; u < (LDS_BYTES - LDSCTL_OFF) / 4; u += NTHR) ((LAS unsigned*)(F.lds + LDSCTL_OFF))[u] = 0u;
    __syncthreads();
    XcdBarrier bar; bar.bar = ctl + CW_BAR; bar.x = 0; bar.st = nullptr;
    if (N_LAUNCH_MODE == 1) bar = xcd_barrier_post(ctl + CW_BAR, MISC + 8);
    const int lo = args.ph_lo, hi = args.ph_hi;
    const int gw = F.bid * NWAVES + F.wave, NGW = F.G * NWAVES, lane = F.lane, tid = F.tid;
    unsigned char* ws = F.ws;
    float* MODS = (float*)(ws + SM_MODS);
    bf16_t* WD = (bf16_t*)(ws + WS_WD);

    if (CT(0) && IN(0)) {
        if (F.bid < 192) {
            LAS float* sl = (LAS float*)F.lds;
            for (int i = tid; i < 3072; i += NTHR) { const int v = i >> 10, k = i & 1023; const float x = v < 2 ? args.in[I_C][v * 1024 + k] : args.in[I_CCTX][k]; sl[i] = x * sigmoidf_(x); }
            __syncthreads();
            const int l = F.bid / 96, n0 = (F.bid % 96) * 64, ks = tid >> 6, nl = tid & 63;
            const float* W = args.in[I_ADAW] + (size_t)l * 1024 * 6144 + n0 + nl;
            float a0 = 0.f, a1 = 0.f, a2 = 0.f;
#pragma unroll 8
            for (int k = ks * 128; k < ks * 128 + 128; ++k) { const float w = W[(size_t)k * 6144]; a0 += sl[k] * w; a1 += sl[1024 + k] * w; a2 += sl[2048 + k] * w; }
            LAS float* part = sl + 3072;
            part[(ks * 3 + 0) * 64 + nl] = a0; part[(ks * 3 + 1) * 64 + nl] = a1; part[(ks * 3 + 2) * 64 + nl] = a2;
            __syncthreads();
            if (tid < 192) { const int v = tid >> 6, n = tid & 63; float s = args.in[I_ADAB][l * 6144 + n0 + n];
#pragma unroll
                for (int q = 0; q < 8; ++q) s += part[(q * 3 + v) * 64 + n];
                MODS[(l * 3 + v) * 6144 + n0 + n] = s; }
            __syncthreads();
        }
        if (F.bid == 192) { float* bz = (float*)(ws + SM_BIASZ);
            for (int i = tid; i < 2560; i += NTHR) bz[i] = i < 1024 ? args.in[I_W0][i] : (i < 2048 ? args.in[I_A0][i - 1024] : 0.f); }
        LAS float* scr = (LAS float*)(F.lds + 32768 + F.wave * 12288);
        constexpr int I1 = 16 * 81, I2 = 16 * 32, I3 = 16, I4 = 32, I5 = 6 * 24, I6 = 4 * 32, I7 = 16 * 48, I8 = 16 * 32;
        constexpr int NIT = I1 + I2 + 4 * I3 + I4 + I5 + I6 + I7 + I8;
        for (int it = gw; it < NIT; it += NGW) {
            int r = it;
            if (r < I1) { tr_matrix_item(args.in[I_ABWIN], 1024, 2592, WD + O_WIN0 / 2, 1024, scr, r, lane); continue; } r -= I1;
            if (r < I2) { tr_matrix_item(args.in[I_ABWOUT], 1024, 1024, WD + O_WOUT0 / 2, 1024, scr, r, lane); continue; } r -= I2;
            if (r < I3) { tr_matrix_item(args.in[I_W2], 64, 512, WD + O_WLORA / 2 + (size_t)0 * 384 + 0, 384, scr, r, lane); continue; } r -= I3;
            if (r < I3) { tr_matrix_item(args.in[I_W2] + 64 * 512, 64, 512, WD + O_WLORA / 2 + (size_t)512 * 384 + 64, 384, scr, r, lane); continue; } r -= I3;
            if (r < I3) { tr_matrix_item(args.in[I_A2], 64, 512, WD + O_WLORA / 2 + (size_t)1024 * 384 + 128, 384, scr, r, lane); continue; } r -= I3;
            if (r < I3) { tr_matrix_item(args.in[I_A2] + 64 * 512, 64, 512, WD + O_WLORA / 2 + (size_t)1536 * 384 + 192, 384, scr, r, lane); continue; } r -= I3;
            if (r < I4) { tr_matrix_item(args.in[I_G2], 128, 512, WD + O_WLORA / 2 + (size_t)2048 * 384 + 256, 384, scr, r, lane); continue; } r -= I4;
            if (r < I5) { tr_matrix_item(args.in[I_WQUP], 384, 768, WD + O_WQUP / 2, 384, scr, r, lane); continue; } r -= I5;
            if (r < I6) { tr_matrix_item(args.in[I_WKVUP], 256, 1024, WD + O_WKVUP / 2, 256, scr, r, lane); continue; } r -= I6;
            if (r < I7) { tr_matrix_item(args.in[I_GWIN], 1024, 1536, WD + O_WIN1 / 2, 1024, scr, r, lane); continue; } r -= I7;
            tr_matrix_item(args.in[I_GWOUT], 1024, 1024, WD + O_WOUT1 / 2, 1024, scr, r, lane);
        }
        { const int gt = F.bid * NTHR + tid, NGT = F.G * NTHR; const u32x4 z = {0u, 0u, 0u, 0u};
          for (int i = gt; i < 224 * 128; i += NGT) *(u32x4*)(WD + O_WIN0 / 2 + (size_t)2592 * 1024 + (size_t)i * 8) = z;
          for (int i = gt; i < 2560 * 48; i += NGT) { const int n = i / 48, ch = i % 48, blk = n >> 9; const int klo = blk < 4 ? blk * 64 : 256, khi = blk < 4 ? klo + 64 : 384;
              if (ch * 8 < klo || ch * 8 >= khi) *(u32x4*)(WD + O_WLORA / 2 + (size_t)n * 384 + ch * 8) = z; } }
        SEAM(0);
    }

    if (CT(1) && IN(1)) {
        bf16_t* H = (bf16_t*)(ws + WS_A);
        for (int m = gw; m < T; m += NGW) { const int b = m / RB, j = m % RB; const bool cx = j < CTXL;
            const float* xr = cx ? args.in[I_CTX] + (size_t)(b * CTXL + j) * DM : args.in[I_X] + (size_t)(b * SEQ + j - CTXL) * DM;
            const float* md = MODS + (0 * 3 + (cx ? 2 : b)) * 6144; f32x4 hv[4];
            norm_mod_row(xr, args.in[I_N1G], md, md + 1024, H + (size_t)m * DM, lane, hv); }
        SEAM(1);
    }
    if (CT(2) && IN(2)) {
        SchedDense S{66, 11, F.G, F.bid, (const char*)(ws + WS_A), (const char*)(WD + O_WIN0 / 2), (char*)(ws + WS_C), (size_t)256 * 1024 * 2, (size_t)256 * 1024 * 2, (size_t)256 * 2816 * 2, 0};
        g8::EpiStoreBf16 E{2816, nullptr, 0};
        g8::gemm_phase(F.lds, 1024, S, E);
        SEAM(2);
    }
    if (CT(3) && IN(3)) {
        const bf16_t* P = (const bf16_t*)(ws + WS_C);
        bf16_t* Rb = (bf16_t*)(ws + WS_B); bf16_t* Kb = Rb + (size_t)T * 512; bf16_t* Vb = Kb + (size_t)T * 512;
        bf16_t* LIN = (bf16_t*)(ws + WS_A); bf16_t* QAN = LIN + (size_t)T * 384; bf16_t* KVAN = QAN + (size_t)T * 384;
        float* KROPE = (float*)(ws + WS_KROPE);
        const float* mu = args.in[I_MU];
        for (int m = gw; m < T; m += NGW) { const int j = m % RB;
            const bool hasp = !(j == 0 || j == CTXL), hasn = !(j == CTXL - 1 || j == RB - 1);
            const bf16_t* pr = P + (size_t)m * 2816;
#pragma unroll 1
            for (int ch = lane; ch < 240; ch += 64) {
                const u32x4 pc = *(const u32x4*)(pr + ch * 8);
                u32x4 pp = {0u, 0u, 0u, 0u}, pn = {0u, 0u, 0u, 0u};
                if (hasp) pp = *(const u32x4*)(pr - 2816 + ch * 8);
                if (hasn) pn = *(const u32x4*)(pr + 2816 + ch * 8);
                const f32x4 m0 = *(const f32x4*)(mu + ch * 8), m1 = *(const f32x4*)(mu + ch * 8 + 4);
                float o[8];
#pragma unroll
                for (int q = 0; q < 4; ++q) { const unsigned c = pc[q], a = pp[q], n = pn[q];
                    const float c0 = lo2f(c), c1 = hi2f(c), mm0 = q < 2 ? m0[2 * q] : m1[2 * q - 4], mm1 = q < 2 ? m0[2 * q + 1] : m1[2 * q - 3];
                    o[2 * q] = c0 + mm0 * (0.5f * (lo2f(a) + lo2f(n)) - c0); o[2 * q + 1] = c1 + mm1 * (0.5f * (hi2f(a) + hi2f(n)) - c1); }
                bf16_t* dst;
                if (ch < 64) dst = Rb + (size_t)m * 512 + ch * 8;
                else if (ch < 128) dst = Kb + (size_t)m * 512 + (ch - 64) * 8;
                else if (ch < 192) dst = Vb + (size_t)m * 512 + (ch - 128) * 8;
                else { dst = LIN + (size_t)m * 384 + (ch - 192) * 8;
                    if (ch < 208) {
#pragma unroll
                        for (int q = 0; q < 8; ++q) { const float e = __expf(-2.f * fabsf(o[q])); const float th = (1.f - e) * __builtin_amdgcn_rcpf(1.f + e); o[q] = o[q] < 0.f ? -th : th; } }
                    else if (ch >= 224) {
#pragma unroll
                        for (int q = 0; q < 8; ++q) o[q] = sigmoidf_(o[q]); } }
                u32x4 w; w.x = pk2(o[0], o[1]); w.y = pk2(o[2], o[3]); w.z = pk2(o[4], o[5]); w.w = pk2(o[6], o[7]);
                *(u32x4*)dst = w;
            }
            { float q[8], ss = 0.f; const bool act = lane < 48;
              const u32x4 pc = act ? *(const u32x4*)(pr + 1920 + lane * 8) : (u32x4){0u, 0u, 0u, 0u};
#pragma unroll
              for (int i = 0; i < 4; ++i) { q[2 * i] = lo2f(pc[i]); q[2 * i + 1] = hi2f(pc[i]); ss += q[2 * i] * q[2 * i] + q[2 * i + 1] * q[2 * i + 1]; }
              const float rstd = 1.f / sqrtf(wave_sum(ss) * (1.f / 384.f) + 1e-6f);
              if (act) { const float* g = args.in[I_GQA_] + lane * 8; u32x4 w; w.x = pk2(q[0] * rstd * g[0], q[1] * rstd * g[1]); w.y = pk2(q[2] * rstd * g[2], q[3] * rstd * g[3]);
                  w.z = pk2(q[4] * rstd * g[4], q[5] * rstd * g[5]); w.w = pk2(q[6] * rstd * g[6], q[7] * rstd * g[7]); *(u32x4*)(QAN + (size_t)m * 384 + lane * 8) = w; } }
            { float q[8], ss = 0.f; const bool act = lane < 32;
              const u32x4 pc = act ? *(const u32x4*)(pr + 2304 + lane * 8) : (u32x4){0u, 0u, 0u, 0u};
#pragma unroll
              for (int i = 0; i < 4; ++i) { q[2 * i] = lo2f(pc[i]); q[2 * i + 1] = hi2f(pc[i]); ss += q[2 * i] * q[2 * i] + q[2 * i + 1] * q[2 * i + 1]; }
              const float rstd = 1.f / sqrtf(wave_sum(ss) * (1.f / 256.f) + 1e-6f);
              if (act) { const float* g = args.in[I_GKVA] + lane * 8; u32x4 w; w.x = pk2(q[0] * rstd * g[0], q[1] * rstd * g[1]); w.y = pk2(q[2] * rstd * g[2], q[3] * rstd * g[3]);
                  w.z = pk2(q[4] * rstd * g[4], q[5] * rstd * g[5]); w.w = pk2(q[6] * rstd * g[6], q[7] * rstd * g[7]); *(u32x4*)(KVAN + (size_t)m * 256 + lane * 8) = w; } }
            if (lane < 32) KROPE[(size_t)m * 32 + lane] = bf2f(pr[2560 + lane]);
        }
        SEAM(3);
    }
    if (CT(4) && IN(4)) {
        { SchedDense S{66, 10, F.G, F.bid, (const char*)(ws + WS_A), (const char*)(WD + O_WLORA / 2), (char*)(ws + WS_C), (size_t)256 * 384 * 2, (size_t)256 * 384 * 2, (size_t)256 * 2560 * 2, 0};
          g8::EpiStoreBf16 E{2560, (const float*)(ws + SM_BIASZ), 2048};
          g8::gemm_phase(F.lds, 384, S, E); }
        { SchedDense S{66, 3, F.G, F.bid, (const char*)(ws + WS_A + SZ384), (const char*)(WD + O_WQUP / 2), (char*)(ws + WS_D), (size_t)256 * 384 * 2, (size_t)256 * 384 * 2, (size_t)256 * 768 * 2, 0};
          g8::EpiStoreBf16 E{768, nullptr, 0};
          g8::gemm_phase(F.lds, 384, S, E); }
        { SchedDense S{66, 4, F.G, F.bid, (const char*)(ws + WS_A + 2 * SZ384), (const char*)(WD + O_WKVUP / 2), (char*)(ws + WS_D + SZ768), (size_t)256 * 256 * 2, (size_t)256 * 256 * 2, (size_t)256 * 1024 * 2, 0};
          g8::EpiStoreBf16 E{1024, nullptr, 0};
          g8::gemm_phase(F.lds, 256, S, E); }
        SEAM(4);
    }
    if (CT(5) && IN(5)) {
        const bf16_t* QRAW = (const bf16_t*)(ws + WS_D); const bf16_t* KVRAW = (const bf16_t*)(ws + WS_D + SZ768); const float* KROPE = (const float*)(ws + WS_KROPE);
        bf16_t* Qm = (bf16_t*)F.out; bf16_t* Km = Qm + (size_t)T * 768; bf16_t* Vm = (bf16_t*)(ws + WS_A);
        const int h = lane >> 3, s = lane & 7;
        const float inv = __powf(10000.f, -(float)s * 0.125f);
        float gq[12], gk[12];
#pragma unroll
        for (int i = 0; i < 12; ++i) { gq[i] = args.in[I_MGQ][s + 8 * i]; gk[i] = args.in[I_MGK][s + 8 * i]; }
        for (int m = gw; m < T; m += NGW) { const int j = m % RB; const bool lat = j >= CTXL;
            float cr = 1.f, sr = 0.f, cc = 1.f, sc = 0.f;
            if (lat) { const int sp = j - CTXL; const float pr_ = (float)(sp >> 6), pc_ = (float)(sp & 63); sincosf(pr_ * inv, &sr, &cr); sincosf(pc_ * inv, &sc, &cc); }
            float q[12], k[12], ssq = 0.f, ssk = 0.f;
#pragma unroll
            for (int i = 0; i < 12; ++i) { q[i] = bf2f(QRAW[(size_t)m * 768 + h * 96 + s + 8 * i]); ssq += q[i] * q[i]; }
#pragma unroll
            for (int i = 0; i < 8; ++i) k[i] = bf2f(KVRAW[(size_t)m * 1024 + h * 128 + s + 8 * i]);
#pragma unroll
            for (int i = 8; i < 12; ++i) k[i] = KROPE[(size_t)m * 32 + s + 8 * (i - 8)];
#pragma unroll
            for (int i = 0; i < 12; ++i) ssk += k[i] * k[i];
            ssq += __shfl_xor(ssq, 1); ssq += __shfl_xor(ssq, 2); ssq += __shfl_xor(ssq, 4);
            ssk += __shfl_xor(ssk, 1); ssk += __shfl_xor(ssk, 2); ssk += __shfl_xor(ssk, 4);
            const float rq = 1.f / sqrtf(ssq * (1.f / 96.f) + 1e-6f), rk = 1.f / sqrtf(ssk * (1.f / 96.f) + 1e-6f);
#pragma unroll
            for (int i = 0; i < 12; ++i) { q[i] = q[i] * rq * gq[i]; k[i] = k[i] * rk * gk[i]; }
            { const float a = q[8], b2 = q[9]; q[8] = a * cr - b2 * sr; q[9] = b2 * cr + a * sr; const float c = q[10], d = q[11]; q[10] = c * cc - d * sc; q[11] = d * cc + c * sc; }
            { const float a = k[8], b2 = k[9]; k[8] = a * cr - b2 * sr; k[9] = b2 * cr + a * sr; const float c = k[10], d = k[11]; k[10] = c * cc - d * sc; k[11] = d * cc + c * sc; }
#pragma unroll
            for (int i = 0; i < 12; ++i) { Qm[(size_t)m * 768 + h * 96 + s + 8 * i] = (bf16_t)(pk2(q[i] * C2_MLA, 0.f) & 0xffffu); Km[(size_t)m * 768 + h * 96 + s + 8 * i] = (bf16_t)(pk2(k[i], 0.f) & 0xffffu); }
#pragma unroll
            for (int i = 0; i < 8; ++i) Vm[(size_t)m * 512 + h * 64 + s + 8 * i] = KVRAW[(size_t)m * 1024 + h * 128 + 64 + s + 8 * i];
        }
        SEAM(5);
    }
    if (CT(6) && IN(6)) {
        unsigned* queue = ctl + CW_QUEUE;
        if (F.bid < 64) {
            const int sid = F.bid, b = sid >> 5, h = (sid >> 2) & 7, dir = (sid >> 1) & 1, half = sid & 1;
            const bf16_t* Rb = (const bf16_t*)(ws + WS_B); const bf16_t* Kb = Rb + (size_t)T * 512; const bf16_t* Vb = Kb + (size_t)T * 512; const bf16_t* ZZ = (const bf16_t*)(ws + WS_C);
            bf16_t* Y = dir == 0 ? (bf16_t*)(ws + WS_A + SZ512) : (bf16_t*)(ws + WS_YB);
            LAS float* OPS = (LAS float*)F.lds;
            LAS float* VV = OPS + 2 * 32 * 320;
            LAS float* BK = VV + 2 * 32 * 64;
            LAS float* YB = BK + 2 * 32 * 2;
            const int tok = tid >> 4, cgs = tid & 15;
            const int wv = F.wave, r4 = lane >> 4, cg = lane & 15, rloc = wv * 4 + r4, irow = half * 32 + rloc;
            float kkp[4], kap[4];
#pragma unroll
            for (int i = 0; i < 4; ++i) { kkp[i] = args.in[I_KK][h * 64 + 4 * cgs + i]; kap[i] = args.in[I_KA][h * 64 + 4 * cgs + i]; }
            u32x2 g_r, g_k, g_v, g_s, g_a;
#define SC_ROW(s_) (b * RB + (dir == 0 ? (s_) : ((s_) < CTXL ? CTXL - 1 - (s_) : RB + CTXL - 1 - (s_))))
#define SC_LOAD(c_) do { const int m_ = SC_ROW((c_) * 32 + tok); const size_t o5 = (size_t)m_ * 512 + h * 64 + 4 * cgs, oz = (size_t)m_ * 2560 + dir * 512 + h * 64 + 4 * cgs; \
        g_r = *(const u32x2*)(Rb + o5); g_k = *(const u32x2*)(Kb + o5); g_v = *(const u32x2*)(Vb + o5); g_s = *(const u32x2*)(ZZ + oz); g_a = *(const u32x2*)(ZZ + oz + 1024); } while (0)
#define SC_WRITE(bf_) do { float r_[4] = {lo2f(g_r.x), hi2f(g_r.x), lo2f(g_r.y), hi2f(g_r.y)}, k_[4] = {lo2f(g_k.x), hi2f(g_k.x), lo2f(g_k.y), hi2f(g_k.y)}, v_[4] = {lo2f(g_v.x), hi2f(g_v.x), lo2f(g_v.y), hi2f(g_v.y)}; \
        float s_[4] = {lo2f(g_s.x), hi2f(g_s.x), lo2f(g_s.y), hi2f(g_s.y)}, a_[4] = {lo2f(g_a.x), hi2f(g_a.x), lo2f(g_a.y), hi2f(g_a.y)}; \
        float ku[4], ss = 0.f; _Pragma("unroll") for (int i = 0; i < 4; ++i) { ku[i] = k_[i] * kkp[i]; ss += ku[i] * ku[i]; } \
        ss = rowsum16(ss); const float inv_ = 1.f / sqrtf(ss + 1e-12f); \
        f32x4 oa, ow, ob, okd, owr; float br_ = 0.f, kr_ = 0.f; \
        _Pragma("unroll") for (int i = 0; i < 4; ++i) { const float kn = ku[i] * inv_, w_ = __expf(-0.6065306597126334f * s_[i]), bb = kn * a_[i], kd = k_[i] * (1.f + (a_[i] - 1.f) * kap[i]); \
            oa[i] = -kn; ow[i] = w_; ob[i] = bb; okd[i] = kd; owr[i] = w_ * r_[i]; br_ += bb * r_[i]; kr_ += kd * r_[i]; } \
        br_ = rowsum16(br_); kr_ = rowsum16(kr_); \
        LAS float* op_ = OPS + ((bf_) * 32 + tok) * 320 + 4 * cgs; \
        *(LAS f32x4*)(op_) = oa; *(LAS f32x4*)(op_ + 64) = ow; *(LAS f32x4*)(op_ + 128) = ob; *(LAS f32x4*)(op_ + 192) = okd; *(LAS f32x4*)(op_ + 256) = owr; \
        *(LAS f32x4*)(VV + ((bf_) * 32 + tok) * 64 + 4 * cgs) = (f32x4){v_[0], v_[1], v_[2], v_[3]}; \
        if (cgs == 0) { BK[((bf_) * 32 + tok) * 2] = br_; BK[((bf_) * 32 + tok) * 2 + 1] = kr_; } } while (0)
            float S0 = 0.f, S1 = 0.f, S2 = 0.f, S3 = 0.f;
            SC_LOAD(0); SC_WRITE(0); __syncthreads();
            constexpr int NCHUNK = RB / 32;
            for (int c = 0; c < NCHUNK; ++c) {
                const int bf = c & 1;
                if (c + 1 < NCHUNK) SC_LOAD(c + 1);
#pragma unroll 4
                for (int t = 0; t < 32; ++t) {
                    const LAS float* op = OPS + (bf * 32 + t) * 320 + 4 * cg;
                    const f32x4 a4 = *(const LAS f32x4*)(op), w4 = *(const LAS f32x4*)(op + 64), b4 = *(const LAS f32x4*)(op + 128), k4 = *(const LAS f32x4*)(op + 192), wr4 = *(const LAS f32x4*)(op + 256);
                    const float v = VV[(bf * 32 + t) * 64 + irow]; const f32x2 bk = *(const LAS f32x2*)(BK + (bf * 32 + t) * 2);
                    float p = S0 * a4[0] + S1 * a4[1] + S2 * a4[2] + S3 * a4[3];
                    float q = S0 * wr4[0] + S1 * wr4[1] + S2 * wr4[2] + S3 * wr4[3];
                    p = rowsum16(p); q = rowsum16(q);
                    const float y = q + p * bk[0] + v * bk[1];
                    S0 = S0 * w4[0] + p * b4[0] + v * k4[0]; S1 = S1 * w4[1] + p * b4[1] + v * k4[1]; S2 = S2 * w4[2] + p * b4[2] + v * k4[2]; S3 = S3 * w4[3] + p * b4[3] + v * k4[3];
                    if (cg == 0) YB[t * 32 + rloc] = y;
                }
                __syncthreads();
                { const int t = tid >> 4, rp = (tid & 15) * 2; const int m_ = SC_ROW(c * 32 + t);
                  *(unsigned*)(Y + (size_t)m_ * 512 + h * 64 + half * 32 + rp) = pk2(YB[t * 32 + rp], YB[t * 32 + rp + 1]); }
                if (c + 1 < NCHUNK) SC_WRITE((c + 1) & 1);
                __syncthreads();
            }
#undef SC_ROW
#undef SC_LOAD
#undef SC_WRITE
        }
        { const bf16_t* Qm = (const bf16_t*)F.out; const bf16_t* Km = Qm + (size_t)T * 768; const bf16_t* Vm = (const bf16_t*)(ws + WS_A); bf16_t* CAT = (bf16_t*)(ws + WS_D);
          for (;;) {
              __syncthreads();
              if (tid == 0) MISC[0] = atomicAdd(queue, 1u);
              __syncthreads();
              const unsigned u = MISC[0];
              if (u >= 528u) break;
              const int bh = u < 512u ? (int)u / 32 : (int)u - 512, qb = u < 512u ? 1 + (int)u % 32 : 0, b = bh >> 3, h = bh & 7;
              const size_t m0 = (size_t)b * RB + (size_t)qb * 256, k0 = (size_t)b * RB;
              att::attn_unit<96>(Qm + m0 * 768 + h * 96, 768, Km + k0 * 768 + h * 96, 768, Vm + k0 * 512 + h * 64, 512, CAT + m0 * 1024 + 512 + h * 64, 1024, qb == 0 ? 4 : 132, (char*)lds_raw);
          } }
        SEAM(6);
    }
    if (CT(7) && IN(7)) {
        const bf16_t* Rb = (const bf16_t*)(ws + WS_B); const bf16_t* Kb = Rb + (size_t)T * 512; const bf16_t* Vb = Kb + (size_t)T * 512; const bf16_t* ZZ = (const bf16_t*)(ws + WS_C);
        const bf16_t* Yf = (const bf16_t*)(ws + WS_A + SZ512); const bf16_t* Yb = (const bf16_t*)(ws + WS_YB); bf16_t* CAT = (bf16_t*)(ws + WS_D);
        float lnw[8], lnb[8], rk[8], ka[8];
#pragma unroll
        for (int i = 0; i < 8; ++i) { lnw[i] = args.in[I_LNW][lane * 8 + i]; lnb[i] = args.in[I_LNB][lane * 8 + i]; rk[i] = args.in[I_RK][lane * 8 + i]; ka[i] = args.in[I_KA][lane * 8 + i]; }
        for (int m = gw; m < T; m += NGW) {
            const size_t o5 = (size_t)m * 512 + lane * 8, oz = (size_t)m * 2560 + lane * 8;
            const u32x4 yf = *(const u32x4*)(Yf + o5), yb = *(const u32x4*)(Yb + o5), rr = *(const u32x4*)(Rb + o5), kk = *(const u32x4*)(Kb + o5), vv = *(const u32x4*)(Vb + o5);
            const u32x4 af = *(const u32x4*)(ZZ + oz + 1024), ab = *(const u32x4*)(ZZ + oz + 1536), gg = *(const u32x4*)(ZZ + oz + 2048);
            float y[8], s = 0.f, bon = 0.f;
#pragma unroll
            for (int i = 0; i < 4; ++i) { y[2 * i] = lo2f(yf[i]) + lo2f(yb[i]); y[2 * i + 1] = hi2f(yf[i]) + hi2f(yb[i]); s += y[2 * i] + y[2 * i + 1];
                const float k0 = lo2f(kk[i]), k1 = hi2f(kk[i]), a0 = lo2f(af[i]) + lo2f(ab[i]) - 2.f, a1 = hi2f(af[i]) + hi2f(ab[i]) - 2.f;
                bon += lo2f(rr[i]) * (k0 * (2.f + a0 * ka[2 * i])) * rk[2 * i] + hi2f(rr[i]) * (k1 * (2.f + a1 * ka[2 * i + 1])) * rk[2 * i + 1]; }
            s += __shfl_xor(s, 1); s += __shfl_xor(s, 2); s += __shfl_xor(s, 4);
            bon += __shfl_xor(bon, 1); bon += __shfl_xor(bon, 2); bon += __shfl_xor(bon, 4);
            const float mean = s * (1.f / 64.f); float q = 0.f;
#pragma unroll
            for (int i = 0; i < 8; ++i) { y[i] -= mean; q += y[i] * y[i]; }
            q += __shfl_xor(q, 1); q += __shfl_xor(q, 2); q += __shfl_xor(q, 4);
            const float rstd = 1.f / sqrtf(q * (1.f / 64.f) + 64e-5f);
            float o[8];
#pragma unroll
            for (int i = 0; i < 4; ++i) { o[2 * i] = (y[2 * i] * rstd * lnw[2 * i] + lnb[2 * i] + bon * lo2f(vv[i])) * lo2f(gg[i]); o[2 * i + 1] = (y[2 * i + 1] * rstd * lnw[2 * i + 1] + lnb[2 * i + 1] + bon * hi2f(vv[i])) * hi2f(gg[i]); }
            u32x4 w; w.x = pk2(o[0], o[1]); w.y = pk2(o[2], o[3]); w.z = pk2(o[4], o[5]); w.w = pk2(o[6], o[7]);
            *(u32x4*)(CAT + (size_t)m * 1024 + lane * 8) = w;
        }
        SEAM(7);
    }
    if (CT(8) && IN(8)) {
        SchedRes S{66, 4, F.G, F.bid, (const char*)(ws + WS_D), (const char*)(WD + O_WOUT0 / 2), (size_t)256 * 1024 * 2, (size_t)256 * 1024 * 2, 0,
                   args.in[I_X], args.in[I_CTX], F.out, (float*)(ws + WS_XLC)};
        g8::EpiResGate E{MODS + 0 * 3 * 6144 + 2 * 1024, MIX_AMP};
        g8::gemm_phase(F.lds, 1024, S, E);
        SEAM(8);
    }

    moe_block<0>(args, F, bar, lo, hi);
        if (CT(14) && IN(14)) {
            SchedDense S{66, 6, F.G, F.bid, (const char*)(ws + WS_A), (const char*)(WD + O_WIN1 / 2), (char*)(ws + WS_C), (size_t)256 * 1024 * 2, (size_t)256 * 1024 * 2, (size_t)256 * 1536 * 2, 0};
            g8::EpiStoreBf16 E{1536, nullptr, 0};
            g8::gemm_phase(F.lds, 1024, S, E);
            SEAM(14);
        }
        if (CT(15) && IN(15)) {
            bf16_t* QKV = (bf16_t*)(ws + WS_C);
            const int hq = lane >> 2, sq = lane & 3, hk = lane >> 4, sk = lane & 15;
            float gq[16], gk[4];
#pragma unroll
            for (int i = 0; i < 16; ++i) gq[i] = args.in[I_GGQ][sq + 4 * i];
#pragma unroll
            for (int i = 0; i < 4; ++i) gk[i] = args.in[I_GGK][sk + 16 * i];
            float invq[4];
#pragma unroll
            for (int i = 0; i < 4; ++i) invq[i] = __powf(10000.f, -(float)(sq + 4 * i) * (1.f / 16.f));
            const float invk = __powf(10000.f, -(float)sk * (1.f / 16.f));
            for (int m = gw; m < T; m += NGW) { const int j = m % RB; const bool lat = j >= CTXL; bf16_t* row = QKV + (size_t)m * 1536;
                const int sp = j - CTXL; const float pr_ = (float)(sp >> 6), pc_ = (float)(sp & 63);
                { float k[4], ss = 0.f;
#pragma unroll
                  for (int i = 0; i < 4; ++i) { k[i] = bf2f(row[1024 + hk * 64 + sk + 16 * i]); ss += k[i] * k[i]; }
                  ss = rowsum16(ss); const float rs = 1.f / sqrtf(ss * (1.f / 64.f) + 1e-6f);
#pragma unroll
                  for (int i = 0; i < 4; ++i) k[i] = k[i] * rs * gk[i];
                  if (lat) { float cr, sr, cc, sc; sincosf(pr_ * invk, &sr, &cr); sincosf(pc_ * invk, &sc, &cc);
                      const float a = k[0], b2 = k[1]; k[0] = a * cr - b2 * sr; k[1] = b2 * cr + a * sr; const float c = k[2], d = k[3]; k[2] = c * cc - d * sc; k[3] = d * cc + c * sc; }
#pragma unroll
                  for (int i = 0; i < 4; ++i) row[1024 + hk * 64 + sk + 16 * i] = (bf16_t)(pk2(k[i], 0.f) & 0xffffu); }
                if (lat) { float q[16], ss = 0.f;
#pragma unroll
                  for (int i = 0; i < 16; ++i) { q[i] = bf2f(row[hq * 64 + sq + 4 * i]); ss += q[i] * q[i]; }
                  ss += __shfl_xor(ss, 1); ss += __shfl_xor(ss, 2); const float rs = 1.f / sqrtf(ss * (1.f / 64.f) + 1e-6f);
#pragma unroll
                  for (int i = 0; i < 16; ++i) q[i] = q[i] * rs * gq[i];
#pragma unroll
                  for (int i = 0; i < 4; ++i) { float cr, sr, cc, sc; sincosf(pr_ * invq[i], &sr, &cr); sincosf(pc_ * invq[i], &sc, &cc);
                      const float a = q[i], b2 = q[i + 4]; q[i] = a * cr - b2 * sr; q[i + 4] = b2 * cr + a * sr; const float c = q[i + 8], d = q[i + 12]; q[i + 8] = c * cc - d * sc; q[i + 12] = d * cc + c * sc; }
#pragma unroll
                  for (int i = 0; i < 16; ++i) row[hq * 64 + sq + 4 * i] = (bf16_t)(pk2(q[i] * C2_GQA, 0.f) & 0xffffu); }
            }
            SEAM(15);
        }
        if (CT(16) && IN(16)) {
            const bf16_t* QKV = (const bf16_t*)(ws + WS_C); bf16_t* O1 = (bf16_t*)(ws + WS_D);
            const int x = F.bid & 7, b = x >> 2, kvh = x & 3, per = F.G >> 3, i0 = F.bid >> 3;
            for (int uu = i0; uu < 128; uu += per) { const int hh = kvh * 4 + (uu >> 5), qb = 1 + (uu & 31);
                const size_t m0 = (size_t)b * RB + (size_t)qb * 256, k0 = (size_t)b * RB;
                __syncthreads();
                att::attn_unit<64>(QKV + m0 * 1536 + hh * 64, 1536, QKV + k0 * 1536 + 1024 + kvh * 64, 1536, QKV + k0 * 1536 + 1280 + kvh * 64, 1536, O1 + m0 * 1024 + hh * 64, 1024, 132, (char*)lds_raw); }
            SEAM(16);
        }
        if (CT(17) && IN(17)) {
            SchedRes S{64, 4, F.G, F.bid, (const char*)(ws + WS_D), (const char*)(WD + O_WOUT1 / 2), (size_t)256 * 1024 * 2, (size_t)256 * 1024 * 2, 1,
                       F.out, (const float*)(ws + WS_XLC), F.out, (float*)(ws + WS_XLC)};
            g8::EpiResGate E{MODS + 1 * 3 * 6144 + 2 * 1024, 1.0f};
            g8::gemm_phase(F.lds, 1024, S, E);
            SEAM(17);
        }
    moe_block<1>(args, F, bar, lo, hi);
#undef IN
#undef SEAM
}

extern "C" void kernel_launch(void* const* d_in, const int* in_sizes, int n_in, void* d_out, int out_size, void* d_ws, size_t ws_size, hipStream_t stream) {
    static int grid = 0;
    if (grid == 0) {
        if (n_in != 39 || out_size != 2 * SEQ * DM || ws_size < WS_NEED) { fprintf(stderr, "kernel_launch: unexpected shapes (n_in %d out %d ws %zu)\n", n_in, out_size, ws_size); grid = -1; return; }
        int dev = 0, cus = 0;
        if (hipGetDevice(&dev) != hipSuccess || hipDeviceGetAttribute(&cus, hipDeviceAttributeMultiprocessorCount, dev) != hipSuccess) { grid = -1; return; }
        if (hipFuncSetAttribute((const void*)fwd_kernel, hipFuncAttributeMaxDynamicSharedMemorySize, LDS_BYTES) != hipSuccess) { fprintf(stderr, "kernel_launch: hipFuncSetAttribute failed\n"); grid = -1; return; }
        int per_cu = 0;
        if (hipOccupancyMaxActiveBlocksPerMultiprocessor(&per_cu, (const void*)fwd_kernel, NTHR, LDS_BYTES) != hipSuccess || per_cu < 1) fprintf(stderr, "kernel_launch: occupancy query says %d\n", per_cu);
        (void)hipGetLastError();
        grid = cus;
    }
    if (grid < 0) return;
    if (hipMemsetAsync((char*)d_ws + WS_CTL, 0, CTL_BYTES, stream) != hipSuccess) return;
    Args a{};
    for (int i = 0; i < 39; ++i) a.in[i] = (const float*)d_in[i];
    a.out = (float*)d_out; a.ws = (unsigned char*)d_ws;
    if (N_LAUNCH_MODE == 1) { a.ph_lo = 0; a.ph_hi = PH_END; hipLaunchKernelGGL(fwd_kernel, dim3(grid), dim3(NTHR), LDS_BYTES, stream, a); }
    else for (int p = 0; p < PH_END; ++p) { a.ph_lo = p; a.ph_hi = p + 1; hipLaunchKernelGGL(fwd_kernel, dim3(grid), dim3(NTHR), LDS_BYTES, stream, a); }
}
```

```cpp
#include <hip/hip_runtime.h>
#include <hip/hip_bf16.h>
#include <cstdio>
#include <cstdint>

#define LAS __attribute__((address_space(3)))
#define GAS __attribute__((address_space(1)))
typedef unsigned short bf16_t;
typedef short bf16x8 __attribute__((ext_vector_type(8)));
typedef short s16x4 __attribute__((ext_vector_type(4)));
typedef float f32x4 __attribute__((ext_vector_type(4)));
typedef float f32x2 __attribute__((ext_vector_type(2)));
typedef float f32x16 __attribute__((ext_vector_type(16)));
typedef unsigned u32x4 __attribute__((ext_vector_type(4)));
typedef unsigned u32x2 __attribute__((ext_vector_type(2)));
typedef __bf16 bf16x2_t __attribute__((ext_vector_type(2)));

#ifndef PH_END
#define PH_END 25
#endif
#ifndef N_LAUNCH_MODE
#define N_LAUNCH_MODE 1
#endif
#ifndef ONLY_PH
#define ONLY_PH -1
#endif
#ifndef EXCL_PH
#define EXCL_PH -2
#endif
#ifndef ONLY_PH2
#define ONLY_PH2 -3
#endif
#define CT(id) ((ONLY_PH < 0 || ONLY_PH == (id) || ONLY_PH2 == (id)) && EXCL_PH != (id))
#ifndef DUP_PH
#define DUP_PH -1
#endif
#ifndef MIX_AMP
#define MIX_AMP 1.0f
#endif

constexpr int T = 16896, RB = 8448, CTXL = 256, SEQ = 8192, DM = 1024;
constexpr int NWAVES = 8, NTHR = 512;
constexpr int NE = 16, HS_TILES = 148, HS_ROWS = HS_TILES * 256;
constexpr float C2_MLA = 0.10206207261596575f * 1.4426950408889634f;
constexpr float C2_GQA = 0.125f * 1.4426950408889634f;

constexpr size_t MiB = 1u << 20;
constexpr size_t WS_CTL = 0, CTL_BYTES = 1 * MiB;
constexpr size_t WS_SMALL = 1 * MiB;
constexpr size_t SM_MODS = WS_SMALL;
constexpr size_t SM_BIASZ = WS_SMALL + 160 * 1024;
constexpr size_t SM_SEL = WS_SMALL + 192 * 1024;
constexpr size_t SM_WTS = WS_SMALL + 512 * 1024;
constexpr size_t SM_POS = WS_SMALL + 704 * 1024;
constexpr size_t SM_ROWWT = WS_SMALL + 1024 * 1024;
constexpr size_t WS_WD = 4 * MiB;
constexpr size_t O_WIN0 = 0, O_WOUT0 = 5767168, O_WLORA = 7864320, O_WQUP = 9830400, O_WKVUP = 10420224, O_WIN1 = 10944512, O_WOUT1 = 14090240, O_WD_END = 16187392;
static_assert(O_WD_END <= 17 * MiB, "dense weights");
constexpr size_t WS_XLC = 21 * MiB;
constexpr size_t WS_KROPE = 23 * MiB;
constexpr size_t WS_A = 26 * MiB;
constexpr size_t WS_B = 59 * MiB;
constexpr size_t WS_C = 113770496;
constexpr size_t WS_ACT = 183 * MiB;
constexpr size_t WS_D = 191 * MiB;
constexpr size_t WS_YB = 224 * MiB;
constexpr size_t WS_SEG = 241 * MiB;
static_assert(WS_SEG + 3 * 256 * 4096 * 4 <= 256 * MiB, "seg");
constexpr size_t SZ1024 = (size_t)T * 1024 * 2, SZ512 = (size_t)T * 512 * 2, SZ768 = (size_t)T * 768 * 2, SZ384 = (size_t)T * 384 * 2, SZ256 = (size_t)T * 256 * 2;
static_assert(WS_A + SZ1024 <= WS_B && WS_B + 3 * SZ512 <= WS_C && WS_C + (size_t)T * 2816 * 2 <= 200 * MiB, "map");
static_assert(WS_C + (size_t)HS_ROWS * 2048 <= WS_ACT && WS_ACT + (size_t)(HS_ROWS + T) * 512 <= 211 * MiB, "map2");
static_assert(WS_D + SZ768 + SZ1024 <= 256 * MiB && WS_YB + SZ512 <= 256 * MiB && WS_D + SZ1024 <= WS_YB, "map3");
constexpr size_t WS_NEED = 256 * MiB;
constexpr int CW_TMO = 0, CW_BAR = 4096  , CW_CNT = 16384  , CW_QUEUE = 20480;

__device__ __forceinline__ float bf2f(unsigned short h) { return __uint_as_float((unsigned)h << 16); }
__device__ __forceinline__ unsigned pk2(float lo, float hi) { f32x2 v = {lo, hi}; bf16x2_t b = __builtin_convertvector(v, bf16x2_t); return __builtin_bit_cast(unsigned, b); }
__device__ __forceinline__ float lo2f(unsigned w) { return __uint_as_float(w << 16); }
__device__ __forceinline__ float hi2f(unsigned w) { return __uint_as_float(w & 0xffff0000u); }
__device__ __forceinline__ float sigmoidf_(float x) { return __builtin_amdgcn_rcpf(1.f + __expf(-x)); }
__device__ __forceinline__ float wave_sum(float v) {
#pragma unroll
    for (int o = 1; o < 64; o <<= 1) v += __shfl_xor(v, o);
    return v;
}
#define DPP_ROR_ADD(x, ctrl) x += __int_as_float(__builtin_amdgcn_update_dpp(0, __float_as_int(x), ctrl, 0xF, 0xF, false))
__device__ __forceinline__ float rowsum16(float x) {
    DPP_ROR_ADD(x, 0x128); DPP_ROR_ADD(x, 0x124); DPP_ROR_ADD(x, 0x122); DPP_ROR_ADD(x, 0x121); return x;
}
#define LDS_WAIT() asm volatile("s_waitcnt lgkmcnt(0)" ::: "memory")
#define VM_WAIT() asm volatile("s_waitcnt vmcnt(0)" ::: "memory")

namespace g8 {
constexpr int BM = 256, BK = 64, HALF = 128, HTB = HALF * BK * 2, STAGE_BYTES = 8 * HTB, NXCD = 8, WGM = 8;
__host__ __device__ __forceinline__ int lds_byte(int r, int c) { const int st = (r >> 4) * 2 + (c >> 5), rr = r & 15, cc = c & 31, ob = rr * 64 + cc * 2; return st * 1024 + (ob ^ (((ob >> 9) & 1) << 5)); }
__host__ __device__ __forceinline__ void stage_rc(int b, int& R, int& C) { const int st = b / 1024, sb = b % 1024, swz = sb ^ (((sb >> 9) & 1) << 5); R = (st >> 1) * 16 + swz / 64; C = (st & 1) * 32 + (swz % 64) / 2; }
__host__ __device__ __forceinline__ int perm32(int rho) { const int n = rho >> 4, i = rho & 15; return 8 * (i >> 2) + 4 * n + (i & 3); }

struct Unit { const char* a; const char* b; char* o; const float* f0; int pn; int aux; };

__device__ __forceinline__ bool tile_order(int i, int G, int c, int nM, int nN, int& pm, int& pn) {
    const int nwg = nM * nN; const long L = (long)i * G + c; if (L >= nwg) return false;
    int wgid = (int)L; { const int q = nwg / NXCD, r = nwg % NXCD, xcd = wgid % NXCD, off = wgid / NXCD; wgid = (xcd < r ? xcd * (q + 1) : r * (q + 1) + (xcd - r) * q) + off; }
    const int nig = WGM * nN, gid = wgid / nig, fm = gid * WGM, gsz = (nM - fm) < WGM ? (nM - fm) : WGM;
    pm = fm + ((wgid % nig) % gsz); pn = (wgid % nig) / gsz; return true;
}

struct EpiStoreBf16 {
    static constexpr bool PERM = true;
    int ldc; const float* bias; int sig_cols;
    __device__ __forceinline__ void operator()(const f32x4 (&acc)[2][2][4][2], const Unit& u, int wr, int wc, int fr, int fq) const {
        bf16_t* base = (bf16_t*)u.o; const int col0 = u.pn * BM + wc * 32 + 8 * fq;
        const bool sig = (u.pn * BM) < sig_cols;
        f32x4 bv[2][2];
#pragma unroll
        for (int bj = 0; bj < 2; ++bj)
#pragma unroll
            for (int n = 0; n < 2; ++n) bv[bj][n] = bias ? *(const f32x4*)(bias + col0 + bj * HALF + 4 * n) : (f32x4){0.f, 0.f, 0.f, 0.f};
#pragma unroll
        for (int ai = 0; ai < 2; ++ai)
#pragma unroll
            for (int m = 0; m < 4; ++m) { bf16_t* rowp = base + (size_t)(ai * HALF + wr * 64 + m * 16 + fr) * ldc + col0;
#pragma unroll
                for (int bj = 0; bj < 2; ++bj) { f32x4 v0 = acc[ai][bj][m][0] + bv[bj][0], v1 = acc[ai][bj][m][1] + bv[bj][1];
                    if (sig) {
#pragma unroll
                        for (int j = 0; j < 4; ++j) { v0[j] = sigmoidf_(v0[j]); v1[j] = sigmoidf_(v1[j]); } }
                    u32x4 w; w.x = pk2(v0[0], v0[1]); w.y = pk2(v0[2], v0[3]); w.z = pk2(v1[0], v1[1]); w.w = pk2(v1[2], v1[3]);
                    *(u32x4*)(rowp + bj * HALF) = w; } }
    }
};
struct EpiResGate {
    static constexpr bool PERM = false;
    const float* gate0; float amp;
    __device__ __forceinline__ void operator()(const f32x4 (&acc)[2][2][4][2], const Unit& u, int wr, int wc, int fr, int fq) const {
        const float* base = u.f0; float* out = (float*)u.o; const float* gate = gate0 + u.aux * 6144;
        const int col0 = u.pn * BM + wc * 32 + 4 * fq;
        f32x4 gv[2][2];
#pragma unroll
        for (int bj = 0; bj < 2; ++bj)
#pragma unroll
            for (int n = 0; n < 2; ++n) gv[bj][n] = *(const f32x4*)(gate + col0 + bj * HALF + n * 16) * amp;
#pragma unroll
        for (int ai = 0; ai < 2; ++ai)
#pragma unroll
            for (int m = 0; m < 4; ++m) { const size_t off = (size_t)(ai * HALF + wr * 64 + m * 16 + fr) * DM + col0;
#pragma unroll
                for (int bj = 0; bj < 2; ++bj)
#pragma unroll
                    for (int n = 0; n < 2; ++n) { const f32x4 bs = *(const f32x4*)(base + off + bj * HALF + n * 16);
                        *(f32x4*)(out + off + bj * HALF + n * 16) = bs + gv[bj][n] * acc[ai][bj][m][n]; }
                asm volatile("" ::: "memory"); }
    }
};
struct EpiSwiGLU {
    static constexpr bool PERM = true;
    __device__ __forceinline__ void operator()(const f32x4 (&acc)[2][2][4][2], const Unit& u, int wr, int wc, int fr, int fq) const {
        bf16_t* act = (bf16_t*)u.o; const float* rw = u.f0; const int f0 = u.pn * 128 + wc * 32 + 8 * fq;
#pragma unroll
        for (int ai = 0; ai < 2; ++ai)
#pragma unroll
            for (int m = 0; m < 4; ++m) { const int r = ai * HALF + wr * 64 + m * 16 + fr; const float wt = rw ? rw[r] : 1.f;
                float o[8];
#pragma unroll
                for (int n = 0; n < 2; ++n)
#pragma unroll
                    for (int j = 0; j < 4; ++j) { const float g = acc[ai][0][m][n][j], up = acc[ai][1][m][n][j]; o[n * 4 + j] = g * sigmoidf_(g) * up * wt; }
                u32x4 w; w.x = pk2(o[0], o[1]); w.y = pk2(o[2], o[3]); w.z = pk2(o[4], o[5]); w.w = pk2(o[6], o[7]);
                *(u32x4*)(act + (size_t)r * 256 + f0) = w; asm volatile("" ::: "memory"); }
    }
};

template <class Epi, class Sched>
__device__ __forceinline__ void gemm_phase(LAS unsigned char* lds, const int K, const Sched& S, const Epi& E) {
    int tid_ = threadIdx.x; asm volatile("" : "+v"(tid_));
    const int tid = tid_, wid = __builtin_amdgcn_readfirstlane(tid >> 6), lane = tid & 63, wr = wid >> 2, wc = wid & 3, fr = lane & 15, fq = lane >> 4;
    const int nt = K / BK;
    unsigned voffA[2], voffB[2];
#pragma unroll
    for (int i = 0; i < 2; ++i) { int R, C; stage_rc(tid * 16 + i * 8192, R, C); const int Rb = Epi::PERM ? ((R & ~31) + perm32(R & 31)) : R;
        voffA[i] = (unsigned)(R * K + C) * 2u; voffB[i] = (unsigned)(Rb * K + C) * 2u; }
    const size_t kstep = (size_t)(BK * 2);
    const size_t hstep = (size_t)HALF * K * 2;
    const unsigned ldsw = (unsigned)wid * 1024u;
    const int aoff = lds_byte(wr * 64 + fr, fq * 8), boff = lds_byte(wc * 32 + fr, fq * 8);
#define PG8_SA(b, h) (((b) * 2 + (h)) * HTB)
#define PG8_SB(b, h) ((4 + (b) * 2 + (h)) * HTB)
#define PG8_STAGE(bufoff, gbase, voff) do { _Pragma("unroll") for (int _i = 0; _i < 2; ++_i) \
        __builtin_amdgcn_global_load_lds((const unsigned*)((const char*)(gbase) + (voff)[_i]), (LAS unsigned*)(lds + (bufoff) + ldsw + _i * 8192), 16, 0, 0); } while (0)
#define PG8_LDA(dst, b, h) do { _Pragma("unroll") for (int m = 0; m < 4; ++m) _Pragma("unroll") for (int k = 0; k < 2; ++k) dst[m][k] = *(const LAS bf16x8*)(lds + PG8_SA(b, h) + aoff + m * 2048 + k * 1024); } while (0)
#define PG8_LDB(dst, b, h) do { _Pragma("unroll") for (int n = 0; n < 2; ++n) _Pragma("unroll") for (int k = 0; k < 2; ++k) dst[n][k] = *(const LAS bf16x8*)(lds + PG8_SB(b, h) + boff + n * 2048 + k * 1024); } while (0)
#define PG8_MMA(ai, bj, At, Bt) do { __builtin_amdgcn_s_setprio(1); _Pragma("unroll") for (int m = 0; m < 4; ++m) _Pragma("unroll") for (int n = 0; n < 2; ++n) _Pragma("unroll") for (int k = 0; k < 2; ++k) \
        acc[ai][bj][m][n] = __builtin_amdgcn_mfma_f32_16x16x32_bf16(Bt[n][k], At[m][k], acc[ai][bj][m][n], 0, 0, 0); __builtin_amdgcn_s_setprio(0); } while (0)
#define PG8_WAIT_V(n) asm volatile("s_waitcnt vmcnt(" #n ")" ::: "memory")
#define PG8_WAIT_L(n) asm volatile("s_waitcnt lgkmcnt(" #n ")" ::: "memory")
#define PG8_BAR __builtin_amdgcn_s_barrier()
#define PG8_SCHED __builtin_amdgcn_sched_barrier(0)
    Unit cur, nxt; int ui = 0;
    if (!S.next(0, cur)) return;
    f32x4 acc[2][2][4][2];
#pragma unroll
    for (int a = 0; a < 2; ++a)
#pragma unroll
        for (int b = 0; b < 2; ++b)
#pragma unroll
            for (int m = 0; m < 4; ++m)
#pragma unroll
                for (int n = 0; n < 2; ++n) acc[a][b][m][n] = (f32x4){0.f, 0.f, 0.f, 0.f};
    bf16x8 At[4][2], B0[2][2], B1[2][2];
    const char* cA = cur.a; const char* cB = cur.b;
    PG8_STAGE(PG8_SB(0, 0), cB, voffB); PG8_STAGE(PG8_SB(0, 1), cB + hstep, voffB); PG8_STAGE(PG8_SA(0, 0), cA, voffA); PG8_STAGE(PG8_SA(0, 1), cA + hstep, voffA);
    if (wr == 1) PG8_BAR;
    PG8_WAIT_V(2); PG8_BAR;
    PG8_STAGE(PG8_SB(1, 0), cB + kstep, voffB); PG8_STAGE(PG8_SA(1, 0), cA + kstep, voffA); PG8_STAGE(PG8_SB(1, 1), cB + hstep + kstep, voffB);
    PG8_WAIT_V(6); PG8_BAR;
    for (;;) {
        const bool has_next = S.next(ui + 1, nxt);
        const char* nA = has_next ? nxt.a : cA; const char* nB = has_next ? nxt.b : cB;
#pragma unroll 1
        for (int t = 0; t < nt; t += 2) {
            const bool last = (t == nt - 2);
            const char* a1 = cA + (size_t)(t + 1) * kstep;
            const char* a2 = last ? nA : cA + (size_t)(t + 2) * kstep; const char* b2 = last ? nB : cB + (size_t)(t + 2) * kstep;
            const char* a3 = a2 + kstep; const char* b3 = b2 + kstep;
            PG8_LDB(B0, 0, 0); PG8_LDB(B1, 0, 1); PG8_SCHED; PG8_LDA(At, 0, 0); PG8_STAGE(PG8_SA(1, 1), a1 + hstep, voffA);
            PG8_WAIT_V(8); PG8_WAIT_L(0); PG8_BAR; PG8_MMA(0, 0, At, B0); PG8_MMA(0, 1, At, B1); PG8_BAR; PG8_SCHED;
            PG8_LDA(At, 0, 1); PG8_STAGE(PG8_SB(0, 0), b2, voffB); PG8_STAGE(PG8_SB(0, 1), b2 + hstep, voffB); PG8_STAGE(PG8_SA(0, 0), a2, voffA);
            PG8_WAIT_V(8); PG8_WAIT_L(0); PG8_BAR; PG8_MMA(1, 0, At, B0); PG8_MMA(1, 1, At, B1); PG8_BAR; PG8_SCHED;
            PG8_LDB(B0, 1, 0); PG8_LDB(B1, 1, 1); PG8_SCHED; PG8_LDA(At, 1, 0); PG8_STAGE(PG8_SA(0, 1), a2 + hstep, voffA);
            PG8_WAIT_V(8); PG8_WAIT_L(0); PG8_BAR; PG8_MMA(0, 0, At, B0); PG8_MMA(0, 1, At, B1); PG8_BAR; PG8_SCHED;
            PG8_LDA(At, 1, 1); PG8_STAGE(PG8_SB(1, 0), b3, voffB); PG8_STAGE(PG8_SB(1, 1), b3 + hstep, voffB); PG8_STAGE(PG8_SA(1, 0), a3, voffA);
            PG8_WAIT_V(8); PG8_WAIT_L(0); PG8_BAR; PG8_MMA(1, 0, At, B0); PG8_MMA(1, 1, At, B1); PG8_BAR; PG8_SCHED;
        }
        if (wr == 0) PG8_BAR;
        E(acc, cur, wr, wc, fr, fq);
        if (!has_next) break;
#pragma unroll
        for (int a = 0; a < 2; ++a)
#pragma unroll
            for (int b = 0; b < 2; ++b)
#pragma unroll
                for (int m = 0; m < 4; ++m)
#pragma unroll
                    for (int n = 0; n < 2; ++n) acc[a][b][m][n] = (f32x4){0.f, 0.f, 0.f, 0.f};
        cur = nxt; cA = nA; cB = nB; ++ui;
        if (wr == 1) PG8_BAR;
    }
    PG8_WAIT_V(0);
    PG8_BAR;
#undef PG8_SA
#undef PG8_SB
#undef PG8_STAGE
#undef PG8_LDA
#undef PG8_LDB
#undef PG8_MMA
#undef PG8_WAIT_V
#undef PG8_WAIT_L
#undef PG8_BAR
#undef PG8_SCHED
}
}

namespace att {
#define SBAR() __builtin_amdgcn_sched_barrier(0)
__device__ __forceinline__ int crow(int r, int hi) { return (r & 3) + 8 * (r >> 2) + 4 * hi; }
constexpr float THR = 8.f;
__device__ __forceinline__ void partialSM(f32x16& p0, f32x16& p1, float& m_reg, float& alpha) {
    float pmax = p0[0];
#pragma unroll
    for (int r = 1; r < 16; ++r) pmax = fmaxf(pmax, p0[r]);
#pragma unroll
    for (int r = 0; r < 16; ++r) pmax = fmaxf(pmax, p1[r]);
    { auto rr = __builtin_amdgcn_permlane32_swap(__float_as_uint(pmax), __float_as_uint(pmax), false, false);
      pmax = fmaxf(__uint_as_float(rr[0]), __uint_as_float(rr[1])); }
    float mn;
    if (__builtin_expect(__all(pmax - m_reg <= THR), 1)) { mn = m_reg; alpha = 1.f; }
    else { mn = fmaxf(m_reg, pmax); alpha = __builtin_amdgcn_exp2f(m_reg - mn); m_reg = mn; }
#pragma unroll
    for (int r = 0; r < 16; ++r) p0[r] = p0[r] - mn;
#pragma unroll
    for (int r = 0; r < 16; ++r) p1[r] = p1[r] - mn;
#pragma unroll
    for (int r = 0; r < 16; ++r) p0[r] = __builtin_amdgcn_exp2f(p0[r]);
}
__device__ __forceinline__ void finishSM(f32x16& p0, f32x16& p1, float alpha, float& l_reg, bf16x8& pa0, bf16x8& pa1, bf16x8& pa2, bf16x8& pa3) {
#pragma unroll
    for (int r = 0; r < 16; ++r) p1[r] = __builtin_amdgcn_exp2f(p1[r]);
    float ps = 0;
#pragma unroll
    for (int r = 0; r < 16; ++r) ps += p0[r];
#pragma unroll
    for (int r = 0; r < 16; ++r) ps += p1[r];
    { auto rr = __builtin_amdgcn_permlane32_swap(__float_as_uint(ps), __float_as_uint(ps), false, false);
      ps = __uint_as_float(rr[0]) + __uint_as_float(rr[1]); }
    l_reg = l_reg * alpha + ps;
#define PK4(P, BASE, OUT) do { unsigned a0 = pk2(P[BASE + 0], P[BASE + 1]), a1 = pk2(P[BASE + 2], P[BASE + 3]);   \
    unsigned b0 = pk2(P[BASE + 4], P[BASE + 5]), b1 = pk2(P[BASE + 6], P[BASE + 7]);                              \
    auto r0 = __builtin_amdgcn_permlane32_swap(a0, b0, false, false); auto r1 = __builtin_amdgcn_permlane32_swap(a1, b1, false, false); \
    u32x4 w = {r0[0], r1[0], r0[1], r1[1]}; OUT = __builtin_bit_cast(bf16x8, w); } while (0)
    PK4(p0, 0, pa0); PK4(p0, 8, pa1); PK4(p1, 0, pa2); PK4(p1, 8, pa3);
#undef PK4
}
template <int DQK>
__device__ __forceinline__ void qkt(f32x16& p0, f32x16& p1, const char* Ks, const bf16x8* qr, int r32, int hi) {
    p0 = f32x16{}; p1 = f32x16{};
    const char* kb = Ks + hi * 1024 + r32 * 16;
#pragma unroll
    for (int d0 = 0; d0 < DQK / 16; ++d0) {
        bf16x8 b0 = *reinterpret_cast<const bf16x8*>(kb + d0 * 2048);
        bf16x8 b1 = *reinterpret_cast<const bf16x8*>(kb + d0 * 2048 + 512);
        p0 = __builtin_amdgcn_mfma_f32_32x32x16_bf16(b0, qr[d0], p0, 0, 0, 0);
        p1 = __builtin_amdgcn_mfma_f32_32x32x16_bf16(b1, qr[d0], p1, 0, 0, 0); }
}
__device__ __forceinline__ int v_st(int k, int c) { const int kk = (k & ~0xC) | ((k & 4) << 1) | ((k & 8) >> 1); return ((kk >> 3) * 2 + (c >> 5)) * 512 + ((kk & 7) * 32 + (c & 31)) * 2; }
__device__ __forceinline__ int v_rd_base(int lane) { return ((lane & 3) << 3) | (((lane >> 2) & 3) << 6) | (((lane >> 4) & 1) << 5) | (((lane >> 5) & 1) << 8); }
constexpr int v_rd_off(int d0, int ks, int half) { return d0 * 512 + ks * 2048 + half * 1024; }
template <int OFF> __device__ __forceinline__ s16x4 tr_read(int vb) {
    s16x4 r; asm volatile("ds_read_b64_tr_b16 %0, %1 offset:%2" : "=&v"(r) : "v"(vb), "i"(OFF) : "memory"); return r;
}
template <int D0> __device__ __forceinline__ void pv_one(f32x16& od, int vb, bf16x8 pa0, bf16x8 pa1, bf16x8 pa2, bf16x8 pa3) {
    const s16x4 l0 = tr_read<v_rd_off(D0, 0, 0)>(vb), h0 = tr_read<v_rd_off(D0, 0, 1)>(vb), l1 = tr_read<v_rd_off(D0, 1, 0)>(vb), h1 = tr_read<v_rd_off(D0, 1, 1)>(vb);
    const s16x4 l2 = tr_read<v_rd_off(D0, 2, 0)>(vb), h2 = tr_read<v_rd_off(D0, 2, 1)>(vb), l3 = tr_read<v_rd_off(D0, 3, 0)>(vb), h3 = tr_read<v_rd_off(D0, 3, 1)>(vb);
    asm volatile("s_waitcnt lgkmcnt(0)" ::: "memory"); SBAR();
#define PK(L, H) (bf16x8){L[0], L[1], L[2], L[3], H[0], H[1], H[2], H[3]}
    od = __builtin_amdgcn_mfma_f32_32x32x16_bf16(pa0, PK(l0, h0), od, 0, 0, 0);
    od = __builtin_amdgcn_mfma_f32_32x32x16_bf16(pa1, PK(l1, h1), od, 0, 0, 0);
    od = __builtin_amdgcn_mfma_f32_32x32x16_bf16(pa2, PK(l2, h2), od, 0, 0, 0);
    od = __builtin_amdgcn_mfma_f32_32x32x16_bf16(pa3, PK(l3, h3), od, 0, 0, 0);
#undef PK
}
__device__ __forceinline__ void pv_all(f32x16* o, int vb, bf16x8 pa0, bf16x8 pa1, bf16x8 pa2, bf16x8 pa3) {
    pv_one<0>(o[0], vb, pa0, pa1, pa2, pa3); pv_one<1>(o[1], vb, pa0, pa1, pa2, pa3);
}
template <int DQK> struct Lay { static constexpr int NCH = DQK / 8, SHM_K = 64 * DQK * 2, SHM_V = 8192, OFF_V = 0, OFF_K = 2 * SHM_V, OFF_WS = OFF_K + 2 * SHM_K, OFF_OST = OFF_WS + NWAVES * 256, BYTES = OFF_OST + NWAVES * 4096; };
template <int DQK>
__device__ __forceinline__ void attn_unit(const bf16_t* __restrict__ Qb, int ldq, const bf16_t* __restrict__ Kh, int ldk, const bf16_t* __restrict__ Vh, int ldv,
                                          bf16_t* __restrict__ Ob, int ldo, int NT, char* lds) {
    using L = Lay<DQK>; constexpr int NCH = L::NCH, ND0 = DQK / 16;
    int tid_ = threadIdx.x; asm volatile("" : "+v"(tid_));
    const int tid = tid_, wid = tid >> 6, lane = tid & 63, r32 = lane & 31, hi = lane >> 5;
    char* V_lds = lds + L::OFF_V; char* K_lds = lds + L::OFF_K;
    float* ws = (float*)(lds + L::OFF_WS) + wid * 64; float* li_l = ws; float* al_l = ws + 32;
    float m_reg = -1e30f, l_reg = 0; f32x16 o[2] = {}; bf16x8 qr[ND0];
    const bf16_t* Qw = Qb + (size_t)(wid * 32 + r32) * ldq + hi * 8;
#pragma unroll
    for (int d0 = 0; d0 < ND0; ++d0) qr[d0] = *reinterpret_cast<const bf16x8*>(Qw + d0 * 16);
    const int vrow = tid >> 3, vcol = (tid & 7) * 8, vst = v_st(vrow, vcol);
    const int kp0 = tid, kr0 = kp0 / NCH, kc0 = kp0 % NCH, kst0 = kc0 * 1024 + kr0 * 16;
    const int kp1 = 512 + (tid & 255), kr1 = kp1 / NCH, kc1 = kp1 % NCH, kst1 = kc1 * 1024 + kr1 * 16;
    const int vb0 = (int)(uintptr_t)V_lds + v_rd_base(lane);
    struct { bf16x8 v, k0, k1; } sr_[2];
#define SLOAD(i, key0) do { sr_[i].v = *reinterpret_cast<const bf16x8*>(Vh + (size_t)((key0) + vrow) * ldv + vcol); \
    sr_[i].k0 = *reinterpret_cast<const bf16x8*>(Kh + (size_t)((key0) + kr0) * ldk + kc0 * 8); \
    if (NCH > 8) sr_[i].k1 = *reinterpret_cast<const bf16x8*>(Kh + (size_t)((key0) + kr1) * ldk + kc1 * 8); } while (0)
#define SWRITE(b, i) do { *(bf16x8*)(V_lds + (b) * L::SHM_V + vst) = sr_[i].v; *(bf16x8*)(K_lds + (b) * L::SHM_K + kst0) = sr_[i].k0; \
    if (NCH > 8) { if (tid < 256) *(bf16x8*)(K_lds + (b) * L::SHM_K + kst1) = sr_[i].k1; } } while (0)
#define SWAIT() do { if (NCH > 8) asm volatile("s_waitcnt vmcnt(3)" ::: "memory"); else asm volatile("s_waitcnt vmcnt(2)" ::: "memory"); } while (0)
#define RESC(a) do { if (__any((a) < 1.f)) { if (hi == 0) al_l[r32] = (a); asm volatile("s_waitcnt lgkmcnt(0)" ::: "memory"); \
    _Pragma("unroll") for (int d = 0; d < 2; ++d) _Pragma("unroll") for (int r = 0; r < 16; ++r) o[d][r] *= al_l[crow(r, hi)]; } } while (0)
    f32x16 pA0, pA1, pB0, pB1; float alA, alB; bf16x8 pa0, pa1, pa2, pa3;
    constexpr int SE = 0, SO = 1;
    SLOAD(SE, 0); asm volatile("s_waitcnt vmcnt(0)" ::: "memory"); SWRITE(0, SE); __syncthreads();
    qkt<DQK>(pA0, pA1, K_lds, qr, r32, hi); partialSM(pA0, pA1, m_reg, alA);
    SLOAD(SO, 64); if (2 < NT) SLOAD(SE, 128);
    SWAIT(); SWRITE(1, SO); __syncthreads();
    for (int j = 1; j + 1 < NT; j += 2) {
        SBAR(); qkt<DQK>(pB0, pB1, K_lds + L::SHM_K, qr, r32, hi);
        finishSM(pA0, pA1, alA, l_reg, pa0, pa1, pa2, pa3); SBAR();
        SLOAD(SO, (j + 2) * 64); SBAR();
        pv_all(o, vb0, pa0, pa1, pa2, pa3); partialSM(pB0, pB1, m_reg, alB);
        __syncthreads(); SWAIT(); SWRITE(0, SE);
        RESC(alB); __syncthreads();
        SBAR(); qkt<DQK>(pA0, pA1, K_lds, qr, r32, hi);
        finishSM(pB0, pB1, alB, l_reg, pa0, pa1, pa2, pa3); SBAR();
        if (j + 3 < NT) SLOAD(SE, (j + 3) * 64); SBAR();
        pv_all(o, vb0 + L::SHM_V, pa0, pa1, pa2, pa3); partialSM(pA0, pA1, m_reg, alA);
        __syncthreads(); SWAIT(); SWRITE(1, SO);
        RESC(alA); __syncthreads();
    }
    SBAR(); qkt<DQK>(pB0, pB1, K_lds + L::SHM_K, qr, r32, hi);
    finishSM(pA0, pA1, alA, l_reg, pa0, pa1, pa2, pa3); SBAR();
    pv_all(o, vb0, pa0, pa1, pa2, pa3); partialSM(pB0, pB1, m_reg, alB);
    __syncthreads(); RESC(alB);
    finishSM(pB0, pB1, alB, l_reg, pa0, pa1, pa2, pa3); SBAR();
    pv_all(o, vb0 + L::SHM_V, pa0, pa1, pa2, pa3);
    if (hi == 0) li_l[r32] = l_reg; asm volatile("s_waitcnt lgkmcnt(0)" ::: "memory");
    float rli[16];
#pragma unroll
    for (int r = 0; r < 16; ++r) rli[r] = __builtin_amdgcn_rcpf(li_l[crow(r, hi)]);
    bf16_t* Ow = Ob + (size_t)(wid * 32) * ldo;
    { bf16_t* stg = (bf16_t*)(lds + L::OFF_OST) + wid * 2048;
#pragma unroll
      for (int r = 0; r < 16; ++r) { const int orow = crow(r, hi);
#pragma unroll
        for (int d0 = 0; d0 < 2; ++d0) stg[orow * 64 + d0 * 32 + r32] = (bf16_t)(pk2(o[d0][r] * rli[r], 0.f) & 0xffffu); }
      asm volatile("s_waitcnt lgkmcnt(0)" ::: "memory");
#pragma unroll
      for (int i = 0; i < 4; ++i) { const int row = i * 8 + (lane >> 3), ch = lane & 7; const u32x4 v = *(const u32x4*)(stg + row * 64 + ch * 8); *(u32x4*)(Ow + (size_t)row * ldo + ch * 8) = v; } }
    asm volatile("s_waitcnt lgkmcnt(0)" ::: "memory");
#undef SLOAD
#undef SWRITE
#undef SWAIT
#undef RESC
}
#undef SBAR
}

namespace ck {
constexpr int PT = 144, MSZ = 64 * PT;
typedef short v4i16_t __attribute__((ext_vector_type(4)));
struct LaneOff { int n, t, s; };
__device__ __forceinline__ LaneOff lane_off(int lane) { const int x = lane & 15, g = lane >> 4; LaneOff o; o.n = x * PT + g * 16; o.t = (8 * g + (x >> 2)) * PT + (x & 3) * 8; o.s = x * PT + g * 8; return o; }
__device__ __forceinline__ bf16x8 fragN(const LAS unsigned char* M, int blk, int ks, const LaneOff& o) {
    return *(const LAS bf16x8*)(M + blk * (16 * PT) + ks * 64 + o.n); }
__device__ __forceinline__ bf16x8 fragT(const LAS unsigned char* M, int blk, int ks, const LaneOff& o) {
    const LAS unsigned char* p = M + ks * (32 * PT) + blk * 32 + o.t;
    const v4i16_t lo = __builtin_amdgcn_ds_read_tr16_b64_v4i16((LAS v4i16_t*)p), hi = __builtin_amdgcn_ds_read_tr16_b64_v4i16((LAS v4i16_t*)(p + 4 * PT));
    return (bf16x8){lo[0], lo[1], lo[2], lo[3], hi[0], hi[1], hi[2], hi[3]}; }
template <bool LT, bool RT> __device__ __forceinline__ void mm2(f32x4 (&acc)[2], const LAS unsigned char* Lm, const LAS unsigned char* Rm, int mt, int nt0, const LaneOff& o) {
#pragma unroll
    for (int ks = 0; ks < 2; ++ks) { const bf16x8 a = LT ? fragT(Lm, mt, ks, o) : fragN(Lm, mt, ks, o);
#pragma unroll
        for (int q = 0; q < 2; ++q) { const bf16x8 b = RT ? fragT(Rm, nt0 + q, ks, o) : fragN(Rm, nt0 + q, ks, o); acc[q] = __builtin_amdgcn_mfma_f32_16x16x32_bf16(a, b, acc[q], 0, 0, 0); } }
}
__device__ __forceinline__ void st2(LAS unsigned char* Out, const f32x4 (&acc)[2], int mt, int nt0, const LaneOff& o) {
#pragma unroll
    for (int q = 0; q < 2; ++q) *(LAS u32x2*)(Out + (nt0 + q) * (16 * PT) + mt * 32 + o.s) = (u32x2){pk2(acc[q][0], acc[q][1]), pk2(acc[q][2], acc[q][3])};
}
}

#define XB_TMO      128
#define XB_XCNT(j)  (256  + 64 * (j))
#define XB_XSUB(j)  (1280 + 64 * (j))
#define XB_XGEN(j)  (2304 + 64 * (j))
#define XB_TOP      3328
#define XB_TOPGEN   3392
#define XCD_BAR_WORDS 3456
#define XB_SPIN_CAP (1u << 18)
__device__ __forceinline__ unsigned xb_ld(unsigned* p)              { return __hip_atomic_load(p, __ATOMIC_RELAXED, __HIP_MEMORY_SCOPE_AGENT); }
__device__ __forceinline__ unsigned xb_add(unsigned* p, unsigned v) { return __hip_atomic_fetch_add(p, v, __ATOMIC_RELAXED, __HIP_MEMORY_SCOPE_AGENT); }
__device__ __forceinline__ unsigned xb_xcc_id() { return (unsigned)__builtin_amdgcn_s_getreg((3 << 11) | 20) & 0xFu; }
#define XB_SPIN(cond, bar) do { unsigned _sp = 0; while (cond) { __builtin_amdgcn_s_sleep(1); \
    if ((++_sp & 255u) == 0u) { if (xb_ld(&(bar)[XB_TMO])) break; if (_sp > XB_SPIN_CAP) { atomicAdd(&(bar)[XB_TMO], 1u); break; } } } } while (0)
struct XcdBarrier { unsigned* bar; unsigned x; volatile LAS unsigned* st; };
__device__ __forceinline__ XcdBarrier xcd_barrier_post(unsigned* bar, volatile LAS unsigned* st) {
    XcdBarrier b; b.bar = bar; b.x = xb_xcc_id(); b.st = st;
    if (threadIdx.x == 0) (void)xb_add(&bar[XB_XCNT(b.x)], 1u);
    return b;
}
__device__ __forceinline__ void xcd_barrier_complete(unsigned* bar, unsigned x, unsigned& nloc, unsigned& nx) {
    const unsigned G = gridDim.x * gridDim.y * gridDim.z;
    unsigned sum, cnt, mine, sp = 0u;
    for (;;) {
        sum = 0u; cnt = 0u; mine = 0u;
#pragma unroll
        for (unsigned j = 0; j < 16; ++j) { const unsigned c = xb_ld(&bar[XB_XCNT(j)]); sum += c; cnt += (c > 0u) ? 1u : 0u; mine = (j == x) ? c : mine; }
        if (sum == G) break;
        __builtin_amdgcn_s_sleep(1);
        if ((++sp & 255u) == 0u) { if (xb_ld(&bar[XB_TMO])) break; if (sp > XB_SPIN_CAP) { atomicAdd(&bar[XB_TMO], 1u); break; } }
    }
    nloc = mine > 0u ? mine : 1u; nx = cnt > 0u ? cnt : 1u;
}
__device__ __forceinline__ void xcd_barrier(const XcdBarrier& b) {
    asm volatile("s_waitcnt vmcnt(0)" ::: "memory");
    __syncthreads();
    if (threadIdx.x == 0) {
        unsigned* bar = b.bar;
        __builtin_amdgcn_s_waitcnt(0);
        unsigned nloc = b.st[0], nx = b.st[1];
        if (nloc == 0u) { xcd_barrier_complete(bar, b.x, nloc, nx); b.st[0] = nloc; b.st[1] = nx; }
        const unsigned old = xb_add(&bar[XB_XSUB(b.x)], 1u);
        const unsigned gen = old / nloc;
        if (old + 1u == (gen + 1u) * nloc) {
            __builtin_amdgcn_fence(__ATOMIC_RELEASE, "agent");
            asm volatile("s_waitcnt vmcnt(0)" ::: "memory");
            const unsigned og = xb_add(&bar[XB_TOP], 1u);
            const unsigned tg = og / nx;
            if (og + 1u == (tg + 1u) * nx) xb_add(&bar[XB_TOPGEN], 1u);
            else XB_SPIN(xb_ld(&bar[XB_TOPGEN]) == tg, bar);
            __builtin_amdgcn_fence(__ATOMIC_ACQUIRE, "agent");
            xb_add(&bar[XB_XGEN(b.x)], 1u);
            asm volatile("s_waitcnt vmcnt(0)" ::: "memory");
        } else {
            XB_SPIN(xb_ld(&bar[XB_XGEN(b.x)]) == gen, bar);
            __builtin_amdgcn_fence(__ATOMIC_ACQUIRE, "agent");
            asm volatile("s_waitcnt vmcnt(0)" ::: "memory");
        }
    }
    __syncthreads();
}

constexpr int RING_BYTES = 131072, LDS_BYTES = 163840, LDSCTL_OFF = LDS_BYTES - 1024, MISC_OFF = LDSCTL_OFF;
struct Args { const float* in[39]; float* out; unsigned char* ws; int ph_lo, ph_hi, li, pad; };
enum { I_X = 0, I_C, I_CTX, I_CCTX, I_ADAW, I_ADAB, I_N1G, I_N2G, I_ABWIN, I_ABWOUT, I_MU, I_W0, I_W2, I_A0, I_A2, I_KK, I_KA, I_RK, I_G2, I_LNW, I_LNB,
       I_GQA_, I_WQUP, I_GKVA, I_WKVUP, I_MGQ, I_MGK, I_GWIN, I_GWOUT, I_GGQ, I_GGK, I_RW, I_RBIAS, I_MGATE, I_MUP, I_MDOWN, I_SGATE, I_SUP, I_SDOWN };

__device__ __forceinline__ const float* inp(const Args& a, int i) { asm volatile("" : "+s"(i)); return a.in[i]; }
#define INP(i) inp(args, (i))
#define PH_LOCALS int tid = F.tid, lane = F.lane; asm volatile("" : "+v"(tid), "+v"(lane));
struct Ctx {
    LAS unsigned char* lds; int tid, lane, wave, G, bid;
    unsigned char* ws; float* out;
};
__device__ __forceinline__ bool row_is_ctx(int m) { return (m % RB) < CTXL; }
__device__ __forceinline__ float* xl_row(const Ctx& F, int m) {
    const int b = m / RB, j = m % RB;
    return j < CTXL ? (float*)(F.ws + WS_XLC) + (size_t)(b * CTXL + j) * DM : F.out + (size_t)(b * SEQ + j - CTXL) * DM;
}

__device__ __forceinline__ void tr_item(const float* W, int ldn, int k0, int n0, bf16_t* dst, int ldw, LAS float* scr, int lane) {
#pragma unroll 8
    for (int i = 0; i < 32; ++i) { const int kk = 2 * i + (lane >> 5); scr[kk * 33 + (lane & 31)] = W[(size_t)(k0 + kk) * ldn + n0 + (lane & 31)]; }
    LDS_WAIT(); asm volatile("" ::: "memory");
    const int c = lane & 7;
#pragma unroll
    for (int j = 0; j < 4; ++j) { const int n = (lane >> 3) + 8 * j; const LAS float* s = scr + (8 * c) * 33 + n;
        u32x4 o; o.x = pk2(s[0 * 33], s[1 * 33]); o.y = pk2(s[2 * 33], s[3 * 33]); o.z = pk2(s[4 * 33], s[5 * 33]); o.w = pk2(s[6 * 33], s[7 * 33]);
        *(u32x4*)(dst + (size_t)n * ldw + 8 * c) = o; }
    LDS_WAIT(); asm volatile("" ::: "memory");
}
__device__ __forceinline__ void tr_matrix_item(const float* W, int K, int N, bf16_t* dst, int ldw, LAS float* scr, int item, int lane) {
    const int nblk = N / 32, kb = item / nblk, nb = item % nblk;
    tr_item(W, N, 64 * kb, 32 * nb, dst + (size_t)(32 * nb) * ldw + 64 * kb, ldw, scr, lane);
}

__device__ __forceinline__ void norm_mod_row(const float* xrow, const float* g, const float* sh, const float* sc, bf16_t* orow, int lane, f32x4 (&hv)[4]) {
    const f32x4* xr = (const f32x4*)xrow + lane;
    f32x4 v[4]; float s = 0.f;
#pragma unroll
    for (int j = 0; j < 4; ++j) { v[j] = xr[64 * j]; s += (v[j].x * v[j].x + v[j].y * v[j].y) + (v[j].z * v[j].z + v[j].w * v[j].w); }
    const float rstd = 1.f / sqrtf(wave_sum(s) * (1.f / DM) + 1e-6f);
    unsigned long long* o8 = (unsigned long long*)orow + lane;
#pragma unroll
    for (int j = 0; j < 4; ++j) { const f32x4 gg = ((const f32x4*)g)[lane + 64 * j], s1 = ((const f32x4*)sc)[lane + 64 * j], s0 = ((const f32x4*)sh)[lane + 64 * j];
        f32x4 h = (v[j] * rstd * gg) * (s1 + 1.f) + s0; hv[j] = h;
        o8[64 * j] = (unsigned long long)pk2(h.x, h.y) | ((unsigned long long)pk2(h.z, h.w) << 32); }
}

struct SchedDense {
    int nM, nN, G, c; const char* A; const char* B; char* O; size_t a_tile, b_tile, o_tile; int latent_only;
    __device__ __forceinline__ bool next(int i, g8::Unit& u) const {
        int pm, pn; if (!g8::tile_order(i, G, c, nM, nN, pm, pn)) return false;
        if (latent_only) pm = pm + 1 + pm / 32;
        u.a = A + (size_t)pm * a_tile; u.b = B + (size_t)pn * b_tile; u.o = O + (size_t)pm * o_tile; u.pn = pn; u.aux = 0; u.f0 = nullptr; return true;
    }
};
struct SchedRes {
    int nM, nN, G, c; const char* A; const char* B; size_t a_tile, b_tile; int latent_only;
    const float* base_l; const float* base_c; float* out_l; float* out_c;
    __device__ __forceinline__ bool next(int i, g8::Unit& u) const {
        int pm, pn; if (!g8::tile_order(i, G, c, nM, nN, pm, pn)) return false;
        if (latent_only) pm = pm + 1 + pm / 32;
        const int b = pm / 33, t = pm % 33;
        u.a = A + (size_t)pm * a_tile; u.b = B + (size_t)pn * b_tile; u.pn = pn;
        if (t == 0) { u.f0 = base_c + (size_t)(b * CTXL) * DM; u.o = (char*)(out_c + (size_t)(b * CTXL) * DM); u.aux = 2; }
        else { const size_t r0 = (size_t)(b * SEQ + (t - 1) * 256) * DM; u.f0 = base_l + r0; u.o = (char*)(out_l + r0); u.aux = b; }
        return true;
    }
};
struct SchedMoe {
    volatile LAS unsigned* tab;
    const char* HS; const char* HSH; size_t a_tile;
    const char* W; size_t w_exp, w_tile;
    char* O; char* OSH; size_t o_tile;
    const float* rowwt;
    __device__ __forceinline__ bool next(int i, g8::Unit& u) const {
        const int n = __builtin_amdgcn_readfirstlane((int)tab[0]); if (i >= n) return false;
        const unsigned w0 = (unsigned)__builtin_amdgcn_readfirstlane((int)tab[1 + 2 * i]), e = (unsigned)__builtin_amdgcn_readfirstlane((int)tab[2 + 2 * i]);
        const unsigned tile = w0 & 0xffffu, pn = (w0 >> 16) & 0xffu; const bool sh = (w0 >> 31) != 0u;
        u.pn = (int)pn; u.aux = 0;
        u.a = (sh ? HSH : HS) + (size_t)tile * a_tile; u.b = W + (size_t)e * w_exp + (size_t)pn * w_tile; u.o = (sh ? OSH : O) + (size_t)tile * o_tile;
        u.f0 = (sh || !rowwt) ? nullptr : rowwt + (size_t)tile * 256;
        return true;
    }
};
__device__ __forceinline__ void moe_units(volatile LAS unsigned* tab, const unsigned* cnt, int G, int c, int npn, int n_sh, int latent_only) {
    int ts[NE + 1]; int tot = 0;
    for (int e = 0; e < NE; ++e) { ts[e] = tot; tot += (int)((cnt[e * 64] + 255u) >> 8); }
    ts[NE] = tot;
    const int total = (tot + n_sh) * npn; int n = 0;
    for (int i = 0; i < 16; ++i) { const int L = i * G + c; if (L >= total) break;
        const int tile = L / npn, pn = L % npn;
        if (tile < tot) { int e = 0; for (int q = 1; q < NE; ++q) e += (tile >= ts[q]) ? 1 : 0; tab[1 + 2 * n] = (unsigned)tile | ((unsigned)pn << 16); tab[2 + 2 * n] = (unsigned)e; }
        else { const int t2 = tile - tot, pm = latent_only ? t2 + 1 + t2 / 32 : t2; tab[1 + 2 * n] = (unsigned)pm | ((unsigned)pn << 16) | 0x80000000u; tab[2 + 2 * n] = (unsigned)NE; }
        ++n; }
    tab[0] = (unsigned)n;
}

template <int PASS>
__device__ __forceinline__ void scan_pass(const Args& args, const Ctx& F, const int unit) {
            unsigned char* ws = F.ws; int tid = F.tid, lane = F.lane; asm volatile("" : "+v"(tid), "+v"(lane));
            const int sid = unit >> 3, seg = unit & 7, b = sid >> 4, h = (sid >> 1) & 7, dir = sid & 1; const bool dummy = false;
            float* SEGM = (float*)(ws + WS_SEG) + (size_t)unit * 4096; float* SEGG = SEGM + 256 * 4096; float* HIN = SEGG + 256 * 4096;
            const bf16_t* Rb = (const bf16_t*)(ws + WS_B); const bf16_t* Kb = Rb + (size_t)T * 512; const bf16_t* Vb = Kb + (size_t)T * 512; const bf16_t* ZZ = (const bf16_t*)(ws + WS_C);
            bf16_t* Y = dir == 0 ? (bf16_t*)(ws + WS_A + SZ512) : (bf16_t*)(ws + WS_YB);
            LAS unsigned char* L0 = F.lds;
#define BUF(i) (L0 + (i) * ck::MSZ)
#define LBAR() asm volatile("s_waitcnt lgkmcnt(0)\n\ts_barrier" ::: "memory")
            LAS float* SEG = (LAS float*)(L0 + 14 * ck::MSZ); LAS float* GAM = SEG + 512;
            const int mt = F.wave >> 1, nt0 = 2 * (F.wave & 1);
            const int st = tid >> 3, c8 = tid & 7, wv = F.wave;
            LAS float* PRM = GAM + 64;
            if (tid < 128) PRM[tid] = tid < 64 ? inp(args, I_KK)[h * 64 + tid] : inp(args, I_KA)[h * 64 + tid - 64];
            const int c0 = (132 * seg) >> 3, c1 = (132 * (seg + 1)) >> 3;
            LAS unsigned char* H0 = BUF(7 + (c0 & 1));
            f32x4 Hacc[2] = {(f32x4){0.f, 0.f, 0.f, 0.f}, (f32x4){0.f, 0.f, 0.f, 0.f}}, Hb[2] = {(f32x4){0.f, 0.f, 0.f, 0.f}, (f32x4){0.f, 0.f, 0.f, 0.f}};
            { const ck::LaneOff li_ = ck::lane_off(lane); const int x_ = lane & 15, g_ = lane >> 4;
              if (PASS == 2) {
#pragma unroll
                  for (int q = 0; q < 2; ++q)
#pragma unroll
                      for (int r = 0; r < 4; ++r) Hacc[q][r] = HIN[(16 * mt + 4 * g_ + r) * 64 + 16 * (nt0 + q) + x_]; }
              else {
#pragma unroll
                  for (int q = 0; q < 2; ++q)
#pragma unroll
                      for (int r = 0; r < 4; ++r) Hb[q][r] = (16 * mt + 4 * g_ + r == 16 * (nt0 + q) + x_) ? 1.f : 0.f;
                  ck::st2(BUF(1), Hb, mt, nt0, li_); }
              ck::st2(H0, Hacc, mt, nt0, li_); }
            u32x4 g_r, g_k, g_v, g_s, g_a;
#define SC_ROW(s_) (b * RB + (dir == 0 ? (s_) : ((s_) < CTXL ? CTXL - 1 - (s_) : RB + CTXL - 1 - (s_))))
#define SC_LOAD(c_) do { const int m_ = SC_ROW((c_) * 64 + st); const size_t o5 = (size_t)m_ * 512 + h * 64 + 8 * c8, oz = (size_t)m_ * 2560 + dir * 512 + h * 64 + 8 * c8; \
        g_r = *(const u32x4*)(Rb + o5); g_k = *(const u32x4*)(Kb + o5); g_v = *(const u32x4*)(Vb + o5); g_s = *(const u32x4*)(ZZ + oz); g_a = *(const u32x4*)(ZZ + oz + 1024); } while (0)
#define MASK2(acc_, INCL) do { _Pragma("unroll") for (int q = 0; q < 2; ++q) _Pragma("unroll") for (int r = 0; r < 4; ++r) { const int m_ = 16 * mt + 4 * g + r, n_ = 16 * (nt0 + q) + x; \
        if (INCL ? (n_ > m_) : (n_ >= m_)) acc_[q][r] = 0.f; } } while (0)
#define ZERO2(acc_) do { acc_[0] = (f32x4){0.f, 0.f, 0.f, 0.f}; acc_[1] = (f32x4){0.f, 0.f, 0.f, 0.f}; } while (0)
            SC_LOAD(c0);
            LBAR();
#pragma unroll 1
            for (int c = c0; c < c1; ++c) {
                LAS unsigned char* Hcur = BUF(7 + (c & 1)); LAS unsigned char* Hnxt = BUF(7 + ((c + 1) & 1));
                int lane_ = lane; asm volatile("" : "+v"(lane_));
                const ck::LaneOff lo_ = ck::lane_off(lane_); const int x = lane_ & 15, g = lane_ >> 4;
                { const u32x4 vraw = g_v, rraw = g_r, kraw = g_k, sraw = g_s, araw = g_a;
                  float inv_;
                  float cs[8];
                  { float ss = 0.f;
                    const f32x4 p0 = *(const LAS f32x4*)(PRM + 8 * c8), p1 = *(const LAS f32x4*)(PRM + 8 * c8 + 4);
#pragma unroll
                    for (int i = 0; i < 4; ++i) { const float k0 = lo2f(kraw[i]) * (i < 2 ? p0[2 * i] : p1[2 * i - 4]), k1 = hi2f(kraw[i]) * (i < 2 ? p0[2 * i + 1] : p1[2 * i - 3]); ss += k0 * k0 + k1 * k1;
                        cs[2 * i] = -0.6065306597126334f * lo2f(sraw[i]); cs[2 * i + 1] = -0.6065306597126334f * hi2f(sraw[i]); }
                    ss += __shfl_xor(ss, 1); ss += __shfl_xor(ss, 2); ss += __shfl_xor(ss, 4);
                    inv_ = 1.f / sqrtf(ss + 1e-12f); }
#pragma unroll
                  for (int d = 8; d < 64; d <<= 1)
#pragma unroll
                      for (int i = 0; i < 8; ++i) { const float v = __shfl_up(cs[i], d); cs[i] += lane >= d ? v : 0.f; }
                  if ((lane >> 3) == 7) { *(LAS f32x4*)(SEG + wv * 64 + 8 * c8) = (f32x4){cs[0], cs[1], cs[2], cs[3]}; *(LAS f32x4*)(SEG + wv * 64 + 8 * c8 + 4) = (f32x4){cs[4], cs[5], cs[6], cs[7]}; }
                  LBAR();
                  const int off = st * ck::PT + 16 * c8;
#pragma unroll
                  for (int hf = 0; hf < 2; ++hf) {
                      f32x4 pre = {0.f, 0.f, 0.f, 0.f}, tot = {0.f, 0.f, 0.f, 0.f};
#pragma unroll
                      for (int q = 0; q < 8; ++q) { const f32x4 v0 = *(const LAS f32x4*)(SEG + q * 64 + 8 * c8 + 4 * hf); tot += v0; if (q < wv) pre += v0; }
                      const f32x4 kk4 = *(const LAS f32x4*)(PRM + 8 * c8 + 4 * hf), ka4 = *(const LAS f32x4*)(PRM + 64 + 8 * c8 + 4 * hf);
                      float oa[4], orr[4], ob[4], ok[4], obh[4], okh[4];
#pragma unroll
                      for (int i = 0; i < 4; ++i) { const int w_ = 2 * hf + (i >> 1); const bool hi_ = i & 1;
                          const float kv = hi_ ? hi2f(kraw[w_]) : lo2f(kraw[w_]), av = hi_ ? hi2f(araw[w_]) : lo2f(araw[w_]), rv = hi_ ? hi2f(rraw[w_]) : lo2f(rraw[w_]), sv_ = hi_ ? hi2f(sraw[w_]) : lo2f(sraw[w_]);
                          const float kn = kv * kk4[i] * inv_, bb = kn * av, kd = kv * (1.f + (av - 1.f) * ka4[i]), lw = -0.6065306597126334f * sv_;
                          const float lc = pre[i] + cs[4 * hf + i]; const float e1 = __expf(lc), e0 = __expf(lc - lw), em = __expf(-lc), eh = __expf(tot[i] - lc);
                          oa[i] = -kn * e0; orr[i] = rv * e1; ob[i] = bb * em; ok[i] = kd * em; obh[i] = bb * eh; okh[i] = kd * eh; }
                      *(LAS u32x2*)(BUF(0) + off + 8 * hf) = (u32x2){pk2(oa[0], oa[1]), pk2(oa[2], oa[3])}; if (PASS == 2) *(LAS u32x2*)(BUF(1) + off + 8 * hf) = (u32x2){pk2(orr[0], orr[1]), pk2(orr[2], orr[3])};
                      *(LAS u32x2*)(BUF(2) + off + 8 * hf) = (u32x2){pk2(ob[0], ob[1]), pk2(ob[2], ob[3])}; *(LAS u32x2*)(BUF(3) + off + 8 * hf) = (u32x2){pk2(ok[0], ok[1]), pk2(ok[2], ok[3])};
                      *(LAS u32x2*)(BUF(4) + off + 8 * hf) = (u32x2){pk2(obh[0], obh[1]), pk2(obh[2], obh[3])}; *(LAS u32x2*)(BUF(5) + off + 8 * hf) = (u32x2){pk2(okh[0], okh[1]), pk2(okh[2], okh[3])};
                      if (st == 0) *(LAS f32x4*)(GAM + 8 * c8 + 4 * hf) = (f32x4){__expf(tot[0]), __expf(tot[1]), __expf(tot[2]), __expf(tot[3])};
                      asm volatile("" ::: "memory"); }
                  *(LAS u32x4*)(BUF(6) + off) = vraw; }
                if (c + 1 < c1) SC_LOAD(c + 1);
                LBAR();
                f32x4 Wacc[2], t2[2];
                ZERO2(Wacc); ck::mm2<false, false>(Wacc, BUF(0), BUF(2), mt, nt0, lo_); MASK2(Wacc, false); ck::st2(BUF(12), Wacc, mt, nt0, lo_);
                ZERO2(t2); ck::mm2<false, false>(t2, BUF(0), BUF(3), mt, nt0, lo_); MASK2(t2, false); ck::st2(BUF(9), t2, mt, nt0, lo_);
                if (PASS == 2) {
                ZERO2(t2); ck::mm2<false, false>(t2, BUF(1), BUF(2), mt, nt0, lo_); MASK2(t2, true); ck::st2(BUF(10), t2, mt, nt0, lo_);
                ZERO2(t2); ck::mm2<false, false>(t2, BUF(1), BUF(3), mt, nt0, lo_); MASK2(t2, true); ck::st2(BUF(11), t2, mt, nt0, lo_); }
                LBAR();
                ZERO2(t2); ck::mm2<true, true>(t2, BUF(9), BUF(6), mt, nt0, lo_); ck::mm2<false, false>(t2, BUF(0), Hcur, mt, nt0, lo_); ck::st2(BUF(2), t2, mt, nt0, lo_);
#pragma unroll
                for (int q = 0; q < 2; ++q)
#pragma unroll
                    for (int r = 0; r < 4; ++r) if (16 * mt + 4 * g + r == 16 * (nt0 + q) + x) Wacc[q][r] += 1.f;
                ck::st2(BUF(13), Wacc, mt, nt0, lo_);
                if (PASS == 1) { ZERO2(t2); ck::mm2<false, false>(t2, BUF(0), BUF(1), mt, nt0, lo_); ck::st2(BUF(10), t2, mt, nt0, lo_); }
                ZERO2(t2); ck::mm2<true, false>(t2, BUF(12), BUF(12), mt, nt0, lo_); ck::st2(BUF(3), t2, mt, nt0, lo_);
                LBAR();
#define WSTEP(Wold, Pcur, Wnew, Pnext, HASNEXT) do { ck::mm2<true, false>(Wacc, BUF(Wold), BUF(Pcur), mt, nt0, lo_); ck::st2(BUF(Wnew), Wacc, mt, nt0, lo_); \
        if (HASNEXT) { ZERO2(t2); ck::mm2<true, false>(t2, BUF(Pcur), BUF(Pcur), mt, nt0, lo_); ck::st2(BUF(Pnext), t2, mt, nt0, lo_); } LBAR(); } while (0)
                WSTEP(13, 3, 9, 12, true); WSTEP(9, 12, 13, 3, true); WSTEP(13, 3, 9, 12, true); WSTEP(9, 12, 13, 3, true); WSTEP(13, 3, 9, 12, false);
                ZERO2(t2); ck::mm2<true, false>(t2, BUF(9), BUF(2), mt, nt0, lo_); ck::st2(BUF(0), t2, mt, nt0, lo_);
                if (PASS == 1) { ZERO2(t2); ck::mm2<true, false>(t2, BUF(9), BUF(10), mt, nt0, lo_); ck::st2(BUF(11), t2, mt, nt0, lo_); }
                LBAR();
                if (PASS == 2) {
                ZERO2(t2); ck::mm2<false, false>(t2, Hcur, BUF(1), mt, nt0, lo_); ck::mm2<false, true>(t2, BUF(0), BUF(10), mt, nt0, lo_); ck::mm2<true, true>(t2, BUF(6), BUF(11), mt, nt0, lo_);
#pragma unroll
                for (int q = 0; q < 2; ++q) { const int m_ = SC_ROW(c * 64 + 16 * (nt0 + q) + x);
                    *(u32x2*)(Y + (size_t)m_ * 512 + h * 64 + 16 * mt + 4 * g) = (u32x2){pk2(t2[q][0], t2[q][1]), pk2(t2[q][2], t2[q][3])}; } }
                { const f32x4 gm = *(const LAS f32x4*)(GAM + 16 * mt + 4 * g); Hacc[0] = Hacc[0] * gm; Hacc[1] = Hacc[1] * gm; if (PASS == 1) { Hb[0] = Hb[0] * gm; Hb[1] = Hb[1] * gm; } }
                if (PASS == 1) { ck::mm2<true, false>(Hb, BUF(4), BUF(11), mt, nt0, lo_); ck::st2(BUF(1), Hb, mt, nt0, lo_); }
                ck::mm2<true, false>(Hacc, BUF(4), BUF(0), mt, nt0, lo_); ck::mm2<true, true>(Hacc, BUF(5), BUF(6), mt, nt0, lo_);
                ck::st2(Hnxt, Hacc, mt, nt0, lo_);
                LBAR();
            }
            if (PASS == 1) { const int x_ = lane & 15, g_ = lane >> 4;
#pragma unroll
                for (int q = 0; q < 2; ++q)
#pragma unroll
                    for (int r = 0; r < 4; ++r) { const int o_ = (16 * mt + 4 * g_ + r) * 64 + 16 * (nt0 + q) + x_; SEGG[o_] = Hacc[q][r]; SEGM[o_] = Hb[q][r]; } }
            __syncthreads();
#undef WSTEP
#undef ZERO2
#undef MASK2
#undef SC_ROW
#undef SC_LOAD
#undef LBAR
#undef BUF
        }

#define IN(k) (lo <= (k) && (k) < hi)
#define SEAM(k) do { if (N_LAUNCH_MODE == 1 && IN((k) + 1)) xcd_barrier(bar); } while (0)
template <int L>
__device__ __forceinline__ void moe_block(const Args& args, const Ctx& F, const XcdBarrier& bar, const int lo, const int hi) {
    const int gw = F.bid * NWAVES + F.wave, NGW = F.G * NWAVES, lane = F.lane, tid = F.tid;
    unsigned char* ws = F.ws; unsigned* ctl = (unsigned*)(ws + WS_CTL); float* MODS = (float*)(ws + SM_MODS);
    volatile LAS unsigned* MISC = (volatile LAS unsigned*)(F.lds + MISC_OFF);
    constexpr int l = L, pb = L == 0 ? 11 : 20, NROW = L == 0 ? T : 2 * SEQ;
    unsigned* cnt = ctl + CW_CNT + l * 1024;
    bf16_t* MW1 = (bf16_t*)(ws + WS_B); bf16_t* MW2 = MW1 + (size_t)17 * 512 * 1024;
    if (CT(11) && IN(pb + 0)) { PH_LOCALS
        LAS float* rwT = (LAS float*)F.lds;
        for (int i = tid; i < 16384; i += NTHR) { const int k = i >> 4, e = i & 15; rwT[e * 1024 + k] = INP(I_RW)[i]; }
        __syncthreads();
        bf16_t* H = (bf16_t*)(ws + WS_A); int* SEL = (int*)(ws + SM_SEL); float* WTS = (float*)(ws + SM_WTS);
        const float rbias_l = lane < 16 ? INP(I_RBIAS)[lane] : 0.f; const float* n2g = INP(I_N2G) + l * 1024;
        for (int r = gw; r < NROW; r += NGW) { const int m = l == 0 ? r : (r / SEQ) * RB + CTXL + r % SEQ; const int b = m / RB; const bool cx = (m % RB) < CTXL;
            const float* md = MODS + (l * 3 + (cx ? 2 : b)) * 6144; f32x4 hv[4];
            norm_mod_row(xl_row(F, m), n2g, md + 3 * 1024, md + 4 * 1024, H + (size_t)m * DM, lane, hv);
            float mylg = 0.f;
#pragma unroll 2
            for (int e = 0; e < 16; ++e) { float a = 0.f;
#pragma unroll
                for (int j = 0; j < 4; ++j) { const f32x4 w = *(const LAS f32x4*)(rwT + e * 1024 + 4 * lane + 256 * j); a += hv[j].x * w.x + hv[j].y * w.y + hv[j].z * w.z + hv[j].w * w.w; }
                a = wave_sum(a); mylg = lane == e ? a : mylg; }
            const float mysc = 1.f / (1.f + __expf(-mylg)), mybs = mysc + rbias_l;
            float sc[16], bs[16];
#pragma unroll
            for (int e = 0; e < 16; ++e) { sc[e] = __int_as_float(__builtin_amdgcn_readlane(__float_as_int(mysc), e)); bs[e] = __int_as_float(__builtin_amdgcn_readlane(__float_as_int(mybs), e)); }
            int grp = 0; float best = -1e30f;
#pragma unroll
            for (int g = 0; g < 4; ++g) { float m1 = -1e30f, m2 = -1e30f;
#pragma unroll
                for (int q = 0; q < 4; ++q) { const float v = bs[g * 4 + q]; if (v > m1) { m2 = m1; m1 = v; } else if (v > m2) m2 = v; }
                const float gs = m1 + m2; if (gs > best) { best = gs; grp = g; } }
            float v4[4], s4[4];
#pragma unroll
            for (int q = 0; q < 4; ++q) { v4[q] = grp == 0 ? bs[q] : grp == 1 ? bs[4 + q] : grp == 2 ? bs[8 + q] : bs[12 + q]; s4[q] = grp == 0 ? sc[q] : grp == 1 ? sc[4 + q] : grp == 2 ? sc[8 + q] : sc[12 + q]; }
            int i0 = 0; float bv0 = v4[0];
#pragma unroll
            for (int q = 1; q < 4; ++q) if (v4[q] > bv0) { bv0 = v4[q]; i0 = q; }
            int i1 = -1; float bv1 = -1e30f;
#pragma unroll
            for (int q = 0; q < 4; ++q) if (q != i0 && v4[q] > bv1) { bv1 = v4[q]; i1 = q; }
            float w0 = 0.f, w1 = 0.f;
#pragma unroll
            for (int q = 0; q < 4; ++q) { w0 = q == i0 ? s4[q] : w0; w1 = q == i1 ? s4[q] : w1; }
            const float ws_ = 1.f / (w0 + w1);
            if (lane == 0) { const int e0 = grp * 4 + i0, e1 = grp * 4 + i1;
                const int s0 = (int)atomicAdd(cnt + e0 * 64, 1u), s1 = (int)atomicAdd(cnt + e1 * 64, 1u);
                *(int4*)(SEL + (size_t)m * 4) = make_int4(e0, s0, e1, s1); *(float2*)(WTS + (size_t)m * 2) = make_float2(w0 * ws_, w1 * ws_); }
        }
        __syncthreads();
        LAS float* scr = (LAS float*)(F.lds + F.wave * 12288);
        for (int it = gw; it < 17 * 384; it += NGW) { const int e = it / 384, r = it % 384;
            if (r < 256) { const int isup = r >> 7, rr = r & 127, kb = rr >> 3, nb = rr & 7;
                const float* W = e < 16 ? (isup ? INP(I_MUP) : INP(I_MGATE)) + ((size_t)l * 16 + e) * 1024 * 256 : (isup ? INP(I_SUP) : INP(I_SGATE)) + (size_t)l * 1024 * 256;
                const int f0 = nb * 32, drow = (f0 >> 7) * 256 + isup * 128 + (f0 & 127);
                tr_item(W, 256, kb * 64, f0, MW1 + (size_t)e * 512 * 1024 + (size_t)drow * 1024 + kb * 64, 1024, scr, lane); }
            else { const int rr = r - 256, kb = rr >> 5, nb = rr & 31;
                const float* W = e < 16 ? INP(I_MDOWN) + ((size_t)l * 16 + e) * 256 * 1024 : INP(I_SDOWN) + (size_t)l * 256 * 1024;
                tr_item(W, 1024, kb * 64, nb * 32, MW2 + (size_t)e * 1024 * 256 + (size_t)(nb * 32) * 256 + kb * 64, 256, scr, lane); } }
        SEAM(pb + 0);
    }
    if (CT(12) && IN(pb + 1)) { PH_LOCALS
        const bf16_t* H = (const bf16_t*)(ws + WS_A); bf16_t* HSb = (bf16_t*)(ws + WS_C); const int* SEL = (const int*)(ws + SM_SEL); const float* WTS = (const float*)(ws + SM_WTS);
        int* POS = (int*)(ws + SM_POS); float* ROWWT = (float*)(ws + SM_ROWWT);
        int seg[16]; { int tot = 0;
#pragma unroll
            for (int e = 0; e < 16; ++e) { seg[e] = tot; tot += (int)((cnt[e * 64] + 255u) & ~255u); } }
        for (int r = gw; r < NROW; r += NGW) { const int m = l == 0 ? r : (r / SEQ) * RB + CTXL + r % SEQ;
            const int4 s = *(const int4*)(SEL + (size_t)m * 4); const float2 w = *(const float2*)(WTS + (size_t)m * 2);
            int d0 = 0, d1 = 0;
#pragma unroll
            for (int e = 0; e < 16; ++e) { d0 = s.x == e ? seg[e] : d0; d1 = s.z == e ? seg[e] : d1; }
            d0 += s.y; d1 += s.w;
            const u32x4* src = (const u32x4*)(H + (size_t)m * DM) + lane; u32x4* p0 = (u32x4*)(HSb + (size_t)d0 * DM) + lane; u32x4* p1 = (u32x4*)(HSb + (size_t)d1 * DM) + lane;
            const u32x4 a = src[0], c = src[64]; p0[0] = a; p0[64] = c; p1[0] = a; p1[64] = c;
            if (lane == 0) { POS[(size_t)m * 2] = d0; POS[(size_t)m * 2 + 1] = d1; ROWWT[d0] = w.x; ROWWT[d1] = w.y; } }
        SEAM(pb + 1);
    }
    if (CT(13) && IN(pb + 2)) { PH_LOCALS
        if (tid == 0) moe_units(MISC + 16, cnt, F.G, F.bid, 2, l == 0 ? 66 : 64, l);
        __syncthreads();
        SchedMoe S{MISC + 16, (const char*)(ws + WS_C), (const char*)(ws + WS_A), (size_t)256 * 1024 * 2,
                   (const char*)MW1, (size_t)512 * 1024 * 2, (size_t)256 * 1024 * 2, (char*)(ws + WS_ACT), (char*)(ws + WS_ACT) + (size_t)HS_ROWS * 512, (size_t)256 * 512, (const float*)(ws + SM_ROWWT)};
        g8::EpiSwiGLU E{};
        g8::gemm_phase(F.lds, 1024, S, E);
        SEAM(pb + 2);
    }
    if (CT(14) && IN(pb + 3)) { PH_LOCALS
        if (tid == 0) moe_units(MISC + 16, cnt, F.G, F.bid, 4, l == 0 ? 66 : 64, l);
        __syncthreads();
        SchedMoe S{MISC + 16, (const char*)(ws + WS_ACT), (const char*)(ws + WS_ACT) + (size_t)HS_ROWS * 512, (size_t)256 * 256 * 2,
                   (const char*)MW2, (size_t)1024 * 256 * 2, (size_t)256 * 256 * 2, (char*)(ws + WS_C), (char*)(ws + WS_A), (size_t)256 * 1024 * 2, nullptr};
        g8::EpiStoreBf16 E{1024, nullptr, 0};
        g8::gemm_phase(F.lds, 256, S, E);
        SEAM(pb + 3);
    }
    if (CT(15) && IN(pb + 4)) { PH_LOCALS
        const bf16_t* YS = (const bf16_t*)(ws + WS_C); bf16_t* YSH = (bf16_t*)(ws + WS_A); const int* POS = (const int*)(ws + SM_POS); const float* n1g1 = INP(I_N1G) + 1024;
        for (int r = gw; r < NROW; r += NGW) { const int m = l == 0 ? r : (r / SEQ) * RB + CTXL + r % SEQ; const int b = m / RB; const bool cx = (m % RB) < CTXL;
            const float* ga2 = MODS + (l * 3 + (cx ? 2 : b)) * 6144 + 5 * 1024;
            const int d0 = POS[(size_t)m * 2], d1 = POS[(size_t)m * 2 + 1];
            float* xr = xl_row(F, m);
            const u32x2* y0 = (const u32x2*)(YS + (size_t)d0 * DM) + lane; const u32x2* y1 = (const u32x2*)(YS + (size_t)d1 * DM) + lane; const u32x2* y2 = (const u32x2*)(YSH + (size_t)m * DM) + lane;
            f32x4 v[4]; float ss = 0.f;
#pragma unroll
            for (int j = 0; j < 4; ++j) { const u32x2 a = y0[64 * j], c = y1[64 * j], d = y2[64 * j]; const f32x4 g = ((const f32x4*)ga2)[lane + 64 * j]; f32x4 x = ((const f32x4*)xr)[lane + 64 * j];
                x.x += g.x * (lo2f(a.x) + lo2f(c.x) + lo2f(d.x)); x.y += g.y * (hi2f(a.x) + hi2f(c.x) + hi2f(d.x)); x.z += g.z * (lo2f(a.y) + lo2f(c.y) + lo2f(d.y)); x.w += g.w * (hi2f(a.y) + hi2f(c.y) + hi2f(d.y));
                ((f32x4*)xr)[lane + 64 * j] = x; v[j] = x; ss += (x.x * x.x + x.y * x.y) + (x.z * x.z + x.w * x.w); }
            if (l == 0) { const float rstd = 1.f / sqrtf(wave_sum(ss) * (1.f / DM) + 1e-6f); const float* md = MODS + (1 * 3 + (cx ? 2 : b)) * 6144; const float* g1 = n1g1;
                unsigned long long* o8 = (unsigned long long*)(YSH + (size_t)m * DM) + lane;
#pragma unroll
                for (int j = 0; j < 4; ++j) { const f32x4 gg = ((const f32x4*)g1)[lane + 64 * j], s1 = ((const f32x4*)(md + 1024))[lane + 64 * j], s0 = ((const f32x4*)md)[lane + 64 * j];
                    const f32x4 h = (v[j] * rstd * gg) * (s1 + 1.f) + s0; o8[64 * j] = (unsigned long long)pk2(h.x, h.y) | ((unsigned long long)pk2(h.z, h.w) << 32); } }
        }
        SEAM(pb + 4);
    }
}

__global__ void __launch_bounds__(NTHR, 2) fwd_kernel(Args args) {
    extern __shared__ __attribute__((aligned(16))) unsigned char lds_raw[];
    Ctx F; F.lds = (LAS unsigned char*)lds_raw; F.tid = threadIdx.x; F.lane = F.tid & 63; F.wave = __builtin_amdgcn_readfirstlane(F.tid >> 6);
    F.G = gridDim.x; F.bid = blockIdx.x; F.ws = args.ws; F.out = args.out;
    volatile LAS unsigned* MISC = (volatile LAS unsigned*)(F.lds + MISC_OFF);
    unsigned* ctl = (unsigned*)(F.ws + WS_CTL);
    for (int u = F.tid; u < (LDS_BYTES - LDSCTL_OFF) / 4; u += NTHR) ((LAS unsigned*)(F.lds + LDSCTL_OFF))[u] = 0u;
    __syncthreads();
    XcdBarrier bar; bar.bar = ctl + CW_BAR; bar.x = 0; bar.st = nullptr;
    if (N_LAUNCH_MODE == 1) bar = xcd_barrier_post(ctl + CW_BAR + args.li * XCD_BAR_WORDS, MISC + 8);
    const int lo = args.ph_lo, hi = args.ph_hi;
    const int gw = F.bid * NWAVES + F.wave, NGW = F.G * NWAVES, lane = F.lane, tid = F.tid;
    unsigned char* ws = F.ws;
    float* MODS = (float*)(ws + SM_MODS);
    bf16_t* WD = (bf16_t*)(ws + WS_WD);

    if (CT(0) && IN(0)) { PH_LOCALS
        if (F.bid < 192) {
            LAS float* sl = (LAS float*)F.lds;
            for (int i = tid; i < 3072; i += NTHR) { const int v = i >> 10, k = i & 1023; const float x = v < 2 ? INP(I_C)[v * 1024 + k] : INP(I_CCTX)[k]; sl[i] = x * sigmoidf_(x); }
            __syncthreads();
            const int l = F.bid / 96, n0 = (F.bid % 96) * 64, ks = tid >> 6, nl = tid & 63;
            const float* W = INP(I_ADAW) + (size_t)l * 1024 * 6144 + n0 + nl;
            float a0 = 0.f, a1 = 0.f, a2 = 0.f;
#pragma unroll 8
            for (int k = ks * 128; k < ks * 128 + 128; ++k) { const float w = W[(size_t)k * 6144]; a0 += sl[k] * w; a1 += sl[1024 + k] * w; a2 += sl[2048 + k] * w; }
            LAS float* part = sl + 3072;
            part[(ks * 3 + 0) * 64 + nl] = a0; part[(ks * 3 + 1) * 64 + nl] = a1; part[(ks * 3 + 2) * 64 + nl] = a2;
            __syncthreads();
            if (tid < 192) { const int v = tid >> 6, n = tid & 63; float s = INP(I_ADAB)[l * 6144 + n0 + n];
#pragma unroll
                for (int q = 0; q < 8; ++q) s += part[(q * 3 + v) * 64 + n];
                MODS[(l * 3 + v) * 6144 + n0 + n] = s; }
            __syncthreads();
        }
        if (F.bid == 192) { float* bz = (float*)(ws + SM_BIASZ);
            for (int i = tid; i < 2560; i += NTHR) bz[i] = i < 1024 ? INP(I_W0)[i] : (i < 2048 ? INP(I_A0)[i - 1024] : 0.f); }
        LAS float* scr = (LAS float*)(F.lds + 32768 + F.wave * 12288);
        constexpr int I1 = 16 * 81, I2 = 16 * 32, I3 = 16, I4 = 32, I5 = 6 * 24, I6 = 4 * 32, I7 = 16 * 48, I8 = 16 * 32;
        constexpr int NIT = I1 + I2 + 4 * I3 + I4 + I5 + I6 + I7 + I8;
        for (int it = gw; it < NIT; it += NGW) {
            int r = it;
            if (r < I1) { tr_matrix_item(INP(I_ABWIN), 1024, 2592, WD + O_WIN0 / 2, 1024, scr, r, lane); continue; } r -= I1;
            if (r < I2) { tr_matrix_item(INP(I_ABWOUT), 1024, 1024, WD + O_WOUT0 / 2, 1024, scr, r, lane); continue; } r -= I2;
            if (r < I3) { tr_matrix_item(INP(I_W2), 64, 512, WD + O_WLORA / 2 + (size_t)0 * 384 + 0, 384, scr, r, lane); continue; } r -= I3;
            if (r < I3) { tr_matrix_item(INP(I_W2) + 64 * 512, 64, 512, WD + O_WLORA / 2 + (size_t)512 * 384 + 64, 384, scr, r, lane); continue; } r -= I3;
            if (r < I3) { tr_matrix_item(INP(I_A2), 64, 512, WD + O_WLORA / 2 + (size_t)1024 * 384 + 128, 384, scr, r, lane); continue; } r -= I3;
            if (r < I3) { tr_matrix_item(INP(I_A2) + 64 * 512, 64, 512, WD + O_WLORA / 2 + (size_t)1536 * 384 + 192, 384, scr, r, lane); continue; } r -= I3;
            if (r < I4) { tr_matrix_item(INP(I_G2), 128, 512, WD + O_WLORA / 2 + (size_t)2048 * 384 + 256, 384, scr, r, lane); continue; } r -= I4;
            if (r < I5) { tr_matrix_item(INP(I_WQUP), 384, 768, WD + O_WQUP / 2, 384, scr, r, lane); continue; } r -= I5;
            if (r < I6) { tr_matrix_item(INP(I_WKVUP), 256, 1024, WD + O_WKVUP / 2, 256, scr, r, lane); continue; } r -= I6;
            if (r < I7) { tr_matrix_item(INP(I_GWIN), 1024, 1536, WD + O_WIN1 / 2, 1024, scr, r, lane); continue; } r -= I7;
            tr_matrix_item(INP(I_GWOUT), 1024, 1024, WD + O_WOUT1 / 2, 1024, scr, r, lane);
        }
        { const int gt = F.bid * NTHR + tid, NGT = F.G * NTHR; const u32x4 z = {0u, 0u, 0u, 0u};
          for (int i = gt; i < 224 * 128; i += NGT) *(u32x4*)(WD + O_WIN0 / 2 + (size_t)2592 * 1024 + (size_t)i * 8) = z;
          for (int i = gt; i < 2560 * 48; i += NGT) { const int n = i / 48, ch = i % 48, blk = n >> 9; const int klo = blk < 4 ? blk * 64 : 256, khi = blk < 4 ? klo + 64 : 384;
              if (ch * 8 < klo || ch * 8 >= khi) *(u32x4*)(WD + O_WLORA / 2 + (size_t)n * 384 + ch * 8) = z; } }
        SEAM(0);
    }

    if (CT(1) && IN(1)) { PH_LOCALS
        bf16_t* H = (bf16_t*)(ws + WS_A); const float* pctx = INP(I_CTX); const float* px = INP(I_X); const float* n1g = INP(I_N1G);
        for (int m = gw; m < T; m += NGW) { const int b = m / RB, j = m % RB; const bool cx = j < CTXL;
            const float* xr = cx ? pctx + (size_t)(b * CTXL + j) * DM : px + (size_t)(b * SEQ + j - CTXL) * DM;
            const float* md = MODS + (0 * 3 + (cx ? 2 : b)) * 6144; f32x4 hv[4];
            norm_mod_row(xr, n1g, md, md + 1024, H + (size_t)m * DM, lane, hv); }
        SEAM(1);
    }
    if (CT(2) && IN(2)) { PH_LOCALS
        SchedDense S{66, 11, F.G, F.bid, (const char*)(ws + WS_A), (const char*)(WD + O_WIN0 / 2), (char*)(ws + WS_C), (size_t)256 * 1024 * 2, (size_t)256 * 1024 * 2, (size_t)256 * 2816 * 2, 0};
        g8::EpiStoreBf16 E{2816, nullptr, 0};
        g8::gemm_phase(F.lds, 1024, S, E);
        SEAM(2);
    }
    if (CT(3) && IN(3)) { PH_LOCALS
        const bf16_t* P = (const bf16_t*)(ws + WS_C);
        bf16_t* Rb = (bf16_t*)(ws + WS_B); bf16_t* Kb = Rb + (size_t)T * 512; bf16_t* Vb = Kb + (size_t)T * 512;
        bf16_t* LIN = (bf16_t*)(ws + WS_A); bf16_t* QAN = LIN + (size_t)T * 384; bf16_t* KVAN = QAN + (size_t)T * 384;
        float* KROPE = (float*)(ws + WS_KROPE);
        const float* mu = INP(I_MU); const float* gqa_ = INP(I_GQA_); const float* gkva_ = INP(I_GKVA);
        for (int m = gw; m < T; m += NGW) { const int j = m % RB;
            const bool hasp = !(j == 0 || j == CTXL), hasn = !(j == CTXL - 1 || j == RB - 1);
            const bf16_t* pr = P + (size_t)m * 2816;
#pragma unroll 1
            for (int ch = lane; ch < 240; ch += 64) {
                const u32x4 pc = *(const u32x4*)(pr + ch * 8);
                u32x4 pp = {0u, 0u, 0u, 0u}, pn = {0u, 0u, 0u, 0u};
                if (hasp) pp = *(const u32x4*)(pr - 2816 + ch * 8);
                if (hasn) pn = *(const u32x4*)(pr + 2816 + ch * 8);
                const f32x4 m0 = *(const f32x4*)(mu + ch * 8), m1 = *(const f32x4*)(mu + ch * 8 + 4);
                float o[8];
#pragma unroll
                for (int q = 0; q < 4; ++q) { const unsigned c = pc[q], a = pp[q], n = pn[q];
                    const float c0 = lo2f(c), c1 = hi2f(c), mm0 = q < 2 ? m0[2 * q] : m1[2 * q - 4], mm1 = q < 2 ? m0[2 * q + 1] : m1[2 * q - 3];
                    o[2 * q] = c0 + mm0 * (0.5f * (lo2f(a) + lo2f(n)) - c0); o[2 * q + 1] = c1 + mm1 * (0.5f * (hi2f(a) + hi2f(n)) - c1); }
                bf16_t* dst;
                if (ch < 64) dst = Rb + (size_t)m * 512 + ch * 8;
                else if (ch < 128) dst = Kb + (size_t)m * 512 + (ch - 64) * 8;
                else if (ch < 192) dst = Vb + (size_t)m * 512 + (ch - 128) * 8;
                else { dst = LIN + (size_t)m * 384 + (ch - 192) * 8;
                    if (ch < 208) {
#pragma unroll
                        for (int q = 0; q < 8; ++q) { const float e = __expf(-2.f * fabsf(o[q])); const float th = (1.f - e) * __builtin_amdgcn_rcpf(1.f + e); o[q] = o[q] < 0.f ? -th : th; } }
                    else if (ch >= 224) {
#pragma unroll
                        for (int q = 0; q < 8; ++q) o[q] = sigmoidf_(o[q]); } }
                u32x4 w; w.x = pk2(o[0], o[1]); w.y = pk2(o[2], o[3]); w.z = pk2(o[4], o[5]); w.w = pk2(o[6], o[7]);
                *(u32x4*)dst = w;
            }
            { float q[8], ss = 0.f; const bool act = lane < 48;
              const u32x4 pc = act ? *(const u32x4*)(pr + 1920 + lane * 8) : (u32x4){0u, 0u, 0u, 0u};
#pragma unroll
              for (int i = 0; i < 4; ++i) { q[2 * i] = lo2f(pc[i]); q[2 * i + 1] = hi2f(pc[i]); ss += q[2 * i] * q[2 * i] + q[2 * i + 1] * q[2 * i + 1]; }
              const float rstd = 1.f / sqrtf(wave_sum(ss) * (1.f / 384.f) + 1e-6f);
              if (act) { const float* g = gqa_ + lane * 8; u32x4 w; w.x = pk2(q[0] * rstd * g[0], q[1] * rstd * g[1]); w.y = pk2(q[2] * rstd * g[2], q[3] * rstd * g[3]);
                  w.z = pk2(q[4] * rstd * g[4], q[5] * rstd * g[5]); w.w = pk2(q[6] * rstd * g[6], q[7] * rstd * g[7]); *(u32x4*)(QAN + (size_t)m * 384 + lane * 8) = w; } }
            { float q[8], ss = 0.f; const bool act = lane < 32;
              const u32x4 pc = act ? *(const u32x4*)(pr + 2304 + lane * 8) : (u32x4){0u, 0u, 0u, 0u};
#pragma unroll
              for (int i = 0; i < 4; ++i) { q[2 * i] = lo2f(pc[i]); q[2 * i + 1] = hi2f(pc[i]); ss += q[2 * i] * q[2 * i] + q[2 * i + 1] * q[2 * i + 1]; }
              const float rstd = 1.f / sqrtf(wave_sum(ss) * (1.f / 256.f) + 1e-6f);
              if (act) { const float* g = gkva_ + lane * 8; u32x4 w; w.x = pk2(q[0] * rstd * g[0], q[1] * rstd * g[1]); w.y = pk2(q[2] * rstd * g[2], q[3] * rstd * g[3]);
                  w.z = pk2(q[4] * rstd * g[4], q[5] * rstd * g[5]); w.w = pk2(q[6] * rstd * g[6], q[7] * rstd * g[7]); *(u32x4*)(KVAN + (size_t)m * 256 + lane * 8) = w; } }
            if (lane < 32) KROPE[(size_t)m * 32 + lane] = bf2f(pr[2560 + lane]);
        }
        SEAM(3);
    }
    if (CT(4) && IN(4)) { PH_LOCALS
        { SchedDense S{66, 10, F.G, F.bid, (const char*)(ws + WS_A), (const char*)(WD + O_WLORA / 2), (char*)(ws + WS_C), (size_t)256 * 384 * 2, (size_t)256 * 384 * 2, (size_t)256 * 2560 * 2, 0};
          g8::EpiStoreBf16 E{2560, (const float*)(ws + SM_BIASZ), 2048};
          g8::gemm_phase(F.lds, 384, S, E); }
        { SchedDense S{66, 3, F.G, F.bid, (const char*)(ws + WS_A + SZ384), (const char*)(WD + O_WQUP / 2), (char*)(ws + WS_D), (size_t)256 * 384 * 2, (size_t)256 * 384 * 2, (size_t)256 * 768 * 2, 0};
          g8::EpiStoreBf16 E{768, nullptr, 0};
          g8::gemm_phase(F.lds, 384, S, E); }
        { SchedDense S{66, 4, F.G, F.bid, (const char*)(ws + WS_A + 2 * SZ384), (const char*)(WD + O_WKVUP / 2), (char*)(ws + WS_D + SZ768), (size_t)256 * 256 * 2, (size_t)256 * 256 * 2, (size_t)256 * 1024 * 2, 0};
          g8::EpiStoreBf16 E{1024, nullptr, 0};
          g8::gemm_phase(F.lds, 256, S, E); }
        SEAM(4);
    }
    if (CT(5) && IN(5)) { PH_LOCALS
        const bf16_t* QRAW = (const bf16_t*)(ws + WS_D); const bf16_t* KVRAW = (const bf16_t*)(ws + WS_D + SZ768); const float* KROPE = (const float*)(ws + WS_KROPE);
        bf16_t* Qm = (bf16_t*)F.out; bf16_t* Km = Qm + (size_t)T * 768; bf16_t* Vm = (bf16_t*)(ws + WS_A);
        const int h = lane >> 3, s = lane & 7;
        const float inv = __powf(10000.f, -(float)s * 0.125f);
        float gq[12], gk[12];
#pragma unroll
        for (int i = 0; i < 12; ++i) { gq[i] = INP(I_MGQ)[s + 8 * i]; gk[i] = INP(I_MGK)[s + 8 * i]; }
        for (int m = gw; m < T; m += NGW) { const int j = m % RB; const bool lat = j >= CTXL;
            float cr = 1.f, sr = 0.f, cc = 1.f, sc = 0.f;
            if (lat) { const int sp = j - CTXL; const float pr_ = (float)(sp >> 6), pc_ = (float)(sp & 63); sincosf(pr_ * inv, &sr, &cr); sincosf(pc_ * inv, &sc, &cc); }
            float q[12], k[12], ssq = 0.f, ssk = 0.f;
#pragma unroll
            for (int i = 0; i < 12; ++i) { q[i] = bf2f(QRAW[(size_t)m * 768 + h * 96 + s + 8 * i]); ssq += q[i] * q[i]; }
#pragma unroll
            for (int i = 0; i < 8; ++i) k[i] = bf2f(KVRAW[(size_t)m * 1024 + h * 128 + s + 8 * i]);
#pragma unroll
            for (int i = 8; i < 12; ++i) k[i] = KROPE[(size_t)m * 32 + s + 8 * (i - 8)];
#pragma unroll
            for (int i = 0; i < 12; ++i) ssk += k[i] * k[i];
            ssq += __shfl_xor(ssq, 1); ssq += __shfl_xor(ssq, 2); ssq += __shfl_xor(ssq, 4);
            ssk += __shfl_xor(ssk, 1); ssk += __shfl_xor(ssk, 2); ssk += __shfl_xor(ssk, 4);
            const float rq = 1.f / sqrtf(ssq * (1.f / 96.f) + 1e-6f), rk = 1.f / sqrtf(ssk * (1.f / 96.f) + 1e-6f);
#pragma unroll
            for (int i = 0; i < 12; ++i) { q[i] = q[i] * rq * gq[i]; k[i] = k[i] * rk * gk[i]; }
            { const float a = q[8], b2 = q[9]; q[8] = a * cr - b2 * sr; q[9] = b2 * cr + a * sr; const float c = q[10], d = q[11]; q[10] = c * cc - d * sc; q[11] = d * cc + c * sc; }
            { const float a = k[8], b2 = k[9]; k[8] = a * cr - b2 * sr; k[9] = b2 * cr + a * sr; const float c = k[10], d = k[11]; k[10] = c * cc - d * sc; k[11] = d * cc + c * sc; }
#pragma unroll
            for (int i = 0; i < 12; ++i) { Qm[(size_t)m * 768 + h * 96 + s + 8 * i] = (bf16_t)(pk2(q[i] * C2_MLA, 0.f) & 0xffffu); Km[(size_t)m * 768 + h * 96 + s + 8 * i] = (bf16_t)(pk2(k[i], 0.f) & 0xffffu); }
#pragma unroll
            for (int i = 0; i < 8; ++i) Vm[(size_t)m * 512 + h * 64 + s + 8 * i] = KVRAW[(size_t)m * 1024 + h * 128 + 64 + s + 8 * i];
        }
        SEAM(5);
    }
    if (CT(6) && IN(6)) { PH_LOCALS
        for (int unit = F.bid; unit < 256; unit += F.G) scan_pass<1>(args, F, unit);
        SEAM(6);
    }
    if (CT(7) && IN(7)) { PH_LOCALS
        LAS float* Ml = (LAS float*)F.lds; LAS float* Hl = Ml + 64 * 65;
        for (int sid = F.bid; sid < 32; sid += F.G) {
            float* SEGM = (float*)(ws + WS_SEG) + (size_t)sid * 8 * 4096; float* SEGG = SEGM + 256 * 4096; float* HIN = SEGG + 256 * 4096;
            const int j = tid >> 3, i0 = (tid & 7) * 8;
            __syncthreads();
            for (int i = tid; i < 4096; i += NTHR) { Hl[i] = 0.f; HIN[i] = 0.f; }
            for (int sg = 0; sg < 7; ++sg) {
                __syncthreads();
                for (int i = tid; i < 4096; i += NTHR) Ml[(i >> 6) * 65 + (i & 63)] = SEGM[sg * 4096 + i];
                __syncthreads();
                float acc[8];
#pragma unroll
                for (int q = 0; q < 8; ++q) acc[q] = SEGG[sg * 4096 + j * 64 + i0 + q];
#pragma unroll 4
                for (int k = 0; k < 64; ++k) { const float m = Ml[j * 65 + k]; const f32x4 h0 = *(const LAS f32x4*)(Hl + k * 64 + i0), h1 = *(const LAS f32x4*)(Hl + k * 64 + i0 + 4);
#pragma unroll
                    for (int q = 0; q < 4; ++q) { acc[q] += m * h0[q]; acc[4 + q] += m * h1[q]; } }
                __syncthreads();
#pragma unroll
                for (int q = 0; q < 8; ++q) { Hl[j * 64 + i0 + q] = acc[q]; HIN[(sg + 1) * 4096 + j * 64 + i0 + q] = acc[q]; }
            }
        }
        SEAM(7);
    }
    if (CT(8) && IN(8)) { PH_LOCALS
        unsigned* queue = ctl + CW_QUEUE;
        for (int unit = F.bid; unit < 256; unit += F.G) scan_pass<2>(args, F, unit);
        { const bf16_t* Qm = (const bf16_t*)F.out; const bf16_t* Km = Qm + (size_t)T * 768; const bf16_t* Vm = (const bf16_t*)(ws + WS_A); bf16_t* CAT = (bf16_t*)(ws + WS_D);
          for (;;) {
              __syncthreads();
              if (tid == 0) MISC[0] = atomicAdd(queue, 1u);
              __syncthreads();
              const unsigned u = MISC[0];
              if (u >= 528u) break;
              const int bh = u < 512u ? (int)u / 32 : (int)u - 512, qb = u < 512u ? 1 + (int)u % 32 : 0, b = bh >> 3, h = bh & 7;
              const size_t m0 = (size_t)b * RB + (size_t)qb * 256, k0 = (size_t)b * RB;
              att::attn_unit<96>(Qm + m0 * 768 + h * 96, 768, Km + k0 * 768 + h * 96, 768, Vm + k0 * 512 + h * 64, 512, CAT + m0 * 1024 + 512 + h * 64, 1024, qb == 0 ? 4 : 132, (char*)lds_raw);
          } }
        SEAM(8);
    }
    if (CT(9) && IN(9)) { PH_LOCALS
        const bf16_t* Rb = (const bf16_t*)(ws + WS_B); const bf16_t* Kb = Rb + (size_t)T * 512; const bf16_t* Vb = Kb + (size_t)T * 512; const bf16_t* ZZ = (const bf16_t*)(ws + WS_C);
        const bf16_t* Yf = (const bf16_t*)(ws + WS_A + SZ512); const bf16_t* Yb = (const bf16_t*)(ws + WS_YB); bf16_t* CAT = (bf16_t*)(ws + WS_D);
        float lnw[8], lnb[8], rk[8], ka[8];
#pragma unroll
        for (int i = 0; i < 8; ++i) { lnw[i] = INP(I_LNW)[lane * 8 + i]; lnb[i] = INP(I_LNB)[lane * 8 + i]; rk[i] = INP(I_RK)[lane * 8 + i]; ka[i] = INP(I_KA)[lane * 8 + i]; }
        for (int m = gw; m < T; m += NGW) {
            const size_t o5 = (size_t)m * 512 + lane * 8, oz = (size_t)m * 2560 + lane * 8;
            const u32x4 yf = *(const u32x4*)(Yf + o5), yb = *(const u32x4*)(Yb + o5), rr = *(const u32x4*)(Rb + o5), kk = *(const u32x4*)(Kb + o5), vv = *(const u32x4*)(Vb + o5);
            const u32x4 af = *(const u32x4*)(ZZ + oz + 1024), ab = *(const u32x4*)(ZZ + oz + 1536), gg = *(const u32x4*)(ZZ + oz + 2048);
            float y[8], s = 0.f, bon = 0.f;
#pragma unroll
            for (int i = 0; i < 4; ++i) { y[2 * i] = lo2f(yf[i]) + lo2f(yb[i]); y[2 * i + 1] = hi2f(yf[i]) + hi2f(yb[i]); s += y[2 * i] + y[2 * i + 1];
                const float k0 = lo2f(kk[i]), k1 = hi2f(kk[i]), a0 = lo2f(af[i]) + lo2f(ab[i]) - 2.f, a1 = hi2f(af[i]) + hi2f(ab[i]) - 2.f;
                bon += lo2f(rr[i]) * (k0 * (2.f + a0 * ka[2 * i])) * rk[2 * i] + hi2f(rr[i]) * (k1 * (2.f + a1 * ka[2 * i + 1])) * rk[2 * i + 1]; }
            s += __shfl_xor(s, 1); s += __shfl_xor(s, 2); s += __shfl_xor(s, 4);
            bon += __shfl_xor(bon, 1); bon += __shfl_xor(bon, 2); bon += __shfl_xor(bon, 4);
            const float mean = s * (1.f / 64.f); float q = 0.f;
#pragma unroll
            for (int i = 0; i < 8; ++i) { y[i] -= mean; q += y[i] * y[i]; }
            q += __shfl_xor(q, 1); q += __shfl_xor(q, 2); q += __shfl_xor(q, 4);
            const float rstd = 1.f / sqrtf(q * (1.f / 64.f) + 64e-5f);
            float o[8];
#pragma unroll
            for (int i = 0; i < 4; ++i) { o[2 * i] = (y[2 * i] * rstd * lnw[2 * i] + lnb[2 * i] + bon * lo2f(vv[i])) * lo2f(gg[i]); o[2 * i + 1] = (y[2 * i + 1] * rstd * lnw[2 * i + 1] + lnb[2 * i + 1] + bon * hi2f(vv[i])) * hi2f(gg[i]); }
            u32x4 w; w.x = pk2(o[0], o[1]); w.y = pk2(o[2], o[3]); w.z = pk2(o[4], o[5]); w.w = pk2(o[6], o[7]);
            *(u32x4*)(CAT + (size_t)m * 1024 + lane * 8) = w;
        }
        SEAM(9);
    }
    if (CT(10) && IN(10)) { PH_LOCALS
        SchedRes S{66, 4, F.G, F.bid, (const char*)(ws + WS_D), (const char*)(WD + O_WOUT0 / 2), (size_t)256 * 1024 * 2, (size_t)256 * 1024 * 2, 0,
                   INP(I_X), INP(I_CTX), F.out, (float*)(ws + WS_XLC)};
        g8::EpiResGate E{MODS + 0 * 3 * 6144 + 2 * 1024, MIX_AMP};
        g8::gemm_phase(F.lds, 1024, S, E);
        SEAM(10);
    }

    moe_block<0>(args, F, bar, lo, hi);
        if (CT(16) && IN(16)) { PH_LOCALS
            SchedDense S{66, 6, F.G, F.bid, (const char*)(ws + WS_A), (const char*)(WD + O_WIN1 / 2), (char*)(ws + WS_C), (size_t)256 * 1024 * 2, (size_t)256 * 1024 * 2, (size_t)256 * 1536 * 2, 0};
            g8::EpiStoreBf16 E{1536, nullptr, 0};
            g8::gemm_phase(F.lds, 1024, S, E);
            SEAM(16);
        }
        if (CT(17) && IN(17)) { PH_LOCALS
            bf16_t* QKV = (bf16_t*)(ws + WS_C);
            const int hq = lane >> 2, sq = lane & 3, hk = lane >> 4, sk = lane & 15;
            float gq[16], gk[4];
#pragma unroll
            for (int i = 0; i < 16; ++i) gq[i] = INP(I_GGQ)[sq + 4 * i];
#pragma unroll
            for (int i = 0; i < 4; ++i) gk[i] = INP(I_GGK)[sk + 16 * i];
            float invq[4];
#pragma unroll
            for (int i = 0; i < 4; ++i) invq[i] = __powf(10000.f, -(float)(sq + 4 * i) * (1.f / 16.f));
            const float invk = __powf(10000.f, -(float)sk * (1.f / 16.f));
            for (int m = gw; m < T; m += NGW) { const int j = m % RB; const bool lat = j >= CTXL; bf16_t* row = QKV + (size_t)m * 1536;
                const int sp = j - CTXL; const float pr_ = (float)(sp >> 6), pc_ = (float)(sp & 63);
                { float k[4], ss = 0.f;
#pragma unroll
                  for (int i = 0; i < 4; ++i) { k[i] = bf2f(row[1024 + hk * 64 + sk + 16 * i]); ss += k[i] * k[i]; }
                  ss = rowsum16(ss); const float rs = 1.f / sqrtf(ss * (1.f / 64.f) + 1e-6f);
#pragma unroll
                  for (int i = 0; i < 4; ++i) k[i] = k[i] * rs * gk[i];
                  if (lat) { float cr, sr, cc, sc; sincosf(pr_ * invk, &sr, &cr); sincosf(pc_ * invk, &sc, &cc);
                      const float a = k[0], b2 = k[1]; k[0] = a * cr - b2 * sr; k[1] = b2 * cr + a * sr; const float c = k[2], d = k[3]; k[2] = c * cc - d * sc; k[3] = d * cc + c * sc; }
#pragma unroll
                  for (int i = 0; i < 4; ++i) row[1024 + hk * 64 + sk + 16 * i] = (bf16_t)(pk2(k[i], 0.f) & 0xffffu); }
                if (lat) { float q[16], ss = 0.f;
#pragma unroll
                  for (int i = 0; i < 16; ++i) { q[i] = bf2f(row[hq * 64 + sq + 4 * i]); ss += q[i] * q[i]; }
                  ss += __shfl_xor(ss, 1); ss += __shfl_xor(ss, 2); const float rs = 1.f / sqrtf(ss * (1.f / 64.f) + 1e-6f);
#pragma unroll
                  for (int i = 0; i < 16; ++i) q[i] = q[i] * rs * gq[i];
#pragma unroll
                  for (int i = 0; i < 4; ++i) { float cr, sr, cc, sc; sincosf(pr_ * invq[i], &sr, &cr); sincosf(pc_ * invq[i], &sc, &cc);
                      const float a = q[i], b2 = q[i + 4]; q[i] = a * cr - b2 * sr; q[i + 4] = b2 * cr + a * sr; const float c = q[i + 8], d = q[i + 12]; q[i + 8] = c * cc - d * sc; q[i + 12] = d * cc + c * sc; }
#pragma unroll
                  for (int i = 0; i < 16; ++i) row[hq * 64 + sq + 4 * i] = (bf16_t)(pk2(q[i] * C2_GQA, 0.f) & 0xffffu); }
            }
            SEAM(17);
        }
        if (CT(18) && IN(18)) { PH_LOCALS
            const bf16_t* QKV = (const bf16_t*)(ws + WS_C); bf16_t* O1 = (bf16_t*)(ws + WS_D);
            const int x = F.bid & 7, b = x >> 2, kvh = x & 3, per = F.G >> 3, i0 = F.bid >> 3;
            for (int uu = i0; uu < 128; uu += per) { const int hh = kvh * 4 + (uu >> 5), qb = 1 + (uu & 31);
                const size_t m0 = (size_t)b * RB + (size_t)qb * 256, k0 = (size_t)b * RB;
                __syncthreads();
                att::attn_unit<64>(QKV + m0 * 1536 + hh * 64, 1536, QKV + k0 * 1536 + 1024 + kvh * 64, 1536, QKV + k0 * 1536 + 1280 + kvh * 64, 1536, O1 + m0 * 1024 + hh * 64, 1024, 132, (char*)lds_raw); }
            SEAM(18);
        }
        if (CT(19) && IN(19)) { PH_LOCALS
            SchedRes S{64, 4, F.G, F.bid, (const char*)(ws + WS_D), (const char*)(WD + O_WOUT1 / 2), (size_t)256 * 1024 * 2, (size_t)256 * 1024 * 2, 1,
                       F.out, (const float*)(ws + WS_XLC), F.out, (float*)(ws + WS_XLC)};
            g8::EpiResGate E{MODS + 1 * 3 * 6144 + 2 * 1024, 1.0f};
            g8::gemm_phase(F.lds, 1024, S, E);
            SEAM(19);
        }
    moe_block<1>(args, F, bar, lo, hi);
#undef IN
#undef SEAM
}

extern "C" void kernel_launch(void* const* d_in, const int* in_sizes, int n_in, void* d_out, int out_size, void* d_ws, size_t ws_size, hipStream_t stream) {
    static int grid = 0;
    if (grid == 0) {
        if (n_in != 39 || out_size != 2 * SEQ * DM || ws_size < WS_NEED) { fprintf(stderr, "kernel_launch: unexpected shapes (n_in %d out %d ws %zu)\n", n_in, out_size, ws_size); grid = -1; return; }
        int dev = 0, cus = 0;
        if (hipGetDevice(&dev) != hipSuccess || hipDeviceGetAttribute(&cus, hipDeviceAttributeMultiprocessorCount, dev) != hipSuccess) { grid = -1; return; }
        if (hipFuncSetAttribute((const void*)fwd_kernel, hipFuncAttributeMaxDynamicSharedMemorySize, LDS_BYTES) != hipSuccess) { fprintf(stderr, "kernel_launch: hipFuncSetAttribute failed\n"); grid = -1; return; }
        int per_cu = 0;
        if (hipOccupancyMaxActiveBlocksPerMultiprocessor(&per_cu, (const void*)fwd_kernel, NTHR, LDS_BYTES) != hipSuccess || per_cu < 1) fprintf(stderr, "kernel_launch: occupancy query says %d\n", per_cu);
        (void)hipGetLastError();
        grid = cus;
    }
    if (grid < 0) return;
    if (hipMemsetAsync((char*)d_ws + WS_CTL, 0, CTL_BYTES, stream) != hipSuccess) return;
    Args a{};
    for (int i = 0; i < 39; ++i) a.in[i] = (const float*)d_in[i];
    a.out = (float*)d_out; a.ws = (unsigned char*)d_ws;
    if (N_LAUNCH_MODE == 1 && DUP_PH >= 0) { a.ph_lo = 0; a.ph_hi = DUP_PH + 1; a.li = 0; hipLaunchKernelGGL(fwd_kernel, dim3(grid), dim3(NTHR), LDS_BYTES, stream, a);
        a.ph_lo = DUP_PH; a.ph_hi = PH_END; a.li = 1; hipLaunchKernelGGL(fwd_kernel, dim3(grid), dim3(NTHR), LDS_BYTES, stream, a); }
    else if (N_LAUNCH_MODE == 1) { a.ph_lo = 0; a.ph_hi = PH_END; hipLaunchKernelGGL(fwd_kernel, dim3(grid), dim3(NTHR), LDS_BYTES, stream, a); }
    else for (int p = 0; p < PH_END; ++p) { a.ph_lo = p; a.ph_hi = p + 1; hipLaunchKernelGGL(fwd_kernel, dim3(grid), dim3(NTHR), LDS_BYTES, stream, a); }
}
```

```cpp
#include <hip/hip_runtime.h>
#include <hip/hip_bf16.h>
#include <cstdio>
#include <cstdint>

#define LAS __attribute__((address_space(3)))
#define GAS __attribute__((address_space(1)))
typedef unsigned short bf16_t;
typedef short bf16x8 __attribute__((ext_vector_type(8)));
typedef short s16x4 __attribute__((ext_vector_type(4)));
typedef float f32x4 __attribute__((ext_vector_type(4)));
typedef float f32x2 __attribute__((ext_vector_type(2)));
typedef float f32x16 __attribute__((ext_vector_type(16)));
typedef unsigned u32x4 __attribute__((ext_vector_type(4)));
typedef unsigned u32x2 __attribute__((ext_vector_type(2)));
typedef __bf16 bf16x2_t __attribute__((ext_vector_type(2)));

#ifndef PH_END
#define PH_END 25
#endif
#ifndef N_LAUNCH_MODE
#define N_LAUNCH_MODE 1
#endif
#ifndef ONLY_PH
#define ONLY_PH -1
#endif
#ifndef EXCL_PH
#define EXCL_PH -2
#endif
#ifndef ONLY_PH2
#define ONLY_PH2 -3
#endif
#define CT(id) ((ONLY_PH < 0 || ONLY_PH == (id) || ONLY_PH2 == (id)) && EXCL_PH != (id))
#ifndef DUP_PH
#define DUP_PH -1
#endif
#ifndef MIX_AMP
#define MIX_AMP 1.0f
#endif

constexpr int T = 16896, RB = 8448, CTXL = 256, SEQ = 8192, DM = 1024;
constexpr int NWAVES = 8, NTHR = 512;
constexpr int NE = 16, HS_TILES = 148, HS_ROWS = HS_TILES * 256;
constexpr float C2_MLA = 0.10206207261596575f * 1.4426950408889634f;
constexpr float C2_GQA = 0.125f * 1.4426950408889634f;

constexpr size_t MiB = 1u << 20;
constexpr size_t WS_CTL = 0, CTL_BYTES = 1 * MiB;
constexpr size_t WS_SMALL = 1 * MiB;
constexpr size_t SM_MODS = WS_SMALL;
constexpr size_t SM_BIASZ = WS_SMALL + 160 * 1024;
constexpr size_t SM_SEL = WS_SMALL + 192 * 1024;
constexpr size_t SM_WTS = WS_SMALL + 512 * 1024;
constexpr size_t SM_POS = WS_SMALL + 704 * 1024;
constexpr size_t SM_ROWWT = WS_SMALL + 1024 * 1024;
constexpr size_t WS_WD = 4 * MiB;
constexpr size_t O_WIN0 = 0, O_WOUT0 = 5767168, O_WLORA = 7864320, O_WQUP = 9830400, O_WKVUP = 10420224, O_WIN1 = 10944512, O_WOUT1 = 14090240, O_WD_END = 16187392;
static_assert(O_WD_END <= 17 * MiB, "dense weights");
constexpr size_t WS_XLC = 21 * MiB;
constexpr size_t WS_KROPE = 23 * MiB;
constexpr size_t WS_A = 26 * MiB;
constexpr size_t WS_B = 59 * MiB;
constexpr size_t WS_C = 113770496;
constexpr size_t WS_ACT = 183 * MiB;
constexpr size_t WS_D = 191 * MiB;
constexpr size_t WS_YB = 224 * MiB;
constexpr size_t WS_SEG = 241 * MiB;
static_assert(WS_SEG + 3 * 256 * 4096 * 4 <= 256 * MiB, "seg");
constexpr size_t SZ1024 = (size_t)T * 1024 * 2, SZ512 = (size_t)T * 512 * 2, SZ768 = (size_t)T * 768 * 2, SZ384 = (size_t)T * 384 * 2, SZ256 = (size_t)T * 256 * 2;
static_assert(WS_A + SZ1024 <= WS_B && WS_B + 3 * SZ512 <= WS_C && WS_C + (size_t)T * 2816 * 2 <= 200 * MiB, "map");
static_assert(WS_C + (size_t)HS_ROWS * 2048 <= WS_ACT && WS_ACT + (size_t)(HS_ROWS + T) * 512 <= 211 * MiB, "map2");
static_assert(WS_D + SZ768 + SZ1024 <= 256 * MiB && WS_YB + SZ512 <= 256 * MiB && WS_D + SZ1024 <= WS_YB, "map3");
constexpr size_t WS_NEED = 256 * MiB;
constexpr int CW_TMO = 0, CW_BAR = 4096  , CW_CNT = 16384  , CW_QUEUE = 20480;

__device__ __forceinline__ float bf2f(unsigned short h) { return __uint_as_float((unsigned)h << 16); }
__device__ __forceinline__ unsigned pk2(float lo, float hi) { f32x2 v = {lo, hi}; bf16x2_t b = __builtin_convertvector(v, bf16x2_t); return __builtin_bit_cast(unsigned, b); }
__device__ __forceinline__ float lo2f(unsigned w) { return __uint_as_float(w << 16); }
__device__ __forceinline__ float hi2f(unsigned w) { return __uint_as_float(w & 0xffff0000u); }
__device__ __forceinline__ float sigmoidf_(float x) { return __builtin_amdgcn_rcpf(1.f + __expf(-x)); }
__device__ __forceinline__ float wave_sum(float v) {
#pragma unroll
    for (int o = 1; o < 64; o <<= 1) v += __shfl_xor(v, o);
    return v;
}
#define DPP_ROR_ADD(x, ctrl) x += __int_as_float(__builtin_amdgcn_update_dpp(0, __float_as_int(x), ctrl, 0xF, 0xF, false))
__device__ __forceinline__ float rowsum16(float x) {
    DPP_ROR_ADD(x, 0x128); DPP_ROR_ADD(x, 0x124); DPP_ROR_ADD(x, 0x122); DPP_ROR_ADD(x, 0x121); return x;
}
#define LDS_WAIT() asm volatile("s_waitcnt lgkmcnt(0)" ::: "memory")
#define VM_WAIT() asm volatile("s_waitcnt vmcnt(0)" ::: "memory")

namespace g8 {
constexpr int BM = 256, BK = 64, HALF = 128, HTB = HALF * BK * 2, STAGE_BYTES = 8 * HTB, NXCD = 8, WGM = 8;
__host__ __device__ __forceinline__ int lds_byte(int r, int c) { const int st = (r >> 4) * 2 + (c >> 5), rr = r & 15, cc = c & 31, ob = rr * 64 + cc * 2; return st * 1024 + (ob ^ (((ob >> 9) & 1) << 5)); }
__host__ __device__ __forceinline__ void stage_rc(int b, int& R, int& C) { const int st = b / 1024, sb = b % 1024, swz = sb ^ (((sb >> 9) & 1) << 5); R = (st >> 1) * 16 + swz / 64; C = (st & 1) * 32 + (swz % 64) / 2; }
__host__ __device__ __forceinline__ int perm32(int rho) { const int n = rho >> 4, i = rho & 15; return 8 * (i >> 2) + 4 * n + (i & 3); }

struct Unit { const char* a; const char* b; char* o; const float* f0; int pn; int aux; };

__device__ __forceinline__ bool tile_order(int i, int G, int c, int nM, int nN, int& pm, int& pn) {
    const int nwg = nM * nN; const long L = (long)i * G + c; if (L >= nwg) return false;
    int wgid = (int)L; { const int q = nwg / NXCD, r = nwg % NXCD, xcd = wgid % NXCD, off = wgid / NXCD; wgid = (xcd < r ? xcd * (q + 1) : r * (q + 1) + (xcd - r) * q) + off; }
    const int nig = WGM * nN, gid = wgid / nig, fm = gid * WGM, gsz = (nM - fm) < WGM ? (nM - fm) : WGM;
    pm = fm + ((wgid % nig) % gsz); pn = (wgid % nig) / gsz; return true;
}

struct EpiStoreBf16 {
    static constexpr bool PERM = true;
    int ldc; const float* bias; int sig_cols;
    __device__ __forceinline__ void operator()(const f32x4 (&acc)[2][2][4][2], const Unit& u, int wr, int wc, int fr, int fq) const {
        bf16_t* base = (bf16_t*)u.o; const int col0 = u.pn * BM + wc * 32 + 8 * fq;
        const bool sig = (u.pn * BM) < sig_cols;
        f32x4 bv[2][2];
#pragma unroll
        for (int bj = 0; bj < 2; ++bj)
#pragma unroll
            for (int n = 0; n < 2; ++n) bv[bj][n] = bias ? *(const f32x4*)(bias + col0 + bj * HALF + 4 * n) : (f32x4){0.f, 0.f, 0.f, 0.f};
#pragma unroll
        for (int ai = 0; ai < 2; ++ai)
#pragma unroll
            for (int m = 0; m < 4; ++m) { bf16_t* rowp = base + (size_t)(ai * HALF + wr * 64 + m * 16 + fr) * ldc + col0;
#pragma unroll
                for (int bj = 0; bj < 2; ++bj) { f32x4 v0 = acc[ai][bj][m][0] + bv[bj][0], v1 = acc[ai][bj][m][1] + bv[bj][1];
                    if (sig) {
#pragma unroll
                        for (int j = 0; j < 4; ++j) { v0[j] = sigmoidf_(v0[j]); v1[j] = sigmoidf_(v1[j]); } }
                    u32x4 w; w.x = pk2(v0[0], v0[1]); w.y = pk2(v0[2], v0[3]); w.z = pk2(v1[0], v1[1]); w.w = pk2(v1[2], v1[3]);
                    *(u32x4*)(rowp + bj * HALF) = w; } }
    }
};
struct EpiResGate {
    static constexpr bool PERM = false;
    const float* gate0; float amp;
    __device__ __forceinline__ void operator()(const f32x4 (&acc)[2][2][4][2], const Unit& u, int wr, int wc, int fr, int fq) const {
        const float* base = u.f0; float* out = (float*)u.o; const float* gate = gate0 + u.aux * 6144;
        const int col0 = u.pn * BM + wc * 32 + 4 * fq;
        f32x4 gv[2][2];
#pragma unroll
        for (int bj = 0; bj < 2; ++bj)
#pragma unroll
            for (int n = 0; n < 2; ++n) gv[bj][n] = *(const f32x4*)(gate + col0 + bj * HALF + n * 16) * amp;
#pragma unroll
        for (int ai = 0; ai < 2; ++ai)
#pragma unroll
            for (int m = 0; m < 4; ++m) { const size_t off = (size_t)(ai * HALF + wr * 64 + m * 16 + fr) * DM + col0;
#pragma unroll
                for (int bj = 0; bj < 2; ++bj)
#pragma unroll
                    for (int n = 0; n < 2; ++n) { const f32x4 bs = *(const f32x4*)(base + off + bj * HALF + n * 16);
                        *(f32x4*)(out + off + bj * HALF + n * 16) = bs + gv[bj][n] * acc[ai][bj][m][n]; }
                asm volatile("" ::: "memory"); }
    }
};
struct EpiSwiGLU {
    static constexpr bool PERM = true;
    __device__ __forceinline__ void operator()(const f32x4 (&acc)[2][2][4][2], const Unit& u, int wr, int wc, int fr, int fq) const {
        bf16_t* act = (bf16_t*)u.o; const float* rw = u.f0; const int f0 = u.pn * 128 + wc * 32 + 8 * fq;
#pragma unroll
        for (int ai = 0; ai < 2; ++ai)
#pragma unroll
            for (int m = 0; m < 4; ++m) { const int r = ai * HALF + wr * 64 + m * 16 + fr; const float wt = rw ? rw[r] : 1.f;
                float o[8];
#pragma unroll
                for (int n = 0; n < 2; ++n)
#pragma unroll
                    for (int j = 0; j < 4; ++j) { const float g = acc[ai][0][m][n][j], up = acc[ai][1][m][n][j]; o[n * 4 + j] = g * sigmoidf_(g) * up * wt; }
                u32x4 w; w.x = pk2(o[0], o[1]); w.y = pk2(o[2], o[3]); w.z = pk2(o[4], o[5]); w.w = pk2(o[6], o[7]);
                *(u32x4*)(act + (size_t)r * 256 + f0) = w; asm volatile("" ::: "memory"); }
    }
};

template <class Epi, class Sched>
__device__ __forceinline__ void gemm_phase(LAS unsigned char* lds, const int K, const Sched& S, const Epi& E) {
    int tid_ = threadIdx.x; asm volatile("" : "+v"(tid_));
    const int tid = tid_, wid = __builtin_amdgcn_readfirstlane(tid >> 6), lane = tid & 63, wr = wid >> 2, wc = wid & 3, fr = lane & 15, fq = lane >> 4;
    const int nt = K / BK;
    unsigned voffA[2], voffB[2];
#pragma unroll
    for (int i = 0; i < 2; ++i) { int R, C; stage_rc(tid * 16 + i * 8192, R, C); const int Rb = Epi::PERM ? ((R & ~31) + perm32(R & 31)) : R;
        voffA[i] = (unsigned)(R * K + C) * 2u; voffB[i] = (unsigned)(Rb * K + C) * 2u; }
    const size_t kstep = (size_t)(BK * 2);
    const size_t hstep = (size_t)HALF * K * 2;
    const unsigned ldsw = (unsigned)wid * 1024u;
    const int aoff = lds_byte(wr * 64 + fr, fq * 8), boff = lds_byte(wc * 32 + fr, fq * 8);
#define PG8_SA(b, h) (((b) * 2 + (h)) * HTB)
#define PG8_SB(b, h) ((4 + (b) * 2 + (h)) * HTB)
#define PG8_STAGE(bufoff, gbase, voff) do { _Pragma("unroll") for (int _i = 0; _i < 2; ++_i) \
        __builtin_amdgcn_global_load_lds((const unsigned*)((const char*)(gbase) + (voff)[_i]), (LAS unsigned*)(lds + (bufoff) + ldsw + _i * 8192), 16, 0, 0); } while (0)
#define PG8_LDA(dst, b, h) do { _Pragma("unroll") for (int m = 0; m < 4; ++m) _Pragma("unroll") for (int k = 0; k < 2; ++k) dst[m][k] = *(const LAS bf16x8*)(lds + PG8_SA(b, h) + aoff + m * 2048 + k * 1024); } while (0)
#define PG8_LDB(dst, b, h) do { _Pragma("unroll") for (int n = 0; n < 2; ++n) _Pragma("unroll") for (int k = 0; k < 2; ++k) dst[n][k] = *(const LAS bf16x8*)(lds + PG8_SB(b, h) + boff + n * 2048 + k * 1024); } while (0)
#define PG8_MMA(ai, bj, At, Bt) do { __builtin_amdgcn_s_setprio(1); _Pragma("unroll") for (int m = 0; m < 4; ++m) _Pragma("unroll") for (int n = 0; n < 2; ++n) _Pragma("unroll") for (int k = 0; k < 2; ++k) \
        acc[ai][bj][m][n] = __builtin_amdgcn_mfma_f32_16x16x32_bf16(Bt[n][k], At[m][k], acc[ai][bj][m][n], 0, 0, 0); __builtin_amdgcn_s_setprio(0); } while (0)
#define PG8_WAIT_V(n) asm volatile("s_waitcnt vmcnt(" #n ")" ::: "memory")
#define PG8_WAIT_L(n) asm volatile("s_waitcnt lgkmcnt(" #n ")" ::: "memory")
#define PG8_BAR __builtin_amdgcn_s_barrier()
#define PG8_SCHED __builtin_amdgcn_sched_barrier(0)
    Unit cur, nxt; int ui = 0;
    if (!S.next(0, cur)) return;
    f32x4 acc[2][2][4][2];
#pragma unroll
    for (int a = 0; a < 2; ++a)
#pragma unroll
        for (int b = 0; b < 2; ++b)
#pragma unroll
            for (int m = 0; m < 4; ++m)
#pragma unroll
                for (int n = 0; n < 2; ++n) acc[a][b][m][n] = (f32x4){0.f, 0.f, 0.f, 0.f};
    bf16x8 At[4][2], B0[2][2], B1[2][2];
    const char* cA = cur.a; const char* cB = cur.b;
    PG8_STAGE(PG8_SB(0, 0), cB, voffB); PG8_STAGE(PG8_SB(0, 1), cB + hstep, voffB); PG8_STAGE(PG8_SA(0, 0), cA, voffA); PG8_STAGE(PG8_SA(0, 1), cA + hstep, voffA);
    if (wr == 1) PG8_BAR;
    PG8_WAIT_V(2); PG8_BAR;
    PG8_STAGE(PG8_SB(1, 0), cB + kstep, voffB); PG8_STAGE(PG8_SA(1, 0), cA + kstep, voffA); PG8_STAGE(PG8_SB(1, 1), cB + hstep + kstep, voffB);
    PG8_WAIT_V(6); PG8_BAR;
    for (;;) {
        const bool has_next = S.next(ui + 1, nxt);
        const char* nA = has_next ? nxt.a : cA; const char* nB = has_next ? nxt.b : cB;
#pragma unroll 1
        for (int t = 0; t < nt; t += 2) {
            const bool last = (t == nt - 2);
            const char* a1 = cA + (size_t)(t + 1) * kstep;
            const char* a2 = last ? nA : cA + (size_t)(t + 2) * kstep; const char* b2 = last ? nB : cB + (size_t)(t + 2) * kstep;
            const char* a3 = a2 + kstep; const char* b3 = b2 + kstep;
            PG8_LDB(B0, 0, 0); PG8_LDB(B1, 0, 1); PG8_SCHED; PG8_LDA(At, 0, 0); PG8_STAGE(PG8_SA(1, 1), a1 + hstep, voffA);
            PG8_WAIT_V(8); PG8_WAIT_L(0); PG8_BAR; PG8_MMA(0, 0, At, B0); PG8_MMA(0, 1, At, B1); PG8_BAR; PG8_SCHED;
            PG8_LDA(At, 0, 1); PG8_STAGE(PG8_SB(0, 0), b2, voffB); PG8_STAGE(PG8_SB(0, 1), b2 + hstep, voffB); PG8_STAGE(PG8_SA(0, 0), a2, voffA);
            PG8_WAIT_V(8); PG8_WAIT_L(0); PG8_BAR; PG8_MMA(1, 0, At, B0); PG8_MMA(1, 1, At, B1); PG8_BAR; PG8_SCHED;
            PG8_LDB(B0, 1, 0); PG8_LDB(B1, 1, 1); PG8_SCHED; PG8_LDA(At, 1, 0); PG8_STAGE(PG8_SA(0, 1), a2 + hstep, voffA);
            PG8_WAIT_V(8); PG8_WAIT_L(0); PG8_BAR; PG8_MMA(0, 0, At, B0); PG8_MMA(0, 1, At, B1); PG8_BAR; PG8_SCHED;
            PG8_LDA(At, 1, 1); PG8_STAGE(PG8_SB(1, 0), b3, voffB); PG8_STAGE(PG8_SB(1, 1), b3 + hstep, voffB); PG8_STAGE(PG8_SA(1, 0), a3, voffA);
            PG8_WAIT_V(8); PG8_WAIT_L(0); PG8_BAR; PG8_MMA(1, 0, At, B0); PG8_MMA(1, 1, At, B1); PG8_BAR; PG8_SCHED;
        }
        if (wr == 0) PG8_BAR;
        E(acc, cur, wr, wc, fr, fq);
        if (!has_next) break;
#pragma unroll
        for (int a = 0; a < 2; ++a)
#pragma unroll
            for (int b = 0; b < 2; ++b)
#pragma unroll
                for (int m = 0; m < 4; ++m)
#pragma unroll
                    for (int n = 0; n < 2; ++n) acc[a][b][m][n] = (f32x4){0.f, 0.f, 0.f, 0.f};
        cur = nxt; cA = nA; cB = nB; ++ui;
        if (wr == 1) PG8_BAR;
    }
    PG8_WAIT_V(0);
    PG8_BAR;
#undef PG8_SA
#undef PG8_SB
#undef PG8_STAGE
#undef PG8_LDA
#undef PG8_LDB
#undef PG8_MMA
#undef PG8_WAIT_V
#undef PG8_WAIT_L
#undef PG8_BAR
#undef PG8_SCHED
}
}

namespace att {
#define SBAR() __builtin_amdgcn_sched_barrier(0)
__device__ __forceinline__ int crow(int r, int hi) { return (r & 3) + 8 * (r >> 2) + 4 * hi; }
constexpr float THR = 8.f;
__device__ __forceinline__ void partialSM(f32x16& p0, f32x16& p1, float& m_reg, float& alpha) {
    float pmax = p0[0];
#pragma unroll
    for (int r = 1; r < 16; ++r) pmax = fmaxf(pmax, p0[r]);
#pragma unroll
    for (int r = 0; r < 16; ++r) pmax = fmaxf(pmax, p1[r]);
    { auto rr = __builtin_amdgcn_permlane32_swap(__float_as_uint(pmax), __float_as_uint(pmax), false, false);
      pmax = fmaxf(__uint_as_float(rr[0]), __uint_as_float(rr[1])); }
    float mn;
    if (__builtin_expect(__all(pmax - m_reg <= THR), 1)) { mn = m_reg; alpha = 1.f; }
    else { mn = fmaxf(m_reg, pmax); alpha = __builtin_amdgcn_exp2f(m_reg - mn); m_reg = mn; }
#pragma unroll
    for (int r = 0; r < 16; ++r) p0[r] = p0[r] - mn;
#pragma unroll
    for (int r = 0; r < 16; ++r) p1[r] = p1[r] - mn;
#pragma unroll
    for (int r = 0; r < 16; ++r) p0[r] = __builtin_amdgcn_exp2f(p0[r]);
}
__device__ __forceinline__ void finishSM(f32x16& p0, f32x16& p1, float alpha, float& l_reg, bf16x8& pa0, bf16x8& pa1, bf16x8& pa2, bf16x8& pa3) {
#pragma unroll
    for (int r = 0; r < 16; ++r) p1[r] = __builtin_amdgcn_exp2f(p1[r]);
    float ps = 0;
#pragma unroll
    for (int r = 0; r < 16; ++r) ps += p0[r];
#pragma unroll
    for (int r = 0; r < 16; ++r) ps += p1[r];
    { auto rr = __builtin_amdgcn_permlane32_swap(__float_as_uint(ps), __float_as_uint(ps), false, false);
      ps = __uint_as_float(rr[0]) + __uint_as_float(rr[1]); }
    l_reg = l_reg * alpha + ps;
#define PK4(P, BASE, OUT) do { unsigned a0 = pk2(P[BASE + 0], P[BASE + 1]), a1 = pk2(P[BASE + 2], P[BASE + 3]);   \
    unsigned b0 = pk2(P[BASE + 4], P[BASE + 5]), b1 = pk2(P[BASE + 6], P[BASE + 7]);                              \
    auto r0 = __builtin_amdgcn_permlane32_swap(a0, b0, false, false); auto r1 = __builtin_amdgcn_permlane32_swap(a1, b1, false, false); \
    u32x4 w = {r0[0], r1[0], r0[1], r1[1]}; OUT = __builtin_bit_cast(bf16x8, w); } while (0)
    PK4(p0, 0, pa0); PK4(p0, 8, pa1); PK4(p1, 0, pa2); PK4(p1, 8, pa3);
#undef PK4
}
template <int DQK>
__device__ __forceinline__ void qkt(f32x16& p0, f32x16& p1, const char* Ks, const bf16x8* qr, int r32, int hi) {
    p0 = f32x16{}; p1 = f32x16{};
    const char* kb = Ks + hi * 1024 + r32 * 16;
#pragma unroll
    for (int d0 = 0; d0 < DQK / 16; ++d0) {
        bf16x8 b0 = *reinterpret_cast<const bf16x8*>(kb + d0 * 2048);
        bf16x8 b1 = *reinterpret_cast<const bf16x8*>(kb + d0 * 2048 + 512);
        p0 = __builtin_amdgcn_mfma_f32_32x32x16_bf16(b0, qr[d0], p0, 0, 0, 0);
        p1 = __builtin_amdgcn_mfma_f32_32x32x16_bf16(b1, qr[d0], p1, 0, 0, 0); }
}
__device__ __forceinline__ int v_st(int k, int c) { const int kk = (k & ~0xC) | ((k & 4) << 1) | ((k & 8) >> 1); return ((kk >> 3) * 2 + (c >> 5)) * 512 + ((kk & 7) * 32 + (c & 31)) * 2; }
__device__ __forceinline__ int v_rd_base(int lane) { return ((lane & 3) << 3) | (((lane >> 2) & 3) << 6) | (((lane >> 4) & 1) << 5) | (((lane >> 5) & 1) << 8); }
constexpr int v_rd_off(int d0, int ks, int half) { return d0 * 512 + ks * 2048 + half * 1024; }
template <int OFF> __device__ __forceinline__ s16x4 tr_read(int vb) {
    s16x4 r; asm volatile("ds_read_b64_tr_b16 %0, %1 offset:%2" : "=&v"(r) : "v"(vb), "i"(OFF) : "memory"); return r;
}
template <int D0> __device__ __forceinline__ void pv_one(f32x16& od, int vb, bf16x8 pa0, bf16x8 pa1, bf16x8 pa2, bf16x8 pa3) {
    const s16x4 l0 = tr_read<v_rd_off(D0, 0, 0)>(vb), h0 = tr_read<v_rd_off(D0, 0, 1)>(vb), l1 = tr_read<v_rd_off(D0, 1, 0)>(vb), h1 = tr_read<v_rd_off(D0, 1, 1)>(vb);
    const s16x4 l2 = tr_read<v_rd_off(D0, 2, 0)>(vb), h2 = tr_read<v_rd_off(D0, 2, 1)>(vb), l3 = tr_read<v_rd_off(D0, 3, 0)>(vb), h3 = tr_read<v_rd_off(D0, 3, 1)>(vb);
    asm volatile("s_waitcnt lgkmcnt(0)" ::: "memory"); SBAR();
#define PK(L, H) (bf16x8){L[0], L[1], L[2], L[3], H[0], H[1], H[2], H[3]}
    od = __builtin_amdgcn_mfma_f32_32x32x16_bf16(pa0, PK(l0, h0), od, 0, 0, 0);
    od = __builtin_amdgcn_mfma_f32_32x32x16_bf16(pa1, PK(l1, h1), od, 0, 0, 0);
    od = __builtin_amdgcn_mfma_f32_32x32x16_bf16(pa2, PK(l2, h2), od, 0, 0, 0);
    od = __builtin_amdgcn_mfma_f32_32x32x16_bf16(pa3, PK(l3, h3), od, 0, 0, 0);
#undef PK
}
__device__ __forceinline__ void pv_all(f32x16* o, int vb, bf16x8 pa0, bf16x8 pa1, bf16x8 pa2, bf16x8 pa3) {
    pv_one<0>(o[0], vb, pa0, pa1, pa2, pa3); pv_one<1>(o[1], vb, pa0, pa1, pa2, pa3);
}
template <int DQK> struct Lay { static constexpr int NCH = DQK / 8, SHM_K = 64 * DQK * 2, SHM_V = 8192, OFF_V = 0, OFF_K = 2 * SHM_V, OFF_WS = OFF_K + 2 * SHM_K, OFF_OST = OFF_WS + NWAVES * 256, BYTES = OFF_OST + NWAVES * 4096; };
template <int DQK>
__device__ __forceinline__ void attn_unit(const bf16_t* __restrict__ Qb, int ldq, const bf16_t* __restrict__ Kh, int ldk, const bf16_t* __restrict__ Vh, int ldv,
                                          bf16_t* __restrict__ Ob, int ldo, int NT, char* lds) {
    using L = Lay<DQK>; constexpr int NCH = L::NCH, ND0 = DQK / 16;
    int tid_ = threadIdx.x; asm volatile("" : "+v"(tid_));
    const int tid = tid_, wid = tid >> 6, lane = tid & 63, r32 = lane & 31, hi = lane >> 5;
    char* V_lds = lds + L::OFF_V; char* K_lds = lds + L::OFF_K;
    float* ws = (float*)(lds + L::OFF_WS) + wid * 64; float* li_l = ws; float* al_l = ws + 32;
    float m_reg = -1e30f, l_reg = 0; f32x16 o[2] = {}; bf16x8 qr[ND0];
    const bf16_t* Qw = Qb + (size_t)(wid * 32 + r32) * ldq + hi * 8;
#pragma unroll
    for (int d0 = 0; d0 < ND0; ++d0) qr[d0] = *reinterpret_cast<const bf16x8*>(Qw + d0 * 16);
    const int vrow = tid >> 3, vcol = (tid & 7) * 8, vst = v_st(vrow, vcol);
    const int kp0 = tid, kr0 = kp0 / NCH, kc0 = kp0 % NCH, kst0 = kc0 * 1024 + kr0 * 16;
    const int kp1 = 512 + (tid & 255), kr1 = kp1 / NCH, kc1 = kp1 % NCH, kst1 = kc1 * 1024 + kr1 * 16;
    const int vb0 = (int)(uintptr_t)V_lds + v_rd_base(lane);
    struct { bf16x8 v, k0, k1; } sr_[2];
#define SLOAD(i, key0) do { sr_[i].v = *reinterpret_cast<const bf16x8*>(Vh + (size_t)((key0) + vrow) * ldv + vcol); \
    sr_[i].k0 = *reinterpret_cast<const bf16x8*>(Kh + (size_t)((key0) + kr0) * ldk + kc0 * 8); \
    if (NCH > 8) sr_[i].k1 = *reinterpret_cast<const bf16x8*>(Kh + (size_t)((key0) + kr1) * ldk + kc1 * 8); } while (0)
#define SWRITE(b, i) do { *(bf16x8*)(V_lds + (b) * L::SHM_V + vst) = sr_[i].v; *(bf16x8*)(K_lds + (b) * L::SHM_K + kst0) = sr_[i].k0; \
    if (NCH > 8) { if (tid < 256) *(bf16x8*)(K_lds + (b) * L::SHM_K + kst1) = sr_[i].k1; } } while (0)
#define SWAIT() do { if (NCH > 8) asm volatile("s_waitcnt vmcnt(3)" ::: "memory"); else asm volatile("s_waitcnt vmcnt(2)" ::: "memory"); } while (0)
#define RESC(a) do { if (__any((a) < 1.f)) { if (hi == 0) al_l[r32] = (a); asm volatile("s_waitcnt lgkmcnt(0)" ::: "memory"); \
    _Pragma("unroll") for (int d = 0; d < 2; ++d) _Pragma("unroll") for (int r = 0; r < 16; ++r) o[d][r] *= al_l[crow(r, hi)]; } } while (0)
    f32x16 pA0, pA1, pB0, pB1; float alA, alB; bf16x8 pa0, pa1, pa2, pa3;
    constexpr int SE = 0, SO = 1;
    SLOAD(SE, 0); asm volatile("s_waitcnt vmcnt(0)" ::: "memory"); SWRITE(0, SE); __syncthreads();
    qkt<DQK>(pA0, pA1, K_lds, qr, r32, hi); partialSM(pA0, pA1, m_reg, alA);
    SLOAD(SO, 64); if (2 < NT) SLOAD(SE, 128);
    SWAIT(); SWRITE(1, SO); __syncthreads();
    for (int j = 1; j + 1 < NT; j += 2) {
        SBAR(); qkt<DQK>(pB0, pB1, K_lds + L::SHM_K, qr, r32, hi);
        finishSM(pA0, pA1, alA, l_reg, pa0, pa1, pa2, pa3); SBAR();
        SLOAD(SO, (j + 2) * 64); SBAR();
        pv_all(o, vb0, pa0, pa1, pa2, pa3); partialSM(pB0, pB1, m_reg, alB);
        __syncthreads(); SWAIT(); SWRITE(0, SE);
        RESC(alB); __syncthreads();
        SBAR(); qkt<DQK>(pA0, pA1, K_lds, qr, r32, hi);
        finishSM(pB0, pB1, alB, l_reg, pa0, pa1, pa2, pa3); SBAR();
        if (j + 3 < NT) SLOAD(SE, (j + 3) * 64); SBAR();
        pv_all(o, vb0 + L::SHM_V, pa0, pa1, pa2, pa3); partialSM(pA0, pA1, m_reg, alA);
        __syncthreads(); SWAIT(); SWRITE(1, SO);
        RESC(alA); __syncthreads();
    }
    SBAR(); qkt<DQK>(pB0, pB1, K_lds + L::SHM_K, qr, r32, hi);
    finishSM(pA0, pA1, alA, l_reg, pa0, pa1, pa2, pa3); SBAR();
    pv_all(o, vb0, pa0, pa1, pa2, pa3); partialSM(pB0, pB1, m_reg, alB);
    __syncthreads(); RESC(alB);
    finishSM(pB0, pB1, alB, l_reg, pa0, pa1, pa2, pa3); SBAR();
    pv_all(o, vb0 + L::SHM_V, pa0, pa1, pa2, pa3);
    if (hi == 0) li_l[r32] = l_reg; asm volatile("s_waitcnt lgkmcnt(0)" ::: "memory");
    float rli[16];
#pragma unroll
    for (int r = 0; r < 16; ++r) rli[r] = __builtin_amdgcn_rcpf(li_l[crow(r, hi)]);
    bf16_t* Ow = Ob + (size_t)(wid * 32) * ldo;
    { bf16_t* stg = (bf16_t*)(lds + L::OFF_OST) + wid * 2048;
#pragma unroll
      for (int r = 0; r < 16; ++r) { const int orow = crow(r, hi);
#pragma unroll
        for (int d0 = 0; d0 < 2; ++d0) stg[orow * 64 + d0 * 32 + r32] = (bf16_t)(pk2(o[d0][r] * rli[r], 0.f) & 0xffffu); }
      asm volatile("s_waitcnt lgkmcnt(0)" ::: "memory");
#pragma unroll
      for (int i = 0; i < 4; ++i) { const int row = i * 8 + (lane >> 3), ch = lane & 7; const u32x4 v = *(const u32x4*)(stg + row * 64 + ch * 8); *(u32x4*)(Ow + (size_t)row * ldo + ch * 8) = v; } }
    asm volatile("s_waitcnt lgkmcnt(0)" ::: "memory");
#undef SLOAD
#undef SWRITE
#undef SWAIT
#undef RESC
}
#undef SBAR
}

namespace at64 {
using bf16=__hip_bfloat16;
constexpr int D=64;
constexpr int NW=8,QBLK=32,QB=QBLK*NW,KVBLK=64;
__device__ __forceinline__ int crow(int r,int hi){return (r&3)+8*(r>>2)+4*hi;}
#define SBAR() __builtin_amdgcn_sched_barrier(0)
__device__ __forceinline__ void cmask(f32x16&p0,f32x16&p1,int jb,int qrel,int hi){
  const float NEG=-INFINITY; int kb=64*jb+4*hi;
  #pragma unroll
  for(int r=0;r<16;++r){int kv=kb+(r&3)+8*(r>>2); if(kv>qrel)p0[r]=NEG; if(kv+32>qrel)p1[r]=NEG;}
}

constexpr int NSLOT=3, SLOTB=8192;
constexpr int LDS_K=0, LDS_V=NSLOT*SLOTB, LDS_WS=2*NSLOT*SLOTB, LDS_OST=LDS_WS+NW*64*4, LDS_BYTES=LDS_OST+NW*4096;
constexpr float C2=0.125f*1.4426950408889634f;
__device__ __forceinline__ void glds16(const void*gsrc,unsigned lds_dst){unsigned keep;
  asm volatile("s_mov_b32 %0, m0\n\ts_mov_b32 m0, %2\n\ts_nop 0\n\tglobal_load_lds_dwordx4 %1, off\n\ts_mov_b32 m0, %0":"=&s"(keep):"v"(gsrc),"s"(lds_dst):"memory");}
__device__ __forceinline__ float max3f(float a,float b,float c){float r;asm("v_max3_f32 %0, %1, %2, %3":"=v"(r):"v"(a),"v"(b),"v"(c));return r;}
__device__ __forceinline__ float max2f(float a,float b){float r;asm("v_max_f32_e32 %0, %1, %2":"=v"(r):"v"(a),"v"(b));return r;}
__device__ __forceinline__ float fadd_s(float a,float b){float r;asm("v_add_f32_e32 %0, %1, %2":"=v"(r):"v"(a),"v"(b));return r;}
__device__ __forceinline__ float fsub_s(float a,float b){float r;asm("v_sub_f32_e32 %0, %1, %2":"=v"(r):"v"(a),"v"(b));return r;}
typedef float f32x2_t __attribute__((ext_vector_type(2))); typedef __bf16 bf16x2_t __attribute__((ext_vector_type(2)));
__device__ __forceinline__ unsigned cvtpk_s(float lo,float hi){f32x2_t v={lo,hi};bf16x2_t b=__builtin_convertvector(v,bf16x2_t);return __builtin_bit_cast(unsigned,b);}
#define WAIT_BAR(N) asm volatile("s_waitcnt vmcnt(" #N ") lgkmcnt(0)\n\ts_barrier":::"memory")

__device__ __forceinline__ void qkt(f32x16&p0,f32x16&p1,const char*Kslot,const bf16x8*qr,const f32x16&negm,int r32,int hi){
  const char*kb=Kslot+hi*1024+r32*16;
  #pragma unroll
  for(int d0=0;d0<4;++d0){
    const bf16x8 b0=*reinterpret_cast<const bf16x8*>(kb+d0*2048);
    const bf16x8 b1=*reinterpret_cast<const bf16x8*>(kb+d0*2048+512);
    if(d0==0){p0=__builtin_amdgcn_mfma_f32_32x32x16_bf16(b0,qr[0],negm,0,0,0);p1=__builtin_amdgcn_mfma_f32_32x32x16_bf16(b1,qr[0],negm,0,0,0);}
    else{p0=__builtin_amdgcn_mfma_f32_32x32x16_bf16(b0,qr[d0],p0,0,0,0);p1=__builtin_amdgcn_mfma_f32_32x32x16_bf16(b1,qr[d0],p1,0,0,0);}}
}
typedef __attribute__((address_space(3))) const char* lds_cptr;
typedef short v4i16_t __attribute__((ext_vector_type(4)));
__device__ __forceinline__ void kload8(bf16x8*kf,lds_cptr kp){
  kf[0]=*(const __attribute__((address_space(3))) bf16x8*)(kp);      kf[1]=*(const __attribute__((address_space(3))) bf16x8*)(kp+512);
  kf[2]=*(const __attribute__((address_space(3))) bf16x8*)(kp+2048); kf[3]=*(const __attribute__((address_space(3))) bf16x8*)(kp+2560);
  kf[4]=*(const __attribute__((address_space(3))) bf16x8*)(kp+4096); kf[5]=*(const __attribute__((address_space(3))) bf16x8*)(kp+4608);
  kf[6]=*(const __attribute__((address_space(3))) bf16x8*)(kp+6144); kf[7]=*(const __attribute__((address_space(3))) bf16x8*)(kp+6656);
}
__device__ __forceinline__ void kload2(bf16x8*kf,lds_cptr kp,int j){ kf[2*j]=*(const __attribute__((address_space(3))) bf16x8*)(kp+j*2048); kf[2*j+1]=*(const __attribute__((address_space(3))) bf16x8*)(kp+j*2048+512); }
__device__ __forceinline__ s16x4 vtr(lds_cptr p){ return __builtin_bit_cast(s16x4,__builtin_amdgcn_ds_read_tr16_b64_v4i16((__attribute__((address_space(3))) v4i16_t*)p)); }
__device__ __forceinline__ float rowmax(const f32x16&p0,const f32x16&p1){
  float a=max3f(p0[0],p0[1],p1[0]),b=max3f(p0[2],p0[3],p1[1]);a=max3f(a,p1[2],p1[3]);
  #pragma unroll
  for(int r=4;r<16;r+=4){a=max3f(a,p0[r],p0[r+1]);b=max3f(b,p0[r+2],p0[r+3]);a=max3f(a,p1[r],p1[r+1]);b=max3f(b,p1[r+2],p1[r+3]);}
  const float m=max2f(a,b);
  auto rr=__builtin_amdgcn_permlane32_swap(__float_as_uint(m),__float_as_uint(m),false,false);
  return max2f(__uint_as_float(rr[0]),__uint_as_float(rr[1]));
}
__device__ __forceinline__ void pv(f32x16*o,int vb,bf16x8 pa0,bf16x8 pa1,bf16x8 pa2,bf16x8 pa3){
  #pragma unroll
  for(int d0=0;d0<2;++d0){s16x4 lo[4],hi[4];
    #pragma unroll
    for(int ks=0;ks<4;++ks){
      asm volatile("ds_read_b64_tr_b16 %0,%1 offset:%c2":"=&v"(lo[ks]):"v"(vb),"i"(d0*4096+ks*1024):"memory");
      asm volatile("ds_read_b64_tr_b16 %0,%1 offset:%c2":"=&v"(hi[ks]):"v"(vb),"i"(d0*4096+ks*1024+512):"memory");}
    asm volatile("s_waitcnt lgkmcnt(0)":::"memory");SBAR();
    #define PK(k) (bf16x8){lo[k][0],lo[k][1],lo[k][2],lo[k][3],hi[k][0],hi[k][1],hi[k][2],hi[k][3]}
    o[d0]=__builtin_amdgcn_mfma_f32_32x32x16_bf16(pa0,PK(0),o[d0],0,0,0);
    o[d0]=__builtin_amdgcn_mfma_f32_32x32x16_bf16(pa1,PK(1),o[d0],0,0,0);
    o[d0]=__builtin_amdgcn_mfma_f32_32x32x16_bf16(pa2,PK(2),o[d0],0,0,0);
    o[d0]=__builtin_amdgcn_mfma_f32_32x32x16_bf16(pa3,PK(3),o[d0],0,0,0);
    #undef PK
  }
}

#ifndef ATTN_STORE16
#define ATTN_STORE16(p,v) (*(u32x4*)(p)=(v))
#endif
template<int THRL,int LDQ,int LDKV,int LDO> __device__ __forceinline__ void attn_unit(const bf16*Qw0,const bf16*__restrict__ Kh,const bf16*__restrict__ Vh,bf16*Ow0,const int NT,char*shm){
  int tid_=threadIdx.x; asm volatile("":"+v"(tid_)); const int tid=tid_,lane=tid&63,r32=lane&31,hi=lane>>5; const int wid=__builtin_amdgcn_readfirstlane(tid>>6);
  const bf16*Qw=Qw0+(long)(wid*QBLK)*LDQ;
  const unsigned lds0=(unsigned)(uintptr_t)shm;
  float*wsf=(float*)(shm+LDS_WS)+wid*64;
  const bf16*ksrc=Kh+(long)lane*LDKV+wid*8;
  const bf16*vsrc=Vh+(long)(16*(wid&3)+(lane>>2))*LDKV+(wid>>2)*32+(lane&3)*8;
  const unsigned kdst=lds0+LDS_K+wid*1024, vdst=lds0+LDS_V+wid*1024;
  #define DMA_K(t,slot) glds16(ksrc+(long)(t)*KVBLK*LDKV,(unsigned)__builtin_amdgcn_readfirstlane(kdst+(slot)))
  #define DMA_V(t,slot) glds16(vsrc+(long)(t)*KVBLK*LDKV,(unsigned)__builtin_amdgcn_readfirstlane(vdst+(slot)))
  const int vb0=(int)(lds0+LDS_V)+((lane>>4)&1)*32+(lane&3)*8+(4*hi+((lane&15)>>2))*64;
  const char*Kbase=shm+LDS_K; bf16x8 kf[8];
  const lds_cptr shm3=(lds_cptr)shm; const lds_cptr kp0=shm3+LDS_K+hi*1024+r32*16; const lds_cptr vp0=shm3+LDS_V+((lane>>4)&1)*32+(lane&3)*8+(4*hi+((lane&15)>>2))*64;
  DMA_K(0,0);DMA_V(0,0);DMA_K(1,SLOTB);
  bf16x8 qr[4];
  #pragma unroll
  for(int d0=0;d0<4;++d0)qr[d0]=*reinterpret_cast<const bf16x8*>(&Qw[(long)r32*LDQ+d0*16+hi*8]);
  float mhat=0.f,l_reg=0.f;f32x16 o[2];o[0]=f32x16{};o[1]=f32x16{};f32x16 negm=f32x16{};asm volatile("":"+v"(negm));
  #define CMASK(P0,P1,t) do{}while(0)
  bool resc=false;
  #define START(P0,P1) do{ const float rm=rowmax(P0,P1); resc=false; \
    { const float dl=rm; mhat=fadd_s(mhat,dl); \
      _Pragma("unroll") for(int r=0;r<16;++r){P0[r]=fsub_s(P0[r],dl);P1[r]=fsub_s(P1[r],dl);} \
      _Pragma("unroll") for(int r=0;r<16;++r)negm[r]=-mhat; asm volatile("":"+v"(negm)); } \
    _Pragma("unroll") for(int r=0;r<16;++r)P0[r]=__builtin_amdgcn_exp2f(P0[r]); }while(0)
  #define RESC() do{ if(resc){ asm volatile("s_waitcnt lgkmcnt(0)":::"memory"); \
      _Pragma("unroll") for(int d_=0;d_<2;++d_) _Pragma("unroll") for(int r=0;r<16;++r)o[d_][r]*=wsf[crow(r,hi)]; } }while(0)
  f32x16 pA0,pA1,pB0,pB1;
  int sl_prev=0,sl_cur=0,sl_next=SLOTB;
  #define ROT() do{sl_prev=sl_cur;sl_cur=sl_next;sl_next=(sl_next==(NSLOT-1)*SLOTB)?0:sl_next+SLOTB;}while(0)
  DMA_K(2,2*SLOTB);
  WAIT_BAR(3);
  qkt(pA0,pA1,Kbase,qr,negm,r32,hi);asm volatile("s_nop 15\n\ts_nop 7":"+v"(pA0),"+v"(pA1));CMASK(pA0,pA1,0);
  START(pA0,pA1);
  _Pragma("unroll") for(int r=0;r<16;++r)pA1[r]=__builtin_amdgcn_exp2f(pA1[r]);
  WAIT_BAR(0);
  DMA_K(3,0);DMA_V(1,SLOTB);
  ROT();
  kload8(kf,kp0+sl_cur);
  WAIT_BAR(2);
  s16x4 vlo[8],vhi[8]; u32x4 pw0,pw1,pw2,pw3;
  #define PKW(P,B) cvtpk_s(P[B],P[B+1])
  #define PAF(k) __builtin_bit_cast(bf16x8,pw##k)
  #define VFR(i) (bf16x8){vlo[i][0],vlo[i][1],vlo[i][2],vlo[i][3],vhi[i][0],vhi[i][1],vhi[i][2],vhi[i][3]}
  #define PIN(x) asm volatile("":"+v"(x))
  #define MX3(a,b,c) __builtin_fmaxf(__builtin_fmaxf((a),(b)),(c))
  #define GAPA(MF,A0,A1,A2,A3,W0,W1,PW) do{ MF; sacc+=A0; sacc+=A1; sacc+=A2; sacc+=A3; PIN(sacc); W0; W1; PIN(PW); SBAR(); }while(0)
  #define EX(v) __builtin_amdgcn_exp2f(v)
  #define GAPB(MF,X,B) do{ MF; X[B]=EX(X[B]); X[B+1]=EX(X[B+1]); X[B+2]=EX(X[B+2]); X[B+3]=EX(X[B+3]); PIN(X); SBAR(); }while(0)
  #define VRD(i) do{ vlo[i]=vtr(vp_+(((i)>>2)*4096+((i)&3)*1024)); vhi[i]=vtr(vp_+(((i)>>2)*4096+((i)&3)*1024+512)); }while(0)
  #define KRD(G,j) do{ if(G){ kload2(kf,kp0+sl_next,j); SBAR(); } }while(0)
  #define STEP(C0,C1,P0,P1,t,GK,GV,GL) do{ SBAR(); \
    const lds_cptr vp_=vp0+sl_prev; \
    VRD(0); SBAR(); float sacc=(P0[0]+P0[1]); \
    GAPA(C0=__builtin_amdgcn_mfma_f32_32x32x16_bf16(kf[0],qr[0],negm,0,0,0), P0[2],P0[3],P0[4],P0[5],     pw0[0]=PKW(P0,0), pw0[1]=PKW(P0,2), pw0); \
    VRD(4); SBAR(); GAPA(C1=__builtin_amdgcn_mfma_f32_32x32x16_bf16(kf[1],qr[0],negm,0,0,0), P0[6],P0[7],P0[8],P0[9],     pw0[2]=PKW(P0,4), pw0[3]=PKW(P0,6), pw0); \
    VRD(1); SBAR(); GAPA(C0=__builtin_amdgcn_mfma_f32_32x32x16_bf16(kf[2],qr[1],C0,0,0,0),   P0[10],P0[11],P0[12],P0[13], pw1[0]=PKW(P0,8), pw1[1]=PKW(P0,10), pw1); \
    VRD(5); SBAR(); GAPA(C1=__builtin_amdgcn_mfma_f32_32x32x16_bf16(kf[3],qr[1],C1,0,0,0),   P0[14],P0[15],P1[0],P1[1],   pw1[2]=PKW(P0,12),pw1[3]=PKW(P0,14), pw1); \
    VRD(2); SBAR(); GAPA(C0=__builtin_amdgcn_mfma_f32_32x32x16_bf16(kf[4],qr[2],C0,0,0,0),   P1[2],P1[3],P1[4],P1[5],     pw2[0]=PKW(P1,0), pw2[1]=PKW(P1,2), pw2); \
    VRD(6); SBAR(); GAPA(C1=__builtin_amdgcn_mfma_f32_32x32x16_bf16(kf[5],qr[2],C1,0,0,0),   P1[6],P1[7],P1[8],P1[9],     pw2[2]=PKW(P1,4), pw2[3]=PKW(P1,6), pw2); \
    VRD(3); SBAR(); GAPA(C0=__builtin_amdgcn_mfma_f32_32x32x16_bf16(kf[6],qr[3],C0,0,0,0),   P1[10],P1[11],P1[12],P1[13], pw3[0]=PKW(P1,8), pw3[1]=PKW(P1,10), pw3); \
    VRD(7); SBAR(); GAPA(C1=__builtin_amdgcn_mfma_f32_32x32x16_bf16(kf[7],qr[3],C1,0,0,0),   P1[14],P1[15],0.f,0.f,       pw3[2]=PKW(P1,12),pw3[3]=PKW(P1,14), pw3); \
    l_reg+=sacc; \
    if(GK){DMA_K((t)+3,sl_cur);} if(GV){DMA_V((t)+1,sl_next);} \
    CMASK(C0,C1,t); \
    { float a=MX3(C0[0],C0[1],C1[0]),b=MX3(C0[2],C0[3],C1[1]); a=MX3(a,C1[2],C1[3]); \
      _Pragma("unroll") for(int r=4;r<16;r+=4){a=MX3(a,C0[r],C0[r+1]);b=MX3(b,C0[r+2],C0[r+3]);a=MX3(a,C1[r],C1[r+1]);b=MX3(b,C1[r+2],C1[r+3]);} \
      float rm=__builtin_fmaxf(a,b); { auto rr=__builtin_amdgcn_permlane32_swap(__float_as_uint(rm),__float_as_uint(rm),false,false); rm=__builtin_fmaxf(__uint_as_float(rr[0]),__uint_as_float(rr[1])); } \
      resc=false; \
      if(__builtin_expect(__any(rm>(float)THRL),0)){ const float dl=__builtin_fmaxf(rm,0.f); mhat+=dl; \
        _Pragma("unroll") for(int r=0;r<16;++r){C0[r]-=dl;C1[r]-=dl;} \
        _Pragma("unroll") for(int r=0;r<16;++r)negm[r]=-mhat; asm volatile("":"+v"(negm)); \
        const float f=__builtin_amdgcn_exp2f(-dl); l_reg*=f; if(hi==0)wsf[r32]=f; resc=true; } } \
    SBAR(); \
    GAPB(o[0]=__builtin_amdgcn_mfma_f32_32x32x16_bf16(PAF(0),VFR(0),o[0],0,0,0), C0,0); \
    GAPB(o[1]=__builtin_amdgcn_mfma_f32_32x32x16_bf16(PAF(0),VFR(4),o[1],0,0,0), C0,4); \
    KRD(GL,0); GAPB(o[0]=__builtin_amdgcn_mfma_f32_32x32x16_bf16(PAF(1),VFR(1),o[0],0,0,0), C0,8); \
    KRD(GL,1); GAPB(o[1]=__builtin_amdgcn_mfma_f32_32x32x16_bf16(PAF(1),VFR(5),o[1],0,0,0), C0,12); \
    KRD(GL,2); GAPB(o[0]=__builtin_amdgcn_mfma_f32_32x32x16_bf16(PAF(2),VFR(2),o[0],0,0,0), C1,0); \
    KRD(GL,3); GAPB(o[1]=__builtin_amdgcn_mfma_f32_32x32x16_bf16(PAF(2),VFR(6),o[1],0,0,0), C1,4); \
    GAPB(o[0]=__builtin_amdgcn_mfma_f32_32x32x16_bf16(PAF(3),VFR(3),o[0],0,0,0), C1,8); \
    GAPB(o[1]=__builtin_amdgcn_mfma_f32_32x32x16_bf16(PAF(3),VFR(7),o[1],0,0,0), C1,12); \
    }while(0)
  int t=1;
  #undef CMASK
  #define CMASK(P0,P1,t) do{}while(0)
  for(;t+5<NT;t+=2){
    STEP(pB0,pB1,pA0,pA1,t,true,true,true);     WAIT_BAR(2); RESC(); ROT();
    STEP(pA0,pA1,pB0,pB1,t+1,true,true,true);   WAIT_BAR(2); RESC(); ROT();
  }
  #undef CMASK
  #define CMASK(P0,P1,t) do{}while(0)
  #define ENDW(tt) do{ if((tt)+3<NT){WAIT_BAR(2);} else if((tt)+2<NT){WAIT_BAR(1);} else {WAIT_BAR(0);} }while(0)
  for(;t+1<NT;t+=2){
    STEP(pB0,pB1,pA0,pA1,t,(t+3<NT),(t+1<NT),(t+1<NT));       ENDW(t);   RESC(); ROT();
    STEP(pA0,pA1,pB0,pB1,t+1,(t+4<NT),(t+2<NT),(t+2<NT));     ENDW(t+1); RESC(); ROT();
  }
  STEP(pB0,pB1,pA0,pA1,NT-1,false,false,false); RESC();
  { float sacc=pB0[0]+pB0[1]; _Pragma("unroll") for(int r=2;r<16;++r)sacc+=pB0[r]; _Pragma("unroll") for(int r=0;r<16;++r)sacc+=pB1[r]; l_reg+=sacc;
    pw0=(u32x4){PKW(pB0,0),PKW(pB0,2),PKW(pB0,4),PKW(pB0,6)};pw1=(u32x4){PKW(pB0,8),PKW(pB0,10),PKW(pB0,12),PKW(pB0,14)};pw2=(u32x4){PKW(pB1,0),PKW(pB1,2),PKW(pB1,4),PKW(pB1,6)};pw3=(u32x4){PKW(pB1,8),PKW(pB1,10),PKW(pB1,12),PKW(pB1,14)};
    SBAR(); pv(o,vb0+sl_cur,PAF(0),PAF(1),PAF(2),PAF(3)); }
  #undef PKW
  #undef PAF
  #undef VFR
  #undef PIN
  #undef MX3
  #undef GAPA
  #undef GAPB
  #undef EX
  #undef VRD
  #undef KRD
  #undef STEP
  #undef ENDW
  {auto rr=__builtin_amdgcn_permlane32_swap(__float_as_uint(l_reg),__float_as_uint(l_reg),false,false);l_reg=__uint_as_float(rr[0])+__uint_as_float(rr[1]);}
  if(hi==0)wsf[32+r32]=l_reg;asm volatile("s_waitcnt lgkmcnt(0)":::"memory");
  float rli[16];
  #pragma unroll
  for(int r=0;r<16;++r)rli[r]=__builtin_amdgcn_rcpf(wsf[32+crow(r,hi)]);
  bf16*Ow=Ow0+(long)(wid*QBLK)*LDO;
  { bf16*stg=(bf16*)(shm+LDS_OST)+wid*2048;
    #pragma unroll
    for(int r=0;r<16;++r){const int orow=crow(r,hi);
      #pragma unroll
      for(int d0=0;d0<2;++d0)stg[orow*64+d0*32+r32]=__float2bfloat16(o[d0][r]*rli[r]);}
    asm volatile("s_waitcnt lgkmcnt(0)":::"memory");
    #pragma unroll
    for(int i=0;i<4;++i){const int row=i*8+(lane>>3),ch=lane&7; const u32x4 v=*(const u32x4*)(stg+row*64+ch*8); ATTN_STORE16(Ow+(long)row*LDO+ch*8,v);} }
  asm volatile("s_waitcnt lgkmcnt(0)\n\ts_barrier":::"memory");
  #undef DMA_K
  #undef DMA_V
  #undef CMASK
  #undef START
  #undef RESC
  #undef ROT
}
constexpr int ATTN_LDS_BYTES=LDS_BYTES;
#undef SBAR
#undef WAIT_BAR
}

namespace at96 {
using bf16=__hip_bfloat16;
constexpr int D=64;
constexpr int NW=8,QBLK=32,QB=QBLK*NW,KVBLK=64;
__device__ __forceinline__ int crow(int r,int hi){return (r&3)+8*(r>>2)+4*hi;}
#define SBAR() __builtin_amdgcn_sched_barrier(0)
__device__ __forceinline__ void cmask(f32x16&p0,f32x16&p1,int jb,int qrel,int hi){
  const float NEG=-INFINITY; int kb=64*jb+4*hi;
  #pragma unroll
  for(int r=0;r<16;++r){int kv=kb+(r&3)+8*(r>>2); if(kv>qrel)p0[r]=NEG; if(kv+32>qrel)p1[r]=NEG;}
}

constexpr int NSLOT=3, SLOTB=8192, KSLOTB=12288;
constexpr int LDS_K=0, LDS_V=NSLOT*KSLOTB, LDS_WS=LDS_V+NSLOT*SLOTB, LDS_OST=LDS_WS+NW*64*4, LDS_BYTES=LDS_OST+NW*4096;
#define KS(s) ((s)+((s)>>1))
constexpr float C2=0.125f*1.4426950408889634f;
__device__ __forceinline__ void glds16(const void*gsrc,unsigned lds_dst){unsigned keep;
  asm volatile("s_mov_b32 %0, m0\n\ts_mov_b32 m0, %2\n\ts_nop 0\n\tglobal_load_lds_dwordx4 %1, off\n\ts_mov_b32 m0, %0":"=&s"(keep):"v"(gsrc),"s"(lds_dst):"memory");}
__device__ __forceinline__ float max3f(float a,float b,float c){float r;asm("v_max3_f32 %0, %1, %2, %3":"=v"(r):"v"(a),"v"(b),"v"(c));return r;}
__device__ __forceinline__ float max2f(float a,float b){float r;asm("v_max_f32_e32 %0, %1, %2":"=v"(r):"v"(a),"v"(b));return r;}
__device__ __forceinline__ float fadd_s(float a,float b){float r;asm("v_add_f32_e32 %0, %1, %2":"=v"(r):"v"(a),"v"(b));return r;}
__device__ __forceinline__ float fsub_s(float a,float b){float r;asm("v_sub_f32_e32 %0, %1, %2":"=v"(r):"v"(a),"v"(b));return r;}
typedef float f32x2_t __attribute__((ext_vector_type(2))); typedef __bf16 bf16x2_t __attribute__((ext_vector_type(2)));
__device__ __forceinline__ unsigned cvtpk_s(float lo,float hi){f32x2_t v={lo,hi};bf16x2_t b=__builtin_convertvector(v,bf16x2_t);return __builtin_bit_cast(unsigned,b);}
#define WAIT_BAR(N) asm volatile("s_waitcnt vmcnt(" #N ") lgkmcnt(0)\n\ts_barrier":::"memory")

__device__ __forceinline__ void qkt(f32x16&p0,f32x16&p1,const char*Kslot,const bf16x8*qr,const f32x16&negm,int r32,int hi){
  const char*kb=Kslot+hi*1024+r32*16;
  #pragma unroll
  for(int d0=0;d0<6;++d0){
    const bf16x8 b0=*reinterpret_cast<const bf16x8*>(kb+d0*2048);
    const bf16x8 b1=*reinterpret_cast<const bf16x8*>(kb+d0*2048+512);
    if(d0==0){p0=__builtin_amdgcn_mfma_f32_32x32x16_bf16(b0,qr[0],negm,0,0,0);p1=__builtin_amdgcn_mfma_f32_32x32x16_bf16(b1,qr[0],negm,0,0,0);}
    else{p0=__builtin_amdgcn_mfma_f32_32x32x16_bf16(b0,qr[d0],p0,0,0,0);p1=__builtin_amdgcn_mfma_f32_32x32x16_bf16(b1,qr[d0],p1,0,0,0);}}
}
typedef __attribute__((address_space(3))) const char* lds_cptr;
typedef short v4i16_t __attribute__((ext_vector_type(4)));
__device__ __forceinline__ void kload8(bf16x8*kf,lds_cptr kp){
  #pragma unroll
  for(int j=0;j<6;++j){ kf[2*j]=*(const __attribute__((address_space(3))) bf16x8*)(kp+j*2048); kf[2*j+1]=*(const __attribute__((address_space(3))) bf16x8*)(kp+j*2048+512); }
}
__device__ __forceinline__ void kload2(bf16x8*kf,lds_cptr kp,int j){ kf[2*j]=*(const __attribute__((address_space(3))) bf16x8*)(kp+j*2048); kf[2*j+1]=*(const __attribute__((address_space(3))) bf16x8*)(kp+j*2048+512); }
__device__ __forceinline__ s16x4 vtr(lds_cptr p){ return __builtin_bit_cast(s16x4,__builtin_amdgcn_ds_read_tr16_b64_v4i16((__attribute__((address_space(3))) v4i16_t*)p)); }
__device__ __forceinline__ float rowmax(const f32x16&p0,const f32x16&p1){
  float a=max3f(p0[0],p0[1],p1[0]),b=max3f(p0[2],p0[3],p1[1]);a=max3f(a,p1[2],p1[3]);
  #pragma unroll
  for(int r=4;r<16;r+=4){a=max3f(a,p0[r],p0[r+1]);b=max3f(b,p0[r+2],p0[r+3]);a=max3f(a,p1[r],p1[r+1]);b=max3f(b,p1[r+2],p1[r+3]);}
  const float m=max2f(a,b);
  auto rr=__builtin_amdgcn_permlane32_swap(__float_as_uint(m),__float_as_uint(m),false,false);
  return max2f(__uint_as_float(rr[0]),__uint_as_float(rr[1]));
}
__device__ __forceinline__ void pv(f32x16*o,int vb,bf16x8 pa0,bf16x8 pa1,bf16x8 pa2,bf16x8 pa3){
  #pragma unroll
  for(int d0=0;d0<2;++d0){s16x4 lo[4],hi[4];
    #pragma unroll
    for(int ks=0;ks<4;++ks){
      asm volatile("ds_read_b64_tr_b16 %0,%1 offset:%c2":"=&v"(lo[ks]):"v"(vb),"i"(d0*4096+ks*1024):"memory");
      asm volatile("ds_read_b64_tr_b16 %0,%1 offset:%c2":"=&v"(hi[ks]):"v"(vb),"i"(d0*4096+ks*1024+512):"memory");}
    asm volatile("s_waitcnt lgkmcnt(0)":::"memory");SBAR();
    #define PK(k) (bf16x8){lo[k][0],lo[k][1],lo[k][2],lo[k][3],hi[k][0],hi[k][1],hi[k][2],hi[k][3]}
    o[d0]=__builtin_amdgcn_mfma_f32_32x32x16_bf16(pa0,PK(0),o[d0],0,0,0);
    o[d0]=__builtin_amdgcn_mfma_f32_32x32x16_bf16(pa1,PK(1),o[d0],0,0,0);
    o[d0]=__builtin_amdgcn_mfma_f32_32x32x16_bf16(pa2,PK(2),o[d0],0,0,0);
    o[d0]=__builtin_amdgcn_mfma_f32_32x32x16_bf16(pa3,PK(3),o[d0],0,0,0);
    #undef PK
  }
}

#ifndef ATTN_STORE16
#define ATTN_STORE16(p,v) (*(u32x4*)(p)=(v))
#endif
template<int THRL,int LDQ,int LDK,int LDV,int LDO> __device__ __forceinline__ void attn_unit(const bf16*Qw0,const bf16*__restrict__ Kh,const bf16*__restrict__ Vh,bf16*Ow0,const int NT,char*shm){
  int tid_=threadIdx.x; asm volatile("":"+v"(tid_)); const int tid=tid_,lane=tid&63,r32=lane&31,hi=lane>>5; const int wid=__builtin_amdgcn_readfirstlane(tid>>6);
  const bf16*Qw=Qw0+(long)(wid*QBLK)*LDQ;
  const unsigned lds0=(unsigned)(uintptr_t)shm;
  float*wsf=(float*)(shm+LDS_WS)+wid*64;
  const bf16*ksrc=Kh+(long)lane*LDK+wid*8; const bf16*ksrc1=Kh+(long)lane*LDK+(8+(wid&3))*8;
  const bf16*vsrc=Vh+(long)(16*(wid&3)+(lane>>2))*LDV+(wid>>2)*32+(lane&3)*8;
  const unsigned kdst=lds0+LDS_K+wid*1024, kdst1=lds0+LDS_K+(8+(wid&3))*1024, vdst=lds0+LDS_V+wid*1024;
  #define DMA_K(t,slot) do{ glds16(ksrc+(long)(t)*KVBLK*LDK,(unsigned)__builtin_amdgcn_readfirstlane(kdst+KS(slot))); glds16(ksrc1+(long)(t)*KVBLK*LDK,(unsigned)__builtin_amdgcn_readfirstlane(kdst1+KS(slot))); }while(0)
  #define DMA_V(t,slot) glds16(vsrc+(long)(t)*KVBLK*LDV,(unsigned)__builtin_amdgcn_readfirstlane(vdst+(slot)))
  const int vb0=(int)(lds0+LDS_V)+((lane>>4)&1)*32+(lane&3)*8+(4*hi+((lane&15)>>2))*64;
  const char*Kbase=shm+LDS_K; bf16x8 kf[12];
  const lds_cptr shm3=(lds_cptr)shm; const lds_cptr kp0=shm3+LDS_K+hi*1024+r32*16; const lds_cptr vp0=shm3+LDS_V+((lane>>4)&1)*32+(lane&3)*8+(4*hi+((lane&15)>>2))*64;
  DMA_K(0,0);DMA_V(0,0);DMA_K(1,SLOTB);
  bf16x8 qr[6];
  #pragma unroll
  for(int d0=0;d0<6;++d0)qr[d0]=*reinterpret_cast<const bf16x8*>(&Qw[(long)r32*LDQ+d0*16+hi*8]);
  float mhat=0.f,l_reg=0.f;f32x16 o[2];o[0]=f32x16{};o[1]=f32x16{};f32x16 negm=f32x16{};asm volatile("":"+v"(negm));
  #define CMASK(P0,P1,t) do{}while(0)
  bool resc=false;
  #define START(P0,P1) do{ const float rm=rowmax(P0,P1); resc=false; \
    { const float dl=rm; mhat=fadd_s(mhat,dl); \
      _Pragma("unroll") for(int r=0;r<16;++r){P0[r]=fsub_s(P0[r],dl);P1[r]=fsub_s(P1[r],dl);} \
      _Pragma("unroll") for(int r=0;r<16;++r)negm[r]=-mhat; asm volatile("":"+v"(negm)); } \
    _Pragma("unroll") for(int r=0;r<16;++r)P0[r]=__builtin_amdgcn_exp2f(P0[r]); }while(0)
  #define RESC() do{ if(resc){ asm volatile("s_waitcnt lgkmcnt(0)":::"memory"); \
      _Pragma("unroll") for(int d_=0;d_<2;++d_) _Pragma("unroll") for(int r=0;r<16;++r)o[d_][r]*=wsf[crow(r,hi)]; } }while(0)
  f32x16 pA0,pA1,pB0,pB1;
  int sl_prev=0,sl_cur=0,sl_next=SLOTB;
  #define ROT() do{sl_prev=sl_cur;sl_cur=sl_next;sl_next=(sl_next==(NSLOT-1)*SLOTB)?0:sl_next+SLOTB;}while(0)
  DMA_K(2,2*SLOTB);
  WAIT_BAR(5);
  qkt(pA0,pA1,Kbase,qr,negm,r32,hi);asm volatile("s_nop 15\n\ts_nop 7":"+v"(pA0),"+v"(pA1));CMASK(pA0,pA1,0);
  START(pA0,pA1);
  _Pragma("unroll") for(int r=0;r<16;++r)pA1[r]=__builtin_amdgcn_exp2f(pA1[r]);
  WAIT_BAR(0);
  DMA_K(3,0);DMA_V(1,SLOTB);
  ROT();
  kload8(kf,kp0+KS(sl_cur));
  WAIT_BAR(3);
  s16x4 vlo[8],vhi[8]; u32x4 pw0,pw1,pw2,pw3;
  #define PKW(P,B) cvtpk_s(P[B],P[B+1])
  #define PAF(k) __builtin_bit_cast(bf16x8,pw##k)
  #define VFR(i) (bf16x8){vlo[i][0],vlo[i][1],vlo[i][2],vlo[i][3],vhi[i][0],vhi[i][1],vhi[i][2],vhi[i][3]}
  #define PIN(x) asm volatile("":"+v"(x))
  #define MX3(a,b,c) __builtin_fmaxf(__builtin_fmaxf((a),(b)),(c))
  #define GAPA(MF,A0,A1,A2,A3,W0,W1,PW) do{ MF; sacc+=A0; sacc+=A1; sacc+=A2; sacc+=A3; PIN(sacc); W0; W1; PIN(PW); SBAR(); }while(0)
  #define EX(v) __builtin_amdgcn_exp2f(v)
  #define GAPB(MF,X,B) do{ MF; X[B]=EX(X[B]); X[B+1]=EX(X[B+1]); X[B+2]=EX(X[B+2]); X[B+3]=EX(X[B+3]); PIN(X); SBAR(); }while(0)
  #define VRD(i) do{ vlo[i]=vtr(vp_+(((i)>>2)*4096+((i)&3)*1024)); vhi[i]=vtr(vp_+(((i)>>2)*4096+((i)&3)*1024+512)); }while(0)
  #define KRD(G,j) do{ if(G){ kload2(kf,kp0+KS(sl_next),j); SBAR(); } }while(0)
  #define STEP(C0,C1,P0,P1,t,GK,GV,GL) do{ SBAR(); \
    const lds_cptr vp_=vp0+sl_prev; \
    C0=__builtin_amdgcn_mfma_f32_32x32x16_bf16(kf[0],qr[0],negm,0,0,0); C1=__builtin_amdgcn_mfma_f32_32x32x16_bf16(kf[1],qr[0],negm,0,0,0); \
    C0=__builtin_amdgcn_mfma_f32_32x32x16_bf16(kf[2],qr[1],C0,0,0,0); C1=__builtin_amdgcn_mfma_f32_32x32x16_bf16(kf[3],qr[1],C1,0,0,0); SBAR(); \
    VRD(0); SBAR(); float sacc=(P0[0]+P0[1]); \
    GAPA(C0=__builtin_amdgcn_mfma_f32_32x32x16_bf16(kf[4],qr[2],C0,0,0,0), P0[2],P0[3],P0[4],P0[5],     pw0[0]=PKW(P0,0), pw0[1]=PKW(P0,2), pw0); \
    VRD(4); SBAR(); GAPA(C1=__builtin_amdgcn_mfma_f32_32x32x16_bf16(kf[5],qr[2],C1,0,0,0), P0[6],P0[7],P0[8],P0[9],     pw0[2]=PKW(P0,4), pw0[3]=PKW(P0,6), pw0); \
    VRD(1); SBAR(); GAPA(C0=__builtin_amdgcn_mfma_f32_32x32x16_bf16(kf[6],qr[3],C0,0,0,0),   P0[10],P0[11],P0[12],P0[13], pw1[0]=PKW(P0,8), pw1[1]=PKW(P0,10), pw1); \
    VRD(5); SBAR(); GAPA(C1=__builtin_amdgcn_mfma_f32_32x32x16_bf16(kf[7],qr[3],C1,0,0,0),   P0[14],P0[15],P1[0],P1[1],   pw1[2]=PKW(P0,12),pw1[3]=PKW(P0,14), pw1); \
    VRD(2); SBAR(); GAPA(C0=__builtin_amdgcn_mfma_f32_32x32x16_bf16(kf[8],qr[4],C0,0,0,0),   P1[2],P1[3],P1[4],P1[5],     pw2[0]=PKW(P1,0), pw2[1]=PKW(P1,2), pw2); \
    VRD(6); SBAR(); GAPA(C1=__builtin_amdgcn_mfma_f32_32x32x16_bf16(kf[9],qr[4],C1,0,0,0),   P1[6],P1[7],P1[8],P1[9],     pw2[2]=PKW(P1,4), pw2[3]=PKW(P1,6), pw2); \
    VRD(3); SBAR(); GAPA(C0=__builtin_amdgcn_mfma_f32_32x32x16_bf16(kf[10],qr[5],C0,0,0,0),  P1[10],P1[11],P1[12],P1[13], pw3[0]=PKW(P1,8), pw3[1]=PKW(P1,10), pw3); \
    VRD(7); SBAR(); GAPA(C1=__builtin_amdgcn_mfma_f32_32x32x16_bf16(kf[11],qr[5],C1,0,0,0),  P1[14],P1[15],0.f,0.f,       pw3[2]=PKW(P1,12),pw3[3]=PKW(P1,14), pw3); \
    l_reg+=sacc; \
    if(GK){DMA_K((t)+3,sl_cur);} if(GV){DMA_V((t)+1,sl_next);} \
    CMASK(C0,C1,t); \
    { float a=MX3(C0[0],C0[1],C1[0]),b=MX3(C0[2],C0[3],C1[1]); a=MX3(a,C1[2],C1[3]); \
      _Pragma("unroll") for(int r=4;r<16;r+=4){a=MX3(a,C0[r],C0[r+1]);b=MX3(b,C0[r+2],C0[r+3]);a=MX3(a,C1[r],C1[r+1]);b=MX3(b,C1[r+2],C1[r+3]);} \
      float rm=__builtin_fmaxf(a,b); { auto rr=__builtin_amdgcn_permlane32_swap(__float_as_uint(rm),__float_as_uint(rm),false,false); rm=__builtin_fmaxf(__uint_as_float(rr[0]),__uint_as_float(rr[1])); } \
      resc=false; \
      if(__builtin_expect(__any(rm>(float)THRL),0)){ const float dl=__builtin_fmaxf(rm,0.f); mhat+=dl; \
        _Pragma("unroll") for(int r=0;r<16;++r){C0[r]-=dl;C1[r]-=dl;} \
        _Pragma("unroll") for(int r=0;r<16;++r)negm[r]=-mhat; asm volatile("":"+v"(negm)); \
        const float f=__builtin_amdgcn_exp2f(-dl); l_reg*=f; if(hi==0)wsf[r32]=f; resc=true; } } \
    SBAR(); \
    GAPB(o[0]=__builtin_amdgcn_mfma_f32_32x32x16_bf16(PAF(0),VFR(0),o[0],0,0,0), C0,0); \
    GAPB(o[1]=__builtin_amdgcn_mfma_f32_32x32x16_bf16(PAF(0),VFR(4),o[1],0,0,0), C0,4); \
    KRD(GL,0); GAPB(o[0]=__builtin_amdgcn_mfma_f32_32x32x16_bf16(PAF(1),VFR(1),o[0],0,0,0), C0,8); \
    KRD(GL,1); GAPB(o[1]=__builtin_amdgcn_mfma_f32_32x32x16_bf16(PAF(1),VFR(5),o[1],0,0,0), C0,12); \
    KRD(GL,2); GAPB(o[0]=__builtin_amdgcn_mfma_f32_32x32x16_bf16(PAF(2),VFR(2),o[0],0,0,0), C1,0); \
    KRD(GL,3); GAPB(o[1]=__builtin_amdgcn_mfma_f32_32x32x16_bf16(PAF(2),VFR(6),o[1],0,0,0), C1,4); \
    KRD(GL,4); GAPB(o[0]=__builtin_amdgcn_mfma_f32_32x32x16_bf16(PAF(3),VFR(3),o[0],0,0,0), C1,8); \
    KRD(GL,5); GAPB(o[1]=__builtin_amdgcn_mfma_f32_32x32x16_bf16(PAF(3),VFR(7),o[1],0,0,0), C1,12); \
    }while(0)
  int t=1;
  #undef CMASK
  #define CMASK(P0,P1,t) do{}while(0)
  for(;t+5<NT;t+=2){
    STEP(pB0,pB1,pA0,pA1,t,true,true,true);     WAIT_BAR(3); RESC(); ROT();
    STEP(pA0,pA1,pB0,pB1,t+1,true,true,true);   WAIT_BAR(3); RESC(); ROT();
  }
  #undef CMASK
  #define CMASK(P0,P1,t) do{}while(0)
  #define ENDW(tt) do{ if((tt)+3<NT){WAIT_BAR(3);} else if((tt)+2<NT){WAIT_BAR(1);} else {WAIT_BAR(0);} }while(0)
  for(;t+1<NT;t+=2){
    STEP(pB0,pB1,pA0,pA1,t,(t+3<NT),(t+1<NT),(t+1<NT));       ENDW(t);   RESC(); ROT();
    STEP(pA0,pA1,pB0,pB1,t+1,(t+4<NT),(t+2<NT),(t+2<NT));     ENDW(t+1); RESC(); ROT();
  }
  STEP(pB0,pB1,pA0,pA1,NT-1,false,false,false); RESC();
  { float sacc=pB0[0]+pB0[1]; _Pragma("unroll") for(int r=2;r<16;++r)sacc+=pB0[r]; _Pragma("unroll") for(int r=0;r<16;++r)sacc+=pB1[r]; l_reg+=sacc;
    pw0=(u32x4){PKW(pB0,0),PKW(pB0,2),PKW(pB0,4),PKW(pB0,6)};pw1=(u32x4){PKW(pB0,8),PKW(pB0,10),PKW(pB0,12),PKW(pB0,14)};pw2=(u32x4){PKW(pB1,0),PKW(pB1,2),PKW(pB1,4),PKW(pB1,6)};pw3=(u32x4){PKW(pB1,8),PKW(pB1,10),PKW(pB1,12),PKW(pB1,14)};
    SBAR(); pv(o,vb0+sl_cur,PAF(0),PAF(1),PAF(2),PAF(3)); }
  #undef PKW
  #undef PAF
  #undef VFR
  #undef PIN
  #undef MX3
  #undef GAPA
  #undef GAPB
  #undef EX
  #undef VRD
  #undef KRD
  #undef STEP
  #undef ENDW
  {auto rr=__builtin_amdgcn_permlane32_swap(__float_as_uint(l_reg),__float_as_uint(l_reg),false,false);l_reg=__uint_as_float(rr[0])+__uint_as_float(rr[1]);}
  if(hi==0)wsf[32+r32]=l_reg;asm volatile("s_waitcnt lgkmcnt(0)":::"memory");
  float rli[16];
  #pragma unroll
  for(int r=0;r<16;++r)rli[r]=__builtin_amdgcn_rcpf(wsf[32+crow(r,hi)]);
  bf16*Ow=Ow0+(long)(wid*QBLK)*LDO;
  { bf16*stg=(bf16*)(shm+LDS_OST)+wid*2048;
    #pragma unroll
    for(int r=0;r<16;++r){const int orow=crow(r,hi);
      #pragma unroll
      for(int d0=0;d0<2;++d0)stg[orow*64+d0*32+r32]=__float2bfloat16(o[d0][r]*rli[r]);}
    asm volatile("s_waitcnt lgkmcnt(0)":::"memory");
    #pragma unroll
    for(int i=0;i<4;++i){const int row=i*8+(lane>>3),ch=lane&7; const u32x4 v=*(const u32x4*)(stg+row*64+ch*8); ATTN_STORE16(Ow+(long)row*LDO+ch*8,v);} }
  asm volatile("s_waitcnt lgkmcnt(0)\n\ts_barrier":::"memory");
  #undef DMA_K
  #undef DMA_V
  #undef CMASK
  #undef START
  #undef RESC
  #undef ROT
}
constexpr int ATTN_LDS_BYTES=LDS_BYTES;
#undef KS
#undef SBAR
#undef WAIT_BAR
}

namespace ck {
constexpr int PT = 144, MSZ = 64 * PT;
typedef short v4i16_t __attribute__((ext_vector_type(4)));
struct LaneOff { int n, t, s; };
__device__ __forceinline__ LaneOff lane_off(int lane) { const int x = lane & 15, g = lane >> 4; LaneOff o; o.n = x * PT + g * 16; o.t = (8 * g + (x >> 2)) * PT + (x & 3) * 8; o.s = x * PT + g * 8; return o; }
__device__ __forceinline__ bf16x8 fragN(const LAS unsigned char* M, int blk, int ks, const LaneOff& o) {
    return *(const LAS bf16x8*)(M + blk * (16 * PT) + ks * 64 + o.n); }
__device__ __forceinline__ bf16x8 fragT(const LAS unsigned char* M, int blk, int ks, const LaneOff& o) {
    const LAS unsigned char* p = M + ks * (32 * PT) + blk * 32 + o.t;
    const v4i16_t lo = __builtin_amdgcn_ds_read_tr16_b64_v4i16((LAS v4i16_t*)p), hi = __builtin_amdgcn_ds_read_tr16_b64_v4i16((LAS v4i16_t*)(p + 4 * PT));
    return (bf16x8){lo[0], lo[1], lo[2], lo[3], hi[0], hi[1], hi[2], hi[3]}; }
template <bool LT, bool RT> __device__ __forceinline__ void mm2(f32x4 (&acc)[2], const LAS unsigned char* Lm, const LAS unsigned char* Rm, int mt, int nt0, const LaneOff& o) {
#pragma unroll
    for (int ks = 0; ks < 2; ++ks) { const bf16x8 a = LT ? fragT(Lm, mt, ks, o) : fragN(Lm, mt, ks, o);
#pragma unroll
        for (int q = 0; q < 2; ++q) { const bf16x8 b = RT ? fragT(Rm, nt0 + q, ks, o) : fragN(Rm, nt0 + q, ks, o); acc[q] = __builtin_amdgcn_mfma_f32_16x16x32_bf16(a, b, acc[q], 0, 0, 0); } }
}
__device__ __forceinline__ void st2(LAS unsigned char* Out, const f32x4 (&acc)[2], int mt, int nt0, const LaneOff& o) {
#pragma unroll
    for (int q = 0; q < 2; ++q) *(LAS u32x2*)(Out + (nt0 + q) * (16 * PT) + mt * 32 + o.s) = (u32x2){pk2(acc[q][0], acc[q][1]), pk2(acc[q][2], acc[q][3])};
}
}

#define XB_TMO      128
#define XB_XCNT(j)  (256  + 64 * (j))
#define XB_XSUB(j)  (1280 + 64 * (j))
#define XB_XGEN(j)  (2304 + 64 * (j))
#define XB_TOP      3328
#define XB_TOPGEN   3392
#define XCD_BAR_WORDS 3456
#define XB_SPIN_CAP (1u << 18)
__device__ __forceinline__ unsigned xb_ld(unsigned* p)              { return __hip_atomic_load(p, __ATOMIC_RELAXED, __HIP_MEMORY_SCOPE_AGENT); }
__device__ __forceinline__ unsigned xb_add(unsigned* p, unsigned v) { return __hip_atomic_fetch_add(p, v, __ATOMIC_RELAXED, __HIP_MEMORY_SCOPE_AGENT); }
__device__ __forceinline__ unsigned xb_xcc_id() { return (unsigned)__builtin_amdgcn_s_getreg((3 << 11) | 20) & 0xFu; }
#define XB_SPIN(cond, bar) do { unsigned _sp = 0; while (cond) { __builtin_amdgcn_s_sleep(1); \
    if ((++_sp & 255u) == 0u) { if (xb_ld(&(bar)[XB_TMO])) break; if (_sp > XB_SPIN_CAP) { atomicAdd(&(bar)[XB_TMO], 1u); break; } } } } while (0)
struct XcdBarrier { unsigned* bar; unsigned x; volatile LAS unsigned* st; };
__device__ __forceinline__ XcdBarrier xcd_barrier_post(unsigned* bar, volatile LAS unsigned* st) {
    XcdBarrier b; b.bar = bar; b.x = xb_xcc_id(); b.st = st;
    if (threadIdx.x == 0) (void)xb_add(&bar[XB_XCNT(b.x)], 1u);
    return b;
}
__device__ __forceinline__ void xcd_barrier_complete(unsigned* bar, unsigned x, unsigned& nloc, unsigned& nx) {
    const unsigned G = gridDim.x * gridDim.y * gridDim.z;
    unsigned sum, cnt, mine, sp = 0u;
    for (;;) {
        sum = 0u; cnt = 0u; mine = 0u;
#pragma unroll
        for (unsigned j = 0; j < 16; ++j) { const unsigned c = xb_ld(&bar[XB_XCNT(j)]); sum += c; cnt += (c > 0u) ? 1u : 0u; mine = (j == x) ? c : mine; }
        if (sum == G) break;
        __builtin_amdgcn_s_sleep(1);
        if ((++sp & 255u) == 0u) { if (xb_ld(&bar[XB_TMO])) break; if (sp > XB_SPIN_CAP) { atomicAdd(&bar[XB_TMO], 1u); break; } }
    }
    nloc = mine > 0u ? mine : 1u; nx = cnt > 0u ? cnt : 1u;
}
__device__ __forceinline__ void xcd_barrier(const XcdBarrier& b) {
    asm volatile("s_waitcnt vmcnt(0)" ::: "memory");
    __syncthreads();
    if (threadIdx.x == 0) {
        unsigned* bar = b.bar;
        __builtin_amdgcn_s_waitcnt(0);
        unsigned nloc = b.st[0], nx = b.st[1];
        if (nloc == 0u) { xcd_barrier_complete(bar, b.x, nloc, nx); b.st[0] = nloc; b.st[1] = nx; }
        const unsigned old = xb_add(&bar[XB_XSUB(b.x)], 1u);
        const unsigned gen = old / nloc;
        if (old + 1u == (gen + 1u) * nloc) {
            __builtin_amdgcn_fence(__ATOMIC_RELEASE, "agent");
            asm volatile("s_waitcnt vmcnt(0)" ::: "memory");
            const unsigned og = xb_add(&bar[XB_TOP], 1u);
            const unsigned tg = og / nx;
            if (og + 1u == (tg + 1u) * nx) xb_add(&bar[XB_TOPGEN], 1u);
            else XB_SPIN(xb_ld(&bar[XB_TOPGEN]) == tg, bar);
            __builtin_amdgcn_fence(__ATOMIC_ACQUIRE, "agent");
            xb_add(&bar[XB_XGEN(b.x)], 1u);
            asm volatile("s_waitcnt vmcnt(0)" ::: "memory");
        } else {
            XB_SPIN(xb_ld(&bar[XB_XGEN(b.x)]) == gen, bar);
            __builtin_amdgcn_fence(__ATOMIC_ACQUIRE, "agent");
            asm volatile("s_waitcnt vmcnt(0)" ::: "memory");
        }
    }
    __syncthreads();
}

constexpr int RING_BYTES = 131072, LDS_BYTES = 163840, LDSCTL_OFF = LDS_BYTES - 1024, MISC_OFF = LDSCTL_OFF;
struct Args { const float* in[39]; float* out; unsigned char* ws; int ph_lo, ph_hi, li, pad; };
enum { I_X = 0, I_C, I_CTX, I_CCTX, I_ADAW, I_ADAB, I_N1G, I_N2G, I_ABWIN, I_ABWOUT, I_MU, I_W0, I_W2, I_A0, I_A2, I_KK, I_KA, I_RK, I_G2, I_LNW, I_LNB,
       I_GQA_, I_WQUP, I_GKVA, I_WKVUP, I_MGQ, I_MGK, I_GWIN, I_GWOUT, I_GGQ, I_GGK, I_RW, I_RBIAS, I_MGATE, I_MUP, I_MDOWN, I_SGATE, I_SUP, I_SDOWN };

__device__ __forceinline__ const float* inp(const Args& a, int i) { asm volatile("" : "+s"(i)); return a.in[i]; }
#define INP(i) inp(args, (i))
#define PH_LOCALS int tid = F.tid, lane = F.lane; asm volatile("" : "+v"(tid), "+v"(lane));
struct Ctx {
    LAS unsigned char* lds; int tid, lane, wave, G, bid;
    unsigned char* ws; float* out;
};
__device__ __forceinline__ bool row_is_ctx(int m) { return (m % RB) < CTXL; }
__device__ __forceinline__ float* xl_row(const Ctx& F, int m) {
    const int b = m / RB, j = m % RB;
    return j < CTXL ? (float*)(F.ws + WS_XLC) + (size_t)(b * CTXL + j) * DM : F.out + (size_t)(b * SEQ + j - CTXL) * DM;
}

__device__ __forceinline__ void tr_item(const float* W, int ldn, int k0, int n0, bf16_t* dst, int ldw, LAS float* scr, int lane) {
#pragma unroll 8
    for (int i = 0; i < 32; ++i) { const int kk = 2 * i + (lane >> 5); scr[kk * 33 + (lane & 31)] = W[(size_t)(k0 + kk) * ldn + n0 + (lane & 31)]; }
    LDS_WAIT(); asm volatile("" ::: "memory");
    const int c = lane & 7;
#pragma unroll
    for (int j = 0; j < 4; ++j) { const int n = (lane >> 3) + 8 * j; const LAS float* s = scr + (8 * c) * 33 + n;
        u32x4 o; o.x = pk2(s[0 * 33], s[1 * 33]); o.y = pk2(s[2 * 33], s[3 * 33]); o.z = pk2(s[4 * 33], s[5 * 33]); o.w = pk2(s[6 * 33], s[7 * 33]);
        *(u32x4*)(dst + (size_t)n * ldw + 8 * c) = o; }
    LDS_WAIT(); asm volatile("" ::: "memory");
}
__device__ __forceinline__ void tr_matrix_item(const float* W, int K, int N, bf16_t* dst, int ldw, LAS float* scr, int item, int lane) {
    const int nblk = N / 32, kb = item / nblk, nb = item % nblk;
    tr_item(W, N, 64 * kb, 32 * nb, dst + (size_t)(32 * nb) * ldw + 64 * kb, ldw, scr, lane);
}

__device__ __forceinline__ void norm_mod_row(const float* xrow, const float* g, const float* sh, const float* sc, bf16_t* orow, int lane, f32x4 (&hv)[4]) {
    const f32x4* xr = (const f32x4*)xrow + lane;
    f32x4 v[4]; float s = 0.f;
#pragma unroll
    for (int j = 0; j < 4; ++j) { v[j] = xr[64 * j]; s += (v[j].x * v[j].x + v[j].y * v[j].y) + (v[j].z * v[j].z + v[j].w * v[j].w); }
    const float rstd = 1.f / sqrtf(wave_sum(s) * (1.f / DM) + 1e-6f);
    unsigned long long* o8 = (unsigned long long*)orow + lane;
#pragma unroll
    for (int j = 0; j < 4; ++j) { const f32x4 gg = ((const f32x4*)g)[lane + 64 * j], s1 = ((const f32x4*)sc)[lane + 64 * j], s0 = ((const f32x4*)sh)[lane + 64 * j];
        f32x4 h = (v[j] * rstd * gg) * (s1 + 1.f) + s0; hv[j] = h;
        o8[64 * j] = (unsigned long long)pk2(h.x, h.y) | ((unsigned long long)pk2(h.z, h.w) << 32); }
}

struct SchedDense {
    int nM, nN, G, c; const char* A; const char* B; char* O; size_t a_tile, b_tile, o_tile; int latent_only;
    __device__ __forceinline__ bool next(int i, g8::Unit& u) const {
        int pm, pn; if (!g8::tile_order(i, G, c, nM, nN, pm, pn)) return false;
        if (latent_only) pm = pm + 1 + pm / 32;
        u.a = A + (size_t)pm * a_tile; u.b = B + (size_t)pn * b_tile; u.o = O + (size_t)pm * o_tile; u.pn = pn; u.aux = 0; u.f0 = nullptr; return true;
    }
};
struct SchedRes {
    int nM, nN, G, c; const char* A; const char* B; size_t a_tile, b_tile; int latent_only;
    const float* base_l; const float* base_c; float* out_l; float* out_c;
    __device__ __forceinline__ bool next(int i, g8::Unit& u) const {
        int pm, pn; if (!g8::tile_order(i, G, c, nM, nN, pm, pn)) return false;
        if (latent_only) pm = pm + 1 + pm / 32;
        const int b = pm / 33, t = pm % 33;
        u.a = A + (size_t)pm * a_tile; u.b = B + (size_t)pn * b_tile; u.pn = pn;
        if (t == 0) { u.f0 = base_c + (size_t)(b * CTXL) * DM; u.o = (char*)(out_c + (size_t)(b * CTXL) * DM); u.aux = 2; }
        else { const size_t r0 = (size_t)(b * SEQ + (t - 1) * 256) * DM; u.f0 = base_l + r0; u.o = (char*)(out_l + r0); u.aux = b; }
        return true;
    }
};
struct SchedMoe {
    volatile LAS unsigned* tab;
    const char* HS; const char* HSH; size_t a_tile;
    const char* W; size_t w_exp, w_tile;
    char* O; char* OSH; size_t o_tile;
    const float* rowwt;
    __device__ __forceinline__ bool next(int i, g8::Unit& u) const {
        const int n = __builtin_amdgcn_readfirstlane((int)tab[0]); if (i >= n) return false;
        const unsigned w0 = (unsigned)__builtin_amdgcn_readfirstlane((int)tab[1 + 2 * i]), e = (unsigned)__builtin_amdgcn_readfirstlane((int)tab[2 + 2 * i]);
        const unsigned tile = w0 & 0xffffu, pn = (w0 >> 16) & 0xffu; const bool sh = (w0 >> 31) != 0u;
        u.pn = (int)pn; u.aux = 0;
        u.a = (sh ? HSH : HS) + (size_t)tile * a_tile; u.b = W + (size_t)e * w_exp + (size_t)pn * w_tile; u.o = (sh ? OSH : O) + (size_t)tile * o_tile;
        u.f0 = (sh || !rowwt) ? nullptr : rowwt + (size_t)tile * 256;
        return true;
    }
};
__device__ __forceinline__ void moe_units(volatile LAS unsigned* tab, const unsigned* cnt, int G, int c, int npn, int n_sh, int latent_only) {
    int ts[NE + 1]; int tot = 0;
    for (int e = 0; e < NE; ++e) { ts[e] = tot; tot += (int)((cnt[e * 64] + 255u) >> 8); }
    ts[NE] = tot;
    const int total = (tot + n_sh) * npn; int n = 0;
    for (int i = 0; i < 16; ++i) { const int L = i * G + c; if (L >= total) break;
        const int tile = L / npn, pn = L % npn;
        if (tile < tot) { int e = 0; for (int q = 1; q < NE; ++q) e += (tile >= ts[q]) ? 1 : 0; tab[1 + 2 * n] = (unsigned)tile | ((unsigned)pn << 16); tab[2 + 2 * n] = (unsigned)e; }
        else { const int t2 = tile - tot, pm = latent_only ? t2 + 1 + t2 / 32 : t2; tab[1 + 2 * n] = (unsigned)pm | ((unsigned)pn << 16) | 0x80000000u; tab[2 + 2 * n] = (unsigned)NE; }
        ++n; }
    tab[0] = (unsigned)n;
}

template <int PASS>
__device__ __forceinline__ void scan_pass(const Args& args, const Ctx& F, const int unit) {
            unsigned char* ws = F.ws; int tid = F.tid, lane = F.lane; asm volatile("" : "+v"(tid), "+v"(lane));
            const int sid = unit >> 3, seg = unit & 7, b = sid >> 4, h = (sid >> 1) & 7, dir = sid & 1; const bool dummy = false;
            float* SEGM = (float*)(ws + WS_SEG) + (size_t)unit * 4096; float* SEGG = SEGM + 256 * 4096; float* HIN = SEGG + 256 * 4096;
            const bf16_t* Rb = (const bf16_t*)(ws + WS_B); const bf16_t* Kb = Rb + (size_t)T * 512; const bf16_t* Vb = Kb + (size_t)T * 512; const bf16_t* ZZ = (const bf16_t*)(ws + WS_C);
            bf16_t* Y = dir == 0 ? (bf16_t*)(ws + WS_A + SZ512) : (bf16_t*)(ws + WS_YB);
            LAS unsigned char* L0 = F.lds;
#define BUF(i) (L0 + (i) * ck::MSZ)
#define LBAR() asm volatile("s_waitcnt lgkmcnt(0)\n\ts_barrier" ::: "memory")
            LAS float* SEG = (LAS float*)(L0 + 14 * ck::MSZ); LAS float* GAM = SEG + 512;
            const int mt = F.wave >> 1, nt0 = 2 * (F.wave & 1);
            const int st = tid >> 3, c8 = tid & 7, wv = F.wave;
            LAS float* PRM = GAM + 64;
            if (tid < 128) PRM[tid] = tid < 64 ? inp(args, I_KK)[h * 64 + tid] : inp(args, I_KA)[h * 64 + tid - 64];
            const int c0 = (132 * seg) >> 3, c1 = (132 * (seg + 1)) >> 3;
            LAS unsigned char* H0 = BUF(7 + (c0 & 1));
            f32x4 Hacc[2] = {(f32x4){0.f, 0.f, 0.f, 0.f}, (f32x4){0.f, 0.f, 0.f, 0.f}}, Hb[2] = {(f32x4){0.f, 0.f, 0.f, 0.f}, (f32x4){0.f, 0.f, 0.f, 0.f}};
            { const ck::LaneOff li_ = ck::lane_off(lane); const int x_ = lane & 15, g_ = lane >> 4;
              if (PASS == 2) {
#pragma unroll
                  for (int q = 0; q < 2; ++q)
#pragma unroll
                      for (int r = 0; r < 4; ++r) Hacc[q][r] = HIN[(16 * mt + 4 * g_ + r) * 64 + 16 * (nt0 + q) + x_]; }
              else {
#pragma unroll
                  for (int q = 0; q < 2; ++q)
#pragma unroll
                      for (int r = 0; r < 4; ++r) Hb[q][r] = (16 * mt + 4 * g_ + r == 16 * (nt0 + q) + x_) ? 1.f : 0.f;
                  ck::st2(BUF(1), Hb, mt, nt0, li_); }
              ck::st2(H0, Hacc, mt, nt0, li_); }
            u32x4 g_r, g_k, g_v, g_s, g_a;
#define SC_ROW(s_) (b * RB + (dir == 0 ? (s_) : ((s_) < CTXL ? CTXL - 1 - (s_) : RB + CTXL - 1 - (s_))))
#define SC_LOAD(c_) do { const int m_ = SC_ROW((c_) * 64 + st); const size_t o5 = (size_t)m_ * 512 + h * 64 + 8 * c8, oz = (size_t)m_ * 2560 + dir * 512 + h * 64 + 8 * c8; \
        g_r = *(const u32x4*)(Rb + o5); g_k = *(const u32x4*)(Kb + o5); g_v = *(const u32x4*)(Vb + o5); g_s = *(const u32x4*)(ZZ + oz); g_a = *(const u32x4*)(ZZ + oz + 1024); } while (0)
#define MASK2(acc_, INCL) do { _Pragma("unroll") for (int q = 0; q < 2; ++q) _Pragma("unroll") for (int r = 0; r < 4; ++r) { const int m_ = 16 * mt + 4 * g + r, n_ = 16 * (nt0 + q) + x; \
        if (INCL ? (n_ > m_) : (n_ >= m_)) acc_[q][r] = 0.f; } } while (0)
#define ZERO2(acc_) do { acc_[0] = (f32x4){0.f, 0.f, 0.f, 0.f}; acc_[1] = (f32x4){0.f, 0.f, 0.f, 0.f}; } while (0)
            SC_LOAD(c0);
            LBAR();
#pragma unroll 1
            for (int c = c0; c < c1; ++c) {
                LAS unsigned char* Hcur = BUF(7 + (c & 1)); LAS unsigned char* Hnxt = BUF(7 + ((c + 1) & 1));
                int lane_ = lane; asm volatile("" : "+v"(lane_));
                const ck::LaneOff lo_ = ck::lane_off(lane_); const int x = lane_ & 15, g = lane_ >> 4;
                { const u32x4 vraw = g_v, rraw = g_r, kraw = g_k, sraw = g_s, araw = g_a;
                  float inv_;
                  float cs[8];
                  { float ss = 0.f;
                    const f32x4 p0 = *(const LAS f32x4*)(PRM + 8 * c8), p1 = *(const LAS f32x4*)(PRM + 8 * c8 + 4);
#pragma unroll
                    for (int i = 0; i < 4; ++i) { const float k0 = lo2f(kraw[i]) * (i < 2 ? p0[2 * i] : p1[2 * i - 4]), k1 = hi2f(kraw[i]) * (i < 2 ? p0[2 * i + 1] : p1[2 * i - 3]); ss += k0 * k0 + k1 * k1;
                        cs[2 * i] = -0.6065306597126334f * lo2f(sraw[i]); cs[2 * i + 1] = -0.6065306597126334f * hi2f(sraw[i]); }
                    ss += __shfl_xor(ss, 1); ss += __shfl_xor(ss, 2); ss += __shfl_xor(ss, 4);
                    inv_ = 1.f / sqrtf(ss + 1e-12f); }
#pragma unroll
                  for (int d = 8; d < 64; d <<= 1)
#pragma unroll
                      for (int i = 0; i < 8; ++i) { const float v = __shfl_up(cs[i], d); cs[i] += lane >= d ? v : 0.f; }
                  if ((lane >> 3) == 7) { *(LAS f32x4*)(SEG + wv * 64 + 8 * c8) = (f32x4){cs[0], cs[1], cs[2], cs[3]}; *(LAS f32x4*)(SEG + wv * 64 + 8 * c8 + 4) = (f32x4){cs[4], cs[5], cs[6], cs[7]}; }
                  LBAR();
                  const int off = st * ck::PT + 16 * c8;
#pragma unroll
                  for (int hf = 0; hf < 2; ++hf) {
                      f32x4 pre = {0.f, 0.f, 0.f, 0.f}, tot = {0.f, 0.f, 0.f, 0.f};
#pragma unroll
                      for (int q = 0; q < 8; ++q) { const f32x4 v0 = *(const LAS f32x4*)(SEG + q * 64 + 8 * c8 + 4 * hf); tot += v0; if (q < wv) pre += v0; }
                      const f32x4 kk4 = *(const LAS f32x4*)(PRM + 8 * c8 + 4 * hf), ka4 = *(const LAS f32x4*)(PRM + 64 + 8 * c8 + 4 * hf);
                      float oa[4], orr[4], ob[4], ok[4], obh[4], okh[4];
#pragma unroll
                      for (int i = 0; i < 4; ++i) { const int w_ = 2 * hf + (i >> 1); const bool hi_ = i & 1;
                          const float kv = hi_ ? hi2f(kraw[w_]) : lo2f(kraw[w_]), av = hi_ ? hi2f(araw[w_]) : lo2f(araw[w_]), rv = hi_ ? hi2f(rraw[w_]) : lo2f(rraw[w_]), sv_ = hi_ ? hi2f(sraw[w_]) : lo2f(sraw[w_]);
                          const float kn = kv * kk4[i] * inv_, bb = kn * av, kd = kv * (1.f + (av - 1.f) * ka4[i]), lw = -0.6065306597126334f * sv_;
                          const float lc = pre[i] + cs[4 * hf + i]; const float e1 = __expf(lc), e0 = __expf(lc - lw), em = __expf(-lc), eh = __expf(tot[i] - lc);
                          oa[i] = -kn * e0; orr[i] = rv * e1; ob[i] = bb * em; ok[i] = kd * em; obh[i] = bb * eh; okh[i] = kd * eh; }
                      *(LAS u32x2*)(BUF(0) + off + 8 * hf) = (u32x2){pk2(oa[0], oa[1]), pk2(oa[2], oa[3])}; if (PASS == 2) *(LAS u32x2*)(BUF(1) + off + 8 * hf) = (u32x2){pk2(orr[0], orr[1]), pk2(orr[2], orr[3])};
                      *(LAS u32x2*)(BUF(2) + off + 8 * hf) = (u32x2){pk2(ob[0], ob[1]), pk2(ob[2], ob[3])}; *(LAS u32x2*)(BUF(3) + off + 8 * hf) = (u32x2){pk2(ok[0], ok[1]), pk2(ok[2], ok[3])};
                      *(LAS u32x2*)(BUF(4) + off + 8 * hf) = (u32x2){pk2(obh[0], obh[1]), pk2(obh[2], obh[3])}; *(LAS u32x2*)(BUF(5) + off + 8 * hf) = (u32x2){pk2(okh[0], okh[1]), pk2(okh[2], okh[3])};
                      if (st == 0) *(LAS f32x4*)(GAM + 8 * c8 + 4 * hf) = (f32x4){__expf(tot[0]), __expf(tot[1]), __expf(tot[2]), __expf(tot[3])};
                      asm volatile("" ::: "memory"); }
                  *(LAS u32x4*)(BUF(6) + off) = vraw; }
                if (c + 1 < c1) SC_LOAD(c + 1);
                LBAR();
                f32x4 Wacc[2], t2[2];
                ZERO2(Wacc); ck::mm2<false, false>(Wacc, BUF(0), BUF(2), mt, nt0, lo_); MASK2(Wacc, false); ck::st2(BUF(12), Wacc, mt, nt0, lo_);
                ZERO2(t2); ck::mm2<false, false>(t2, BUF(0), BUF(3), mt, nt0, lo_); MASK2(t2, false); ck::st2(BUF(9), t2, mt, nt0, lo_);
                if (PASS == 2) {
                ZERO2(t2); ck::mm2<false, false>(t2, BUF(1), BUF(2), mt, nt0, lo_); MASK2(t2, true); ck::st2(BUF(10), t2, mt, nt0, lo_);
                ZERO2(t2); ck::mm2<false, false>(t2, BUF(1), BUF(3), mt, nt0, lo_); MASK2(t2, true); ck::st2(BUF(11), t2, mt, nt0, lo_); }
                LBAR();
                ZERO2(t2); ck::mm2<true, true>(t2, BUF(9), BUF(6), mt, nt0, lo_); ck::mm2<false, false>(t2, BUF(0), Hcur, mt, nt0, lo_); ck::st2(BUF(2), t2, mt, nt0, lo_);
#pragma unroll
                for (int q = 0; q < 2; ++q)
#pragma unroll
                    for (int r = 0; r < 4; ++r) if (16 * mt + 4 * g + r == 16 * (nt0 + q) + x) Wacc[q][r] += 1.f;
                ck::st2(BUF(13), Wacc, mt, nt0, lo_);
                if (PASS == 1) { ZERO2(t2); ck::mm2<false, false>(t2, BUF(0), BUF(1), mt, nt0, lo_); ck::st2(BUF(10), t2, mt, nt0, lo_); }
                ZERO2(t2); ck::mm2<true, false>(t2, BUF(12), BUF(12), mt, nt0, lo_); ck::st2(BUF(3), t2, mt, nt0, lo_);
                LBAR();
#define WSTEP(Wold, Pcur, Wnew, Pnext, HASNEXT) do { ck::mm2<true, false>(Wacc, BUF(Wold), BUF(Pcur), mt, nt0, lo_); ck::st2(BUF(Wnew), Wacc, mt, nt0, lo_); \
        if (HASNEXT) { ZERO2(t2); ck::mm2<true, false>(t2, BUF(Pcur), BUF(Pcur), mt, nt0, lo_); ck::st2(BUF(Pnext), t2, mt, nt0, lo_); } LBAR(); } while (0)
                WSTEP(13, 3, 9, 12, true); WSTEP(9, 12, 13, 3, true); WSTEP(13, 3, 9, 12, true); WSTEP(9, 12, 13, 3, true); WSTEP(13, 3, 9, 12, false);
                ZERO2(t2); ck::mm2<true, false>(t2, BUF(9), BUF(2), mt, nt0, lo_); ck::st2(BUF(0), t2, mt, nt0, lo_);
                if (PASS == 1) { ZERO2(t2); ck::mm2<true, false>(t2, BUF(9), BUF(10), mt, nt0, lo_); ck::st2(BUF(11), t2, mt, nt0, lo_); }
                LBAR();
                if (PASS == 2) {
                ZERO2(t2); ck::mm2<false, false>(t2, Hcur, BUF(1), mt, nt0, lo_); ck::mm2<false, true>(t2, BUF(0), BUF(10), mt, nt0, lo_); ck::mm2<true, true>(t2, BUF(6), BUF(11), mt, nt0, lo_);
#pragma unroll
                for (int q = 0; q < 2; ++q) { const int m_ = SC_ROW(c * 64 + 16 * (nt0 + q) + x);
                    *(u32x2*)(Y + (size_t)m_ * 512 + h * 64 + 16 * mt + 4 * g) = (u32x2){pk2(t2[q][0], t2[q][1]), pk2(t2[q][2], t2[q][3])}; } }
                { const f32x4 gm = *(const LAS f32x4*)(GAM + 16 * mt + 4 * g); Hacc[0] = Hacc[0] * gm; Hacc[1] = Hacc[1] * gm; if (PASS == 1) { Hb[0] = Hb[0] * gm; Hb[1] = Hb[1] * gm; } }
                if (PASS == 1) { ck::mm2<true, false>(Hb, BUF(4), BUF(11), mt, nt0, lo_); ck::st2(BUF(1), Hb, mt, nt0, lo_); }
                ck::mm2<true, false>(Hacc, BUF(4), BUF(0), mt, nt0, lo_); ck::mm2<true, true>(Hacc, BUF(5), BUF(6), mt, nt0, lo_);
                ck::st2(Hnxt, Hacc, mt, nt0, lo_);
                LBAR();
            }
            if (PASS == 1) { const int x_ = lane & 15, g_ = lane >> 4;
#pragma unroll
                for (int q = 0; q < 2; ++q)
#pragma unroll
                    for (int r = 0; r < 4; ++r) { const int o_ = (16 * mt + 4 * g_ + r) * 64 + 16 * (nt0 + q) + x_; SEGG[o_] = Hacc[q][r]; SEGM[o_] = Hb[q][r]; } }
            __syncthreads();
#undef WSTEP
#undef ZERO2
#undef MASK2
#undef SC_ROW
#undef SC_LOAD
#undef LBAR
#undef BUF
        }

#define IN(k) (lo <= (k) && (k) < hi)
#define SEAM(k) do { if (N_LAUNCH_MODE == 1 && IN((k) + 1)) xcd_barrier(bar); } while (0)
template <int L>
__device__ __forceinline__ void moe_block(const Args& args, const Ctx& F, const XcdBarrier& bar, const int lo, const int hi) {
    const int gw = F.bid * NWAVES + F.wave, NGW = F.G * NWAVES, lane = F.lane, tid = F.tid;
    unsigned char* ws = F.ws; unsigned* ctl = (unsigned*)(ws + WS_CTL); float* MODS = (float*)(ws + SM_MODS);
    volatile LAS unsigned* MISC = (volatile LAS unsigned*)(F.lds + MISC_OFF);
    constexpr int l = L, pb = L == 0 ? 11 : 20, NROW = L == 0 ? T : 2 * SEQ;
    unsigned* cnt = ctl + CW_CNT + l * 1024;
    bf16_t* MW1 = (bf16_t*)(ws + WS_B); bf16_t* MW2 = MW1 + (size_t)17 * 512 * 1024;
    if (CT(11) && IN(pb + 0)) { PH_LOCALS
        LAS float* rwT = (LAS float*)F.lds;
        for (int i = tid; i < 16384; i += NTHR) { const int k = i >> 4, e = i & 15; rwT[e * 1024 + k] = INP(I_RW)[i]; }
        __syncthreads();
        bf16_t* H = (bf16_t*)(ws + WS_A); int* SEL = (int*)(ws + SM_SEL); float* WTS = (float*)(ws + SM_WTS);
        const float rbias_l = lane < 16 ? INP(I_RBIAS)[lane] : 0.f; const float* n2g = INP(I_N2G) + l * 1024;
        for (int r = gw; r < NROW; r += NGW) { const int m = l == 0 ? r : (r / SEQ) * RB + CTXL + r % SEQ; const int b = m / RB; const bool cx = (m % RB) < CTXL;
            const float* md = MODS + (l * 3 + (cx ? 2 : b)) * 6144; f32x4 hv[4];
            norm_mod_row(xl_row(F, m), n2g, md + 3 * 1024, md + 4 * 1024, H + (size_t)m * DM, lane, hv);
            float mylg = 0.f;
#pragma unroll 2
            for (int e = 0; e < 16; ++e) { float a = 0.f;
#pragma unroll
                for (int j = 0; j < 4; ++j) { const f32x4 w = *(const LAS f32x4*)(rwT + e * 1024 + 4 * lane + 256 * j); a += hv[j].x * w.x + hv[j].y * w.y + hv[j].z * w.z + hv[j].w * w.w; }
                a = wave_sum(a); mylg = lane == e ? a : mylg; }
            const float mysc = 1.f / (1.f + __expf(-mylg)), mybs = mysc + rbias_l;
            float sc[16], bs[16];
#pragma unroll
            for (int e = 0; e < 16; ++e) { sc[e] = __int_as_float(__builtin_amdgcn_readlane(__float_as_int(mysc), e)); bs[e] = __int_as_float(__builtin_amdgcn_readlane(__float_as_int(mybs), e)); }
            int grp = 0; float best = -1e30f;
#pragma unroll
            for (int g = 0; g < 4; ++g) { float m1 = -1e30f, m2 = -1e30f;
#pragma unroll
                for (int q = 0; q < 4; ++q) { const float v = bs[g * 4 + q]; if (v > m1) { m2 = m1; m1 = v; } else if (v > m2) m2 = v; }
                const float gs = m1 + m2; if (gs > best) { best = gs; grp = g; } }
            float v4[4], s4[4];
#pragma unroll
            for (int q = 0; q < 4; ++q) { v4[q] = grp == 0 ? bs[q] : grp == 1 ? bs[4 + q] : grp == 2 ? bs[8 + q] : bs[12 + q]; s4[q] = grp == 0 ? sc[q] : grp == 1 ? sc[4 + q] : grp == 2 ? sc[8 + q] : sc[12 + q]; }
            int i0 = 0; float bv0 = v4[0];
#pragma unroll
            for (int q = 1; q < 4; ++q) if (v4[q] > bv0) { bv0 = v4[q]; i0 = q; }
            int i1 = -1; float bv1 = -1e30f;
#pragma unroll
            for (int q = 0; q < 4; ++q) if (q != i0 && v4[q] > bv1) { bv1 = v4[q]; i1 = q; }
            float w0 = 0.f, w1 = 0.f;
#pragma unroll
            for (int q = 0; q < 4; ++q) { w0 = q == i0 ? s4[q] : w0; w1 = q == i1 ? s4[q] : w1; }
            const float ws_ = 1.f / (w0 + w1);
            if (lane == 0) { const int e0 = grp * 4 + i0, e1 = grp * 4 + i1;
                const int s0 = (int)atomicAdd(cnt + e0 * 64, 1u), s1 = (int)atomicAdd(cnt + e1 * 64, 1u);
                *(int4*)(SEL + (size_t)m * 4) = make_int4(e0, s0, e1, s1); *(float2*)(WTS + (size_t)m * 2) = make_float2(w0 * ws_, w1 * ws_); }
        }
        __syncthreads();
        LAS float* scr = (LAS float*)(F.lds + F.wave * 12288);
        for (int it = gw; it < 17 * 384; it += NGW) { const int e = it / 384, r = it % 384;
            if (r < 256) { const int isup = r >> 7, rr = r & 127, kb = rr >> 3, nb = rr & 7;
                const float* W = e < 16 ? (isup ? INP(I_MUP) : INP(I_MGATE)) + ((size_t)l * 16 + e) * 1024 * 256 : (isup ? INP(I_SUP) : INP(I_SGATE)) + (size_t)l * 1024 * 256;
                const int f0 = nb * 32, drow = (f0 >> 7) * 256 + isup * 128 + (f0 & 127);
                tr_item(W, 256, kb * 64, f0, MW1 + (size_t)e * 512 * 1024 + (size_t)drow * 1024 + kb * 64, 1024, scr, lane); }
            else { const int rr = r - 256, kb = rr >> 5, nb = rr & 31;
                const float* W = e < 16 ? INP(I_MDOWN) + ((size_t)l * 16 + e) * 256 * 1024 : INP(I_SDOWN) + (size_t)l * 256 * 1024;
                tr_item(W, 1024, kb * 64, nb * 32, MW2 + (size_t)e * 1024 * 256 + (size_t)(nb * 32) * 256 + kb * 64, 256, scr, lane); } }
        SEAM(pb + 0);
    }
    if (CT(12) && IN(pb + 1)) { PH_LOCALS
        const bf16_t* H = (const bf16_t*)(ws + WS_A); bf16_t* HSb = (bf16_t*)(ws + WS_C); const int* SEL = (const int*)(ws + SM_SEL); const float* WTS = (const float*)(ws + SM_WTS);
        int* POS = (int*)(ws + SM_POS); float* ROWWT = (float*)(ws + SM_ROWWT);
        int seg[16]; { int tot = 0;
#pragma unroll
            for (int e = 0; e < 16; ++e) { seg[e] = tot; tot += (int)((cnt[e * 64] + 255u) & ~255u); } }
        for (int r = gw; r < NROW; r += NGW) { const int m = l == 0 ? r : (r / SEQ) * RB + CTXL + r % SEQ;
            const int4 s = *(const int4*)(SEL + (size_t)m * 4); const float2 w = *(const float2*)(WTS + (size_t)m * 2);
            int d0 = 0, d1 = 0;
#pragma unroll
            for (int e = 0; e < 16; ++e) { d0 = s.x == e ? seg[e] : d0; d1 = s.z == e ? seg[e] : d1; }
            d0 += s.y; d1 += s.w;
            const u32x4* src = (const u32x4*)(H + (size_t)m * DM) + lane; u32x4* p0 = (u32x4*)(HSb + (size_t)d0 * DM) + lane; u32x4* p1 = (u32x4*)(HSb + (size_t)d1 * DM) + lane;
            const u32x4 a = src[0], c = src[64]; p0[0] = a; p0[64] = c; p1[0] = a; p1[64] = c;
            if (lane == 0) { POS[(size_t)m * 2] = d0; POS[(size_t)m * 2 + 1] = d1; ROWWT[d0] = w.x; ROWWT[d1] = w.y; } }
        SEAM(pb + 1);
    }
    if (CT(13) && IN(pb + 2)) { PH_LOCALS
        if (tid == 0) moe_units(MISC + 16, cnt, F.G, F.bid, 2, l == 0 ? 66 : 64, l);
        __syncthreads();
        SchedMoe S{MISC + 16, (const char*)(ws + WS_C), (const char*)(ws + WS_A), (size_t)256 * 1024 * 2,
                   (const char*)MW1, (size_t)512 * 1024 * 2, (size_t)256 * 1024 * 2, (char*)(ws + WS_ACT), (char*)(ws + WS_ACT) + (size_t)HS_ROWS * 512, (size_t)256 * 512, (const float*)(ws + SM_ROWWT)};
        g8::EpiSwiGLU E{};
        g8::gemm_phase(F.lds, 1024, S, E);
        SEAM(pb + 2);
    }
    if (CT(14) && IN(pb + 3)) { PH_LOCALS
        if (tid == 0) moe_units(MISC + 16, cnt, F.G, F.bid, 4, l == 0 ? 66 : 64, l);
        __syncthreads();
        SchedMoe S{MISC + 16, (const char*)(ws + WS_ACT), (const char*)(ws + WS_ACT) + (size_t)HS_ROWS * 512, (size_t)256 * 256 * 2,
                   (const char*)MW2, (size_t)1024 * 256 * 2, (size_t)256 * 256 * 2, (char*)(ws + WS_C), (char*)(ws + WS_A), (size_t)256 * 1024 * 2, nullptr};
        g8::EpiStoreBf16 E{1024, nullptr, 0};
        g8::gemm_phase(F.lds, 256, S, E);
        SEAM(pb + 3);
    }
    if (CT(15) && IN(pb + 4)) { PH_LOCALS
        const bf16_t* YS = (const bf16_t*)(ws + WS_C); bf16_t* YSH = (bf16_t*)(ws + WS_A); const int* POS = (const int*)(ws + SM_POS); const float* n1g1 = INP(I_N1G) + 1024;
        for (int r = gw; r < NROW; r += NGW) { const int m = l == 0 ? r : (r / SEQ) * RB + CTXL + r % SEQ; const int b = m / RB; const bool cx = (m % RB) < CTXL;
            const float* ga2 = MODS + (l * 3 + (cx ? 2 : b)) * 6144 + 5 * 1024;
            const int d0 = POS[(size_t)m * 2], d1 = POS[(size_t)m * 2 + 1];
            float* xr = xl_row(F, m);
            const u32x2* y0 = (const u32x2*)(YS + (size_t)d0 * DM) + lane; const u32x2* y1 = (const u32x2*)(YS + (size_t)d1 * DM) + lane; const u32x2* y2 = (const u32x2*)(YSH + (size_t)m * DM) + lane;
            f32x4 v[4]; float ss = 0.f;
#pragma unroll
            for (int j = 0; j < 4; ++j) { const u32x2 a = y0[64 * j], c = y1[64 * j], d = y2[64 * j]; const f32x4 g = ((const f32x4*)ga2)[lane + 64 * j]; f32x4 x = ((const f32x4*)xr)[lane + 64 * j];
                x.x += g.x * (lo2f(a.x) + lo2f(c.x) + lo2f(d.x)); x.y += g.y * (hi2f(a.x) + hi2f(c.x) + hi2f(d.x)); x.z += g.z * (lo2f(a.y) + lo2f(c.y) + lo2f(d.y)); x.w += g.w * (hi2f(a.y) + hi2f(c.y) + hi2f(d.y));
                ((f32x4*)xr)[lane + 64 * j] = x; v[j] = x; ss += (x.x * x.x + x.y * x.y) + (x.z * x.z + x.w * x.w); }
            if (l == 0) { const float rstd = 1.f / sqrtf(wave_sum(ss) * (1.f / DM) + 1e-6f); const float* md = MODS + (1 * 3 + (cx ? 2 : b)) * 6144; const float* g1 = n1g1;
                unsigned long long* o8 = (unsigned long long*)(YSH + (size_t)m * DM) + lane;
#pragma unroll
                for (int j = 0; j < 4; ++j) { const f32x4 gg = ((const f32x4*)g1)[lane + 64 * j], s1 = ((const f32x4*)(md + 1024))[lane + 64 * j], s0 = ((const f32x4*)md)[lane + 64 * j];
                    const f32x4 h = (v[j] * rstd * gg) * (s1 + 1.f) + s0; o8[64 * j] = (unsigned long long)pk2(h.x, h.y) | ((unsigned long long)pk2(h.z, h.w) << 32); } }
        }
        SEAM(pb + 4);
    }
}

__global__ void __launch_bounds__(NTHR, 2) fwd_kernel(Args args) {
    extern __shared__ __attribute__((aligned(16))) unsigned char lds_raw[];
    Ctx F; F.lds = (LAS unsigned char*)lds_raw; F.tid = threadIdx.x; F.lane = F.tid & 63; F.wave = __builtin_amdgcn_readfirstlane(F.tid >> 6);
    F.G = gridDim.x; F.bid = blockIdx.x; F.ws = args.ws; F.out = args.out;
    volatile LAS unsigned* MISC = (volatile LAS unsigned*)(F.lds + MISC_OFF);
    unsigned* ctl = (unsigned*)(F.ws + WS_CTL);
    for (int u = F.tid; u < (LDS_BYTES - LDSCTL_OFF) / 4; u += NTHR) ((LAS unsigned*)(F.lds + LDSCTL_OFF))[u] = 0u;
    __syncthreads();
    XcdBarrier bar; bar.bar = ctl + CW_BAR; bar.x = 0; bar.st = nullptr;
    if (N_LAUNCH_MODE == 1) bar = xcd_barrier_post(ctl + CW_BAR + args.li * XCD_BAR_WORDS, MISC + 8);
    const int lo = args.ph_lo, hi = args.ph_hi;
    const int gw = F.bid * NWAVES + F.wave, NGW = F.G * NWAVES, lane = F.lane, tid = F.tid;
    unsigned char* ws = F.ws;
    float* MODS = (float*)(ws + SM_MODS);
    bf16_t* WD = (bf16_t*)(ws + WS_WD);

    if (CT(0) && IN(0)) { PH_LOCALS
        if (F.bid < 192) {
            LAS float* sl = (LAS float*)F.lds;
            for (int i = tid; i < 3072; i += NTHR) { const int v = i >> 10, k = i & 1023; const float x = v < 2 ? INP(I_C)[v * 1024 + k] : INP(I_CCTX)[k]; sl[i] = x * sigmoidf_(x); }
            __syncthreads();
            const int l = F.bid / 96, n0 = (F.bid % 96) * 64, ks = tid >> 6, nl = tid & 63;
            const float* W = INP(I_ADAW) + (size_t)l * 1024 * 6144 + n0 + nl;
            float a0 = 0.f, a1 = 0.f, a2 = 0.f;
#pragma unroll 8
            for (int k = ks * 128; k < ks * 128 + 128; ++k) { const float w = W[(size_t)k * 6144]; a0 += sl[k] * w; a1 += sl[1024 + k] * w; a2 += sl[2048 + k] * w; }
            LAS float* part = sl + 3072;
            part[(ks * 3 + 0) * 64 + nl] = a0; part[(ks * 3 + 1) * 64 + nl] = a1; part[(ks * 3 + 2) * 64 + nl] = a2;
            __syncthreads();
            if (tid < 192) { const int v = tid >> 6, n = tid & 63; float s = INP(I_ADAB)[l * 6144 + n0 + n];
#pragma unroll
                for (int q = 0; q < 8; ++q) s += part[(q * 3 + v) * 64 + n];
                MODS[(l * 3 + v) * 6144 + n0 + n] = s; }
            __syncthreads();
        }
        if (F.bid == 192) { float* bz = (float*)(ws + SM_BIASZ);
            for (int i = tid; i < 2560; i += NTHR) bz[i] = i < 1024 ? INP(I_W0)[i] : (i < 2048 ? INP(I_A0)[i - 1024] : 0.f); }
        LAS float* scr = (LAS float*)(F.lds + 32768 + F.wave * 12288);
        constexpr int I1 = 16 * 81, I2 = 16 * 32, I3 = 16, I4 = 32, I5 = 6 * 24, I6 = 4 * 32, I7 = 16 * 48, I8 = 16 * 32;
        constexpr int NIT = I1 + I2 + 4 * I3 + I4 + I5 + I6 + I7 + I8;
        for (int it = gw; it < NIT; it += NGW) {
            int r = it;
            if (r < I1) { tr_matrix_item(INP(I_ABWIN), 1024, 2592, WD + O_WIN0 / 2, 1024, scr, r, lane); continue; } r -= I1;
            if (r < I2) { tr_matrix_item(INP(I_ABWOUT), 1024, 1024, WD + O_WOUT0 / 2, 1024, scr, r, lane); continue; } r -= I2;
            if (r < I3) { tr_matrix_item(INP(I_W2), 64, 512, WD + O_WLORA / 2 + (size_t)0 * 384 + 0, 384, scr, r, lane); continue; } r -= I3;
            if (r < I3) { tr_matrix_item(INP(I_W2) + 64 * 512, 64, 512, WD + O_WLORA / 2 + (size_t)512 * 384 + 64, 384, scr, r, lane); continue; } r -= I3;
            if (r < I3) { tr_matrix_item(INP(I_A2), 64, 512, WD + O_WLORA / 2 + (size_t)1024 * 384 + 128, 384, scr, r, lane); continue; } r -= I3;
            if (r < I3) { tr_matrix_item(INP(I_A2) + 64 * 512, 64, 512, WD + O_WLORA / 2 + (size_t)1536 * 384 + 192, 384, scr, r, lane); continue; } r -= I3;
            if (r < I4) { tr_matrix_item(INP(I_G2), 128, 512, WD + O_WLORA / 2 + (size_t)2048 * 384 + 256, 384, scr, r, lane); continue; } r -= I4;
            if (r < I5) { tr_matrix_item(INP(I_WQUP), 384, 768, WD + O_WQUP / 2, 384, scr, r, lane); continue; } r -= I5;
            if (r < I6) { tr_matrix_item(INP(I_WKVUP), 256, 1024, WD + O_WKVUP / 2, 256, scr, r, lane); continue; } r -= I6;
            if (r < I7) { tr_matrix_item(INP(I_GWIN), 1024, 1536, WD + O_WIN1 / 2, 1024, scr, r, lane); continue; } r -= I7;
            tr_matrix_item(INP(I_GWOUT), 1024, 1024, WD + O_WOUT1 / 2, 1024, scr, r, lane);
        }
        { const int gt = F.bid * NTHR + tid, NGT = F.G * NTHR; const u32x4 z = {0u, 0u, 0u, 0u};
          for (int i = gt; i < 224 * 128; i += NGT) *(u32x4*)(WD + O_WIN0 / 2 + (size_t)2592 * 1024 + (size_t)i * 8) = z;
          for (int i = gt; i < 2560 * 48; i += NGT) { const int n = i / 48, ch = i % 48, blk = n >> 9; const int klo = blk < 4 ? blk * 64 : 256, khi = blk < 4 ? klo + 64 : 384;
              if (ch * 8 < klo || ch * 8 >= khi) *(u32x4*)(WD + O_WLORA / 2 + (size_t)n * 384 + ch * 8) = z; } }
        SEAM(0);
    }

    if (CT(1) && IN(1)) { PH_LOCALS
        bf16_t* H = (bf16_t*)(ws + WS_A); const float* pctx = INP(I_CTX); const float* px = INP(I_X); const float* n1g = INP(I_N1G);
        for (int m = gw; m < T; m += NGW) { const int b = m / RB, j = m % RB; const bool cx = j < CTXL;
            const float* xr = cx ? pctx + (size_t)(b * CTXL + j) * DM : px + (size_t)(b * SEQ + j - CTXL) * DM;
            const float* md = MODS + (0 * 3 + (cx ? 2 : b)) * 6144; f32x4 hv[4];
            norm_mod_row(xr, n1g, md, md + 1024, H + (size_t)m * DM, lane, hv); }
        SEAM(1);
    }
    if (CT(2) && IN(2)) { PH_LOCALS
        SchedDense S{66, 11, F.G, F.bid, (const char*)(ws + WS_A), (const char*)(WD + O_WIN0 / 2), (char*)(ws + WS_C), (size_t)256 * 1024 * 2, (size_t)256 * 1024 * 2, (size_t)256 * 2816 * 2, 0};
        g8::EpiStoreBf16 E{2816, nullptr, 0};
        g8::gemm_phase(F.lds, 1024, S, E);
        SEAM(2);
    }
    if (CT(3) && IN(3)) { PH_LOCALS
        const bf16_t* P = (const bf16_t*)(ws + WS_C);
        bf16_t* Rb = (bf16_t*)(ws + WS_B); bf16_t* Kb = Rb + (size_t)T * 512; bf16_t* Vb = Kb + (size_t)T * 512;
        bf16_t* LIN = (bf16_t*)(ws + WS_A); bf16_t* QAN = LIN + (size_t)T * 384; bf16_t* KVAN = QAN + (size_t)T * 384;
        float* KROPE = (float*)(ws + WS_KROPE);
        const float* mu = INP(I_MU); const float* gqa_ = INP(I_GQA_); const float* gkva_ = INP(I_GKVA);
        for (int m = gw; m < T; m += NGW) { const int j = m % RB;
            const bool hasp = !(j == 0 || j == CTXL), hasn = !(j == CTXL - 1 || j == RB - 1);
            const bf16_t* pr = P + (size_t)m * 2816;
#pragma unroll 1
            for (int ch = lane; ch < 240; ch += 64) {
                const u32x4 pc = *(const u32x4*)(pr + ch * 8);
                u32x4 pp = {0u, 0u, 0u, 0u}, pn = {0u, 0u, 0u, 0u};
                if (hasp) pp = *(const u32x4*)(pr - 2816 + ch * 8);
                if (hasn) pn = *(const u32x4*)(pr + 2816 + ch * 8);
                const f32x4 m0 = *(const f32x4*)(mu + ch * 8), m1 = *(const f32x4*)(mu + ch * 8 + 4);
                float o[8];
#pragma unroll
                for (int q = 0; q < 4; ++q) { const unsigned c = pc[q], a = pp[q], n = pn[q];
                    const float c0 = lo2f(c), c1 = hi2f(c), mm0 = q < 2 ? m0[2 * q] : m1[2 * q - 4], mm1 = q < 2 ? m0[2 * q + 1] : m1[2 * q - 3];
                    o[2 * q] = c0 + mm0 * (0.5f * (lo2f(a) + lo2f(n)) - c0); o[2 * q + 1] = c1 + mm1 * (0.5f * (hi2f(a) + hi2f(n)) - c1); }
                bf16_t* dst;
                if (ch < 64) dst = Rb + (size_t)m * 512 + ch * 8;
                else if (ch < 128) dst = Kb + (size_t)m * 512 + (ch - 64) * 8;
                else if (ch < 192) dst = Vb + (size_t)m * 512 + (ch - 128) * 8;
                else { dst = LIN + (size_t)m * 384 + (ch - 192) * 8;
                    if (ch < 208) {
#pragma unroll
                        for (int q = 0; q < 8; ++q) { const float e = __expf(-2.f * fabsf(o[q])); const float th = (1.f - e) * __builtin_amdgcn_rcpf(1.f + e); o[q] = o[q] < 0.f ? -th : th; } }
                    else if (ch >= 224) {
#pragma unroll
                        for (int q = 0; q < 8; ++q) o[q] = sigmoidf_(o[q]); } }
                u32x4 w; w.x = pk2(o[0], o[1]); w.y = pk2(o[2], o[3]); w.z = pk2(o[4], o[5]); w.w = pk2(o[6], o[7]);
                *(u32x4*)dst = w;
            }
            { float q[8], ss = 0.f; const bool act = lane < 48;
              const u32x4 pc = act ? *(const u32x4*)(pr + 1920 + lane * 8) : (u32x4){0u, 0u, 0u, 0u};
#pragma unroll
              for (int i = 0; i < 4; ++i) { q[2 * i] = lo2f(pc[i]); q[2 * i + 1] = hi2f(pc[i]); ss += q[2 * i] * q[2 * i] + q[2 * i + 1] * q[2 * i + 1]; }
              const float rstd = 1.f / sqrtf(wave_sum(ss) * (1.f / 384.f) + 1e-6f);
              if (act) { const float* g = gqa_ + lane * 8; u32x4 w; w.x = pk2(q[0] * rstd * g[0], q[1] * rstd * g[1]); w.y = pk2(q[2] * rstd * g[2], q[3] * rstd * g[3]);
                  w.z = pk2(q[4] * rstd * g[4], q[5] * rstd * g[5]); w.w = pk2(q[6] * rstd * g[6], q[7] * rstd * g[7]); *(u32x4*)(QAN + (size_t)m * 384 + lane * 8) = w; } }
            { float q[8], ss = 0.f; const bool act = lane < 32;
              const u32x4 pc = act ? *(const u32x4*)(pr + 2304 + lane * 8) : (u32x4){0u, 0u, 0u, 0u};
#pragma unroll
              for (int i = 0; i < 4; ++i) { q[2 * i] = lo2f(pc[i]); q[2 * i + 1] = hi2f(pc[i]); ss += q[2 * i] * q[2 * i] + q[2 * i + 1] * q[2 * i + 1]; }
              const float rstd = 1.f / sqrtf(wave_sum(ss) * (1.f / 256.f) + 1e-6f);
              if (act) { const float* g = gkva_ + lane * 8; u32x4 w; w.x = pk2(q[0] * rstd * g[0], q[1] * rstd * g[1]); w.y = pk2(q[2] * rstd * g[2], q[3] * rstd * g[3]);
                  w.z = pk2(q[4] * rstd * g[4], q[5] * rstd * g[5]); w.w = pk2(q[6] * rstd * g[6], q[7] * rstd * g[7]); *(u32x4*)(KVAN + (size_t)m * 256 + lane * 8) = w; } }
            if (lane < 32) KROPE[(size_t)m * 32 + lane] = bf2f(pr[2560 + lane]);
        }
        SEAM(3);
    }
    if (CT(4) && IN(4)) { PH_LOCALS
        { SchedDense S{66, 10, F.G, F.bid, (const char*)(ws + WS_A), (const char*)(WD + O_WLORA / 2), (char*)(ws + WS_C), (size_t)256 * 384 * 2, (size_t)256 * 384 * 2, (size_t)256 * 2560 * 2, 0};
          g8::EpiStoreBf16 E{2560, (const float*)(ws + SM_BIASZ), 2048};
          g8::gemm_phase(F.lds, 384, S, E); }
        { SchedDense S{66, 3, F.G, F.bid, (const char*)(ws + WS_A + SZ384), (const char*)(WD + O_WQUP / 2), (char*)(ws + WS_D), (size_t)256 * 384 * 2, (size_t)256 * 384 * 2, (size_t)256 * 768 * 2, 0};
          g8::EpiStoreBf16 E{768, nullptr, 0};
          g8::gemm_phase(F.lds, 384, S, E); }
        { SchedDense S{66, 4, F.G, F.bid, (const char*)(ws + WS_A + 2 * SZ384), (const char*)(WD + O_WKVUP / 2), (char*)(ws + WS_D + SZ768), (size_t)256 * 256 * 2, (size_t)256 * 256 * 2, (size_t)256 * 1024 * 2, 0};
          g8::EpiStoreBf16 E{1024, nullptr, 0};
          g8::gemm_phase(F.lds, 256, S, E); }
        SEAM(4);
    }
    if (CT(5) && IN(5)) { PH_LOCALS
        const bf16_t* QRAW = (const bf16_t*)(ws + WS_D); const bf16_t* KVRAW = (const bf16_t*)(ws + WS_D + SZ768); const float* KROPE = (const float*)(ws + WS_KROPE);
        bf16_t* Qm = (bf16_t*)F.out; bf16_t* Km = Qm + (size_t)T * 768; bf16_t* Vm = (bf16_t*)(ws + WS_A);
        const int h = lane >> 3, s = lane & 7;
        const float inv = __powf(10000.f, -(float)s * 0.125f);
        float gq[12], gk[12];
#pragma unroll
        for (int i = 0; i < 12; ++i) { gq[i] = INP(I_MGQ)[s + 8 * i]; gk[i] = INP(I_MGK)[s + 8 * i]; }
        for (int m = gw; m < T; m += NGW) { const int j = m % RB; const bool lat = j >= CTXL;
            float cr = 1.f, sr = 0.f, cc = 1.f, sc = 0.f;
            if (lat) { const int sp = j - CTXL; const float pr_ = (float)(sp >> 6), pc_ = (float)(sp & 63); sincosf(pr_ * inv, &sr, &cr); sincosf(pc_ * inv, &sc, &cc); }
            float q[12], k[12], ssq = 0.f, ssk = 0.f;
#pragma unroll
            for (int i = 0; i < 12; ++i) { q[i] = bf2f(QRAW[(size_t)m * 768 + h * 96 + s + 8 * i]); ssq += q[i] * q[i]; }
#pragma unroll
            for (int i = 0; i < 8; ++i) k[i] = bf2f(KVRAW[(size_t)m * 1024 + h * 128 + s + 8 * i]);
#pragma unroll
            for (int i = 8; i < 12; ++i) k[i] = KROPE[(size_t)m * 32 + s + 8 * (i - 8)];
#pragma unroll
            for (int i = 0; i < 12; ++i) ssk += k[i] * k[i];
            ssq += __shfl_xor(ssq, 1); ssq += __shfl_xor(ssq, 2); ssq += __shfl_xor(ssq, 4);
            ssk += __shfl_xor(ssk, 1); ssk += __shfl_xor(ssk, 2); ssk += __shfl_xor(ssk, 4);
            const float rq = 1.f / sqrtf(ssq * (1.f / 96.f) + 1e-6f), rk = 1.f / sqrtf(ssk * (1.f / 96.f) + 1e-6f);
#pragma unroll
            for (int i = 0; i < 12; ++i) { q[i] = q[i] * rq * gq[i]; k[i] = k[i] * rk * gk[i]; }
            { const float a = q[8], b2 = q[9]; q[8] = a * cr - b2 * sr; q[9] = b2 * cr + a * sr; const float c = q[10], d = q[11]; q[10] = c * cc - d * sc; q[11] = d * cc + c * sc; }
            { const float a = k[8], b2 = k[9]; k[8] = a * cr - b2 * sr; k[9] = b2 * cr + a * sr; const float c = k[10], d = k[11]; k[10] = c * cc - d * sc; k[11] = d * cc + c * sc; }
#pragma unroll
            for (int i = 0; i < 12; ++i) { Qm[(size_t)m * 768 + h * 96 + s + 8 * i] = (bf16_t)(pk2(q[i] * C2_MLA, 0.f) & 0xffffu); Km[(size_t)m * 768 + h * 96 + s + 8 * i] = (bf16_t)(pk2(k[i], 0.f) & 0xffffu); }
#pragma unroll
            for (int i = 0; i < 8; ++i) Vm[(size_t)m * 512 + h * 64 + s + 8 * i] = KVRAW[(size_t)m * 1024 + h * 128 + 64 + s + 8 * i];
        }
        SEAM(5);
    }
    if (CT(6) && IN(6)) { PH_LOCALS
        for (int unit = F.bid; unit < 256; unit += F.G) scan_pass<1>(args, F, unit);
        SEAM(6);
    }
    if (CT(7) && IN(7)) { PH_LOCALS
        LAS float* Ml = (LAS float*)F.lds; LAS float* Hl = Ml + 64 * 65;
        for (int sid = F.bid; sid < 32; sid += F.G) {
            float* SEGM = (float*)(ws + WS_SEG) + (size_t)sid * 8 * 4096; float* SEGG = SEGM + 256 * 4096; float* HIN = SEGG + 256 * 4096;
            const int j = tid >> 3, i0 = (tid & 7) * 8;
            __syncthreads();
            for (int i = tid; i < 4096; i += NTHR) { Hl[i] = 0.f; HIN[i] = 0.f; }
            for (int sg = 0; sg < 7; ++sg) {
                __syncthreads();
                for (int i = tid; i < 4096; i += NTHR) Ml[(i >> 6) * 65 + (i & 63)] = SEGM[sg * 4096 + i];
                __syncthreads();
                float acc[8];
#pragma unroll
                for (int q = 0; q < 8; ++q) acc[q] = SEGG[sg * 4096 + j * 64 + i0 + q];
#pragma unroll 4
                for (int k = 0; k < 64; ++k) { const float m = Ml[j * 65 + k]; const f32x4 h0 = *(const LAS f32x4*)(Hl + k * 64 + i0), h1 = *(const LAS f32x4*)(Hl + k * 64 + i0 + 4);
#pragma unroll
                    for (int q = 0; q < 4; ++q) { acc[q] += m * h0[q]; acc[4 + q] += m * h1[q]; } }
                __syncthreads();
#pragma unroll
                for (int q = 0; q < 8; ++q) { Hl[j * 64 + i0 + q] = acc[q]; HIN[(sg + 1) * 4096 + j * 64 + i0 + q] = acc[q]; }
            }
        }
        SEAM(7);
    }
    if (CT(8) && IN(8)) { PH_LOCALS
        unsigned* queue = ctl + CW_QUEUE;
        for (int unit = F.bid; unit < 256; unit += F.G) scan_pass<2>(args, F, unit);
        { const bf16_t* Qm = (const bf16_t*)F.out; const bf16_t* Km = Qm + (size_t)T * 768; const bf16_t* Vm = (const bf16_t*)(ws + WS_A); bf16_t* CAT = (bf16_t*)(ws + WS_D);
          for (;;) {
              __syncthreads();
              if (tid == 0) MISC[0] = atomicAdd(queue, 1u);
              __syncthreads();
              const unsigned u = MISC[0];
              if (u >= 528u) break;
              const int bh = u < 512u ? (int)u / 32 : (int)u - 512, qb = u < 512u ? 1 + (int)u % 32 : 0, b = bh >> 3, h = bh & 7;
              const size_t m0 = (size_t)b * RB + (size_t)qb * 256, k0 = (size_t)b * RB;
              at96::attn_unit<8, 768, 768, 512, 1024>((const at96::bf16*)(Qm + m0 * 768 + h * 96), (const at96::bf16*)(Km + k0 * 768 + h * 96), (const at96::bf16*)(Vm + k0 * 512 + h * 64),
                                                      (at96::bf16*)(CAT + m0 * 1024 + 512 + h * 64), qb == 0 ? 4 : 132, (char*)lds_raw);
          } }
        SEAM(8);
    }
    if (CT(9) && IN(9)) { PH_LOCALS
        const bf16_t* Rb = (const bf16_t*)(ws + WS_B); const bf16_t* Kb = Rb + (size_t)T * 512; const bf16_t* Vb = Kb + (size_t)T * 512; const bf16_t* ZZ = (const bf16_t*)(ws + WS_C);
        const bf16_t* Yf = (const bf16_t*)(ws + WS_A + SZ512); const bf16_t* Yb = (const bf16_t*)(ws + WS_YB); bf16_t* CAT = (bf16_t*)(ws + WS_D);
        float lnw[8], lnb[8], rk[8], ka[8];
#pragma unroll
        for (int i = 0; i < 8; ++i) { lnw[i] = INP(I_LNW)[lane * 8 + i]; lnb[i] = INP(I_LNB)[lane * 8 + i]; rk[i] = INP(I_RK)[lane * 8 + i]; ka[i] = INP(I_KA)[lane * 8 + i]; }
        for (int m = gw; m < T; m += NGW) {
            const size_t o5 = (size_t)m * 512 + lane * 8, oz = (size_t)m * 2560 + lane * 8;
            const u32x4 yf = *(const u32x4*)(Yf + o5), yb = *(const u32x4*)(Yb + o5), rr = *(const u32x4*)(Rb + o5), kk = *(const u32x4*)(Kb + o5), vv = *(const u32x4*)(Vb + o5);
            const u32x4 af = *(const u32x4*)(ZZ + oz + 1024), ab = *(const u32x4*)(ZZ + oz + 1536), gg = *(const u32x4*)(ZZ + oz + 2048);
            float y[8], s = 0.f, bon = 0.f;
#pragma unroll
            for (int i = 0; i < 4; ++i) { y[2 * i] = lo2f(yf[i]) + lo2f(yb[i]); y[2 * i + 1] = hi2f(yf[i]) + hi2f(yb[i]); s += y[2 * i] + y[2 * i + 1];
                const float k0 = lo2f(kk[i]), k1 = hi2f(kk[i]), a0 = lo2f(af[i]) + lo2f(ab[i]) - 2.f, a1 = hi2f(af[i]) + hi2f(ab[i]) - 2.f;
                bon += lo2f(rr[i]) * (k0 * (2.f + a0 * ka[2 * i])) * rk[2 * i] + hi2f(rr[i]) * (k1 * (2.f + a1 * ka[2 * i + 1])) * rk[2 * i + 1]; }
            s += __shfl_xor(s, 1); s += __shfl_xor(s, 2); s += __shfl_xor(s, 4);
            bon += __shfl_xor(bon, 1); bon += __shfl_xor(bon, 2); bon += __shfl_xor(bon, 4);
            const float mean = s * (1.f / 64.f); float q = 0.f;
#pragma unroll
            for (int i = 0; i < 8; ++i) { y[i] -= mean; q += y[i] * y[i]; }
            q += __shfl_xor(q, 1); q += __shfl_xor(q, 2); q += __shfl_xor(q, 4);
            const float rstd = 1.f / sqrtf(q * (1.f / 64.f) + 64e-5f);
            float o[8];
#pragma unroll
            for (int i = 0; i < 4; ++i) { o[2 * i] = (y[2 * i] * rstd * lnw[2 * i] + lnb[2 * i] + bon * lo2f(vv[i])) * lo2f(gg[i]); o[2 * i + 1] = (y[2 * i + 1] * rstd * lnw[2 * i + 1] + lnb[2 * i + 1] + bon * hi2f(vv[i])) * hi2f(gg[i]); }
            u32x4 w; w.x = pk2(o[0], o[1]); w.y = pk2(o[2], o[3]); w.z = pk2(o[4], o[5]); w.w = pk2(o[6], o[7]);
            *(u32x4*)(CAT + (size_t)m * 1024 + lane * 8) = w;
        }
        SEAM(9);
    }
    if (CT(10) && IN(10)) { PH_LOCALS
        SchedRes S{66, 4, F.G, F.bid, (const char*)(ws + WS_D), (const char*)(WD + O_WOUT0 / 2), (size_t)256 * 1024 * 2, (size_t)256 * 1024 * 2, 0,
                   INP(I_X), INP(I_CTX), F.out, (float*)(ws + WS_XLC)};
        g8::EpiResGate E{MODS + 0 * 3 * 6144 + 2 * 1024, MIX_AMP};
        g8::gemm_phase(F.lds, 1024, S, E);
        SEAM(10);
    }

    moe_block<0>(args, F, bar, lo, hi);
        if (CT(16) && IN(16)) { PH_LOCALS
            SchedDense S{66, 6, F.G, F.bid, (const char*)(ws + WS_A), (const char*)(WD + O_WIN1 / 2), (char*)(ws + WS_C), (size_t)256 * 1024 * 2, (size_t)256 * 1024 * 2, (size_t)256 * 1536 * 2, 0};
            g8::EpiStoreBf16 E{1536, nullptr, 0};
            g8::gemm_phase(F.lds, 1024, S, E);
            SEAM(16);
        }
        if (CT(17) && IN(17)) { PH_LOCALS
            bf16_t* QKV = (bf16_t*)(ws + WS_C);
            const int hq = lane >> 2, sq = lane & 3, hk = lane >> 4, sk = lane & 15;
            float gq[16], gk[4];
#pragma unroll
            for (int i = 0; i < 16; ++i) gq[i] = INP(I_GGQ)[sq + 4 * i];
#pragma unroll
            for (int i = 0; i < 4; ++i) gk[i] = INP(I_GGK)[sk + 16 * i];
            float invq[4];
#pragma unroll
            for (int i = 0; i < 4; ++i) invq[i] = __powf(10000.f, -(float)(sq + 4 * i) * (1.f / 16.f));
            const float invk = __powf(10000.f, -(float)sk * (1.f / 16.f));
            for (int m = gw; m < T; m += NGW) { const int j = m % RB; const bool lat = j >= CTXL; bf16_t* row = QKV + (size_t)m * 1536;
                const int sp = j - CTXL; const float pr_ = (float)(sp >> 6), pc_ = (float)(sp & 63);
                { float k[4], ss = 0.f;
#pragma unroll
                  for (int i = 0; i < 4; ++i) { k[i] = bf2f(row[1024 + hk * 64 + sk + 16 * i]); ss += k[i] * k[i]; }
                  ss = rowsum16(ss); const float rs = 1.f / sqrtf(ss * (1.f / 64.f) + 1e-6f);
#pragma unroll
                  for (int i = 0; i < 4; ++i) k[i] = k[i] * rs * gk[i];
                  if (lat) { float cr, sr, cc, sc; sincosf(pr_ * invk, &sr, &cr); sincosf(pc_ * invk, &sc, &cc);
                      const float a = k[0], b2 = k[1]; k[0] = a * cr - b2 * sr; k[1] = b2 * cr + a * sr; const float c = k[2], d = k[3]; k[2] = c * cc - d * sc; k[3] = d * cc + c * sc; }
#pragma unroll
                  for (int i = 0; i < 4; ++i) row[1024 + hk * 64 + sk + 16 * i] = (bf16_t)(pk2(k[i], 0.f) & 0xffffu); }
                if (lat) { float q[16], ss = 0.f;
#pragma unroll
                  for (int i = 0; i < 16; ++i) { q[i] = bf2f(row[hq * 64 + sq + 4 * i]); ss += q[i] * q[i]; }
                  ss += __shfl_xor(ss, 1); ss += __shfl_xor(ss, 2); const float rs = 1.f / sqrtf(ss * (1.f / 64.f) + 1e-6f);
#pragma unroll
                  for (int i = 0; i < 16; ++i) q[i] = q[i] * rs * gq[i];
#pragma unroll
                  for (int i = 0; i < 4; ++i) { float cr, sr, cc, sc; sincosf(pr_ * invq[i], &sr, &cr); sincosf(pc_ * invq[i], &sc, &cc);
                      const float a = q[i], b2 = q[i + 4]; q[i] = a * cr - b2 * sr; q[i + 4] = b2 * cr + a * sr; const float c = q[i + 8], d = q[i + 12]; q[i + 8] = c * cc - d * sc; q[i + 12] = d * cc + c * sc; }
#pragma unroll
                  for (int i = 0; i < 16; ++i) row[hq * 64 + sq + 4 * i] = (bf16_t)(pk2(q[i] * C2_GQA, 0.f) & 0xffffu); }
            }
            SEAM(17);
        }
        if (CT(18) && IN(18)) { PH_LOCALS
            const bf16_t* QKV = (const bf16_t*)(ws + WS_C); bf16_t* O1 = (bf16_t*)(ws + WS_D);
            const int x = F.bid & 7, b = x >> 2, kvh = x & 3, per = F.G >> 3, i0 = F.bid >> 3;
            for (int uu = i0; uu < 128; uu += per) { const int hh = kvh * 4 + (uu >> 5), qb = 1 + (uu & 31);
                const size_t m0 = (size_t)b * RB + (size_t)qb * 256, k0 = (size_t)b * RB;
                __syncthreads();
                at64::attn_unit<8, 1536, 1536, 1024>((const at64::bf16*)(QKV + m0 * 1536 + hh * 64), (const at64::bf16*)(QKV + k0 * 1536 + 1024 + kvh * 64), (const at64::bf16*)(QKV + k0 * 1536 + 1280 + kvh * 64),
                                                     (at64::bf16*)(O1 + m0 * 1024 + hh * 64), 132, (char*)lds_raw); }
            SEAM(18);
        }
        if (CT(19) && IN(19)) { PH_LOCALS
            SchedRes S{64, 4, F.G, F.bid, (const char*)(ws + WS_D), (const char*)(WD + O_WOUT1 / 2), (size_t)256 * 1024 * 2, (size_t)256 * 1024 * 2, 1,
                       F.out, (const float*)(ws + WS_XLC), F.out, (float*)(ws + WS_XLC)};
            g8::EpiResGate E{MODS + 1 * 3 * 6144 + 2 * 1024, 1.0f};
            g8::gemm_phase(F.lds, 1024, S, E);
            SEAM(19);
        }
    moe_block<1>(args, F, bar, lo, hi);
#undef IN
#undef SEAM
}

extern "C" void kernel_launch(void* const* d_in, const int* in_sizes, int n_in, void* d_out, int out_size, void* d_ws, size_t ws_size, hipStream_t stream) {
    static int grid = 0;
    if (grid == 0) {
        if (n_in != 39 || out_size != 2 * SEQ * DM || ws_size < WS_NEED) { fprintf(stderr, "kernel_launch: unexpected shapes (n_in %d out %d ws %zu)\n", n_in, out_size, ws_size); grid = -1; return; }
        int dev = 0, cus = 0;
        if (hipGetDevice(&dev) != hipSuccess || hipDeviceGetAttribute(&cus, hipDeviceAttributeMultiprocessorCount, dev) != hipSuccess) { grid = -1; return; }
        if (hipFuncSetAttribute((const void*)fwd_kernel, hipFuncAttributeMaxDynamicSharedMemorySize, LDS_BYTES) != hipSuccess) { fprintf(stderr, "kernel_launch: hipFuncSetAttribute failed\n"); grid = -1; return; }
        int per_cu = 0;
        if (hipOccupancyMaxActiveBlocksPerMultiprocessor(&per_cu, (const void*)fwd_kernel, NTHR, LDS_BYTES) != hipSuccess || per_cu < 1) fprintf(stderr, "kernel_launch: occupancy query says %d\n", per_cu);
        (void)hipGetLastError();
        grid = cus;
    }
    if (grid < 0) return;
    if (hipMemsetAsync((char*)d_ws + WS_CTL, 0, CTL_BYTES, stream) != hipSuccess) return;
    Args a{};
    for (int i = 0; i < 39; ++i) a.in[i] = (const float*)d_in[i];
    a.out = (float*)d_out; a.ws = (unsigned char*)d_ws;
    if (N_LAUNCH_MODE == 1 && DUP_PH >= 0) { a.ph_lo = 0; a.ph_hi = DUP_PH + 1; a.li = 0; hipLaunchKernelGGL(fwd_kernel, dim3(grid), dim3(NTHR), LDS_BYTES, stream, a);
        a.ph_lo = DUP_PH; a.ph_hi = PH_END; a.li = 1; hipLaunchKernelGGL(fwd_kernel, dim3(grid), dim3(NTHR), LDS_BYTES, stream, a); }
    else if (N_LAUNCH_MODE == 1) { a.ph_lo = 0; a.ph_hi = PH_END; hipLaunchKernelGGL(fwd_kernel, dim3(grid), dim3(NTHR), LDS_BYTES, stream, a); }
    else for (int p = 0; p < PH_END; ++p) { a.ph_lo = p; a.ph_hi = p + 1; hipLaunchKernelGGL(fwd_kernel, dim3(grid), dim3(NTHR), LDS_BYTES, stream, a); }
}
```
